# Optimizing an MI355X kernel written in HIP

```python
import math
import jax, jax.numpy as jnp
from jax import lax
import numpy as np

D_MODEL = 1024
BATCH = 32
SEQ = 2048
DEPTH = 1

CHUNK = 64
Q_BLOCK = 128

MIX_WIDTH = D_MODEL
HG_WIDTH = MIX_WIDTH // 2
HG_HEADS = 4
HG_DK = HG_WIDTH // HG_HEADS
FOX_WIDTH = MIX_WIDTH - HG_WIDTH
FOX_HEADS = 8
FOX_DH = FOX_WIDTH // FOX_HEADS
IN_COLS = 4 * HG_WIDTH + 3 * FOX_WIDTH + FOX_HEADS
N_EXPERT_GROUPS = 4
EXPERTS_PER_GROUP = 4
N_EXPERTS = N_EXPERT_GROUPS * EXPERTS_PER_GROUP
TOP_K = 2
EXPERT_HIDDEN = D_MODEL // 2
NORM_EPS = 1e-6
NEG_INF = -1e30

kernel_name = "hybrid_hgrn2_fox_hiermoe_block"


def rms_norm(x, gain):
    xf = x.astype(jnp.float32)
    y = xf * lax.rsqrt(jnp.mean(xf * xf, axis=-1, keepdims=True) + NORM_EPS)
    return (y * gain.astype(jnp.float32)).astype(x.dtype)


def hgrn2_mixer(q_raw, f_raw, i_raw, g_raw, lower_bound, norm_gain):
    B, S, _ = q_raw.shape
    nc = S // CHUNK
    f32 = jnp.float32
    q = jax.nn.silu(q_raw.astype(f32))
    lb = lower_bound.astype(f32)
    f = lb + (1.0 - lb) * jax.nn.sigmoid(f_raw.astype(f32))
    log_f = jnp.log(f)
    k = 1.0 - f
    v = i_raw.astype(f32)

    def to_chunks(t):
        return t.reshape(B, nc, CHUNK, HG_HEADS, HG_DK).transpose(1, 0, 3, 2, 4)

    causal = jnp.tril(jnp.ones((CHUNK, CHUNK), dtype=bool))

    def step(state, inp):
        qc, kc, vc, lfc = inp
        b = jnp.cumsum(lfc, axis=2)
        o_inter = jnp.einsum('bhtk,bhkv->bhtv', qc * jnp.exp(b), state)
        diff = b[:, :, :, None, :] - b[:, :, None, :, :]
        decay = jnp.where(causal[:, :, None], jnp.exp(jnp.minimum(diff, 0.0)), 0.0)
        scores = jnp.einsum('bhtk,bhtsk,bhsk->bhts', qc, decay, kc)
        o_intra = jnp.einsum('bhts,bhsv->bhtv', scores, vc)
        b_last = b[:, :, -1:, :]
        new_state = (jnp.exp(b_last[:, :, 0, :])[..., None] * state
                     + jnp.einsum('bhsk,bhsv->bhkv', kc * jnp.exp(b_last - b), vc))
        return new_state, o_inter + o_intra

    s0 = jnp.zeros((B, HG_HEADS, HG_DK, HG_DK), f32)
    _, o = lax.scan(step, s0, (to_chunks(q), to_chunks(k), to_chunks(v), to_chunks(log_f)))
    o = o.transpose(1, 0, 3, 2, 4).reshape(B, S, HG_HEADS, HG_DK)
    o = rms_norm(o, norm_gain)
    o = o.reshape(B, S, HG_WIDTH) * jax.nn.silu(g_raw.astype(f32))
    return o.astype(q_raw.dtype)


def fox_mixer(q_raw, k_raw, v_raw, f_raw, f_bias, norm_gain):
    B, S, _ = q_raw.shape
    f32 = jnp.float32

    def heads(t):
        return t.astype(f32).reshape(B, S, FOX_HEADS, FOX_DH).transpose(0, 2, 1, 3)

    q = heads(q_raw) * (FOX_DH ** -0.5)
    k = heads(k_raw)
    v = heads(v_raw)
    log_f = jax.nn.log_sigmoid(f_raw.astype(f32) + f_bias.astype(f32))
    cum = jnp.cumsum(log_f, axis=1).transpose(0, 2, 1)
    key_pos = jnp.arange(S)

    def block(i):
        start = i * Q_BLOCK
        qb = lax.dynamic_slice_in_dim(q, start, Q_BLOCK, axis=2)
        cb = lax.dynamic_slice_in_dim(cum, start, Q_BLOCK, axis=2)
        logits = jnp.einsum('bhtd,bhsd->bhts', qb, k) + (cb[..., :, None] - cum[..., None, :])
        mask = (start + jnp.arange(Q_BLOCK))[:, None] >= key_pos[None, :]
        logits = jnp.where(mask, logits, NEG_INF)
        p = jax.nn.softmax(logits, axis=-1)
        return jnp.einsum('bhts,bhsd->bhtd', p, v)

    o = lax.map(block, jnp.arange(S // Q_BLOCK))
    o = o.transpose(1, 0, 3, 2, 4).reshape(B, S, FOX_HEADS, FOX_DH)
    o = rms_norm(o, norm_gain)
    return o.reshape(B, S, FOX_WIDTH).astype(q_raw.dtype)


def hier_moe(x, w_group, b_group, w_expert, b_expert, w_gate, w_up, w_down):
    B, S, D = x.shape
    t = x.reshape(-1, D)
    pg = jax.nn.softmax((t @ w_group + b_group).astype(jnp.float32), axis=-1)
    gsel = jnp.argmax(pg, axis=-1)
    pg_sel = jnp.max(pg, axis=-1)
    e_logits = (t @ w_expert + b_expert).astype(jnp.float32).reshape(-1, N_EXPERT_GROUPS, EXPERTS_PER_GROUP)
    e_logits = jnp.take_along_axis(e_logits, gsel[:, None, None], axis=1)[:, 0]
    pe = jax.nn.softmax(e_logits, axis=-1)
    top_p, top_i = lax.top_k(pe, TOP_K)
    top_p = top_p / jnp.sum(top_p, axis=-1, keepdims=True)
    expert_id = gsel[:, None] * EXPERTS_PER_GROUP + top_i
    weights = pg_sel[:, None] * top_p
    gates = jnp.sum(jax.nn.one_hot(expert_id, N_EXPERTS, dtype=jnp.float32) * weights[..., None], axis=1)
    gates = gates.astype(t.dtype)
    y = jnp.zeros_like(t)
    for e in range(N_EXPERTS):
        h = jax.nn.silu(t @ w_gate[e]) * (t @ w_up[e])
        y = y + gates[:, e:e + 1] * (h @ w_down[e])
    return y.reshape(B, S, D)


def setup_inputs(seed: int = 0) -> dict:
    key = jax.random.key(seed)
    ks = jax.random.split(key, 20)
    f32 = jnp.float32
    L, D = DEPTH, D_MODEL
    nrm = lambda k, shape, scale: jax.random.normal(k, shape, f32) * scale
    return {
        "x": jax.random.normal(ks[0], (BATCH, SEQ, D), f32),
        "attn_norm": 1.0 + nrm(ks[1], (L, D), 0.02),
        "w_in": nrm(ks[2], (L, D, IN_COLS), D ** -0.5),
        "hg_lb_logits": nrm(ks[3], (L + 1, HG_WIDTH), 0.5),
        "hg_norm": 1.0 + nrm(ks[4], (L, HG_DK), 0.02),
        "fox_f_bias": nrm(ks[5], (L, FOX_HEADS), 0.1),
        "fox_norm": 1.0 + nrm(ks[6], (L, FOX_DH), 0.02),
        "w_out": nrm(ks[7], (L, MIX_WIDTH, D), MIX_WIDTH ** -0.5),
        "ffn_norm": 1.0 + nrm(ks[8], (L, D), 0.02),
        "w_group": nrm(ks[9], (L, D, N_EXPERT_GROUPS), D ** -0.5),
        "b_group": nrm(ks[10], (L, N_EXPERT_GROUPS), 0.01),
        "w_expert": nrm(ks[11], (L, D, N_EXPERTS), D ** -0.5),
        "b_expert": nrm(ks[12], (L, N_EXPERTS), 0.01),
        "w_gate": nrm(ks[13], (L, N_EXPERTS, D, EXPERT_HIDDEN), D ** -0.5),
        "w_up": nrm(ks[14], (L, N_EXPERTS, D, EXPERT_HIDDEN), D ** -0.5),
        "w_down": nrm(ks[15], (L, N_EXPERTS, EXPERT_HIDDEN, D), EXPERT_HIDDEN ** -0.5),
        "final_norm": 1.0 + nrm(ks[16], (D,), 0.02),
    }


def reference(x, attn_norm, w_in, hg_lb_logits, hg_norm, fox_f_bias, fox_norm, w_out, ffn_norm,
              w_group, b_group, w_expert, b_expert, w_gate, w_up, w_down, final_norm):
    lb_all = jnp.cumsum(jax.nn.softmax(hg_lb_logits.astype(jnp.float32), axis=0), axis=0)
    o0 = 0
    o1 = o0 + HG_WIDTH
    o2 = o1 + HG_WIDTH
    o3 = o2 + HG_WIDTH
    o4 = o3 + HG_WIDTH
    o5 = o4 + FOX_WIDTH
    o6 = o5 + FOX_WIDTH
    o7 = o6 + FOX_WIDTH
    h = x
    for l in range(DEPTH):
        xn = rms_norm(h, attn_norm[l])
        u = xn @ w_in[l]
        o_a = hgrn2_mixer(u[..., o0:o1], u[..., o1:o2], u[..., o2:o3], u[..., o3:o4],
                          lb_all[l], hg_norm[l])
        o_b = fox_mixer(u[..., o4:o5], u[..., o5:o6], u[..., o6:o7], u[..., o7:IN_COLS],
                        fox_f_bias[l], fox_norm[l])
        h = h + jnp.concatenate([o_a, o_b], axis=-1) @ w_out[l]
        h = h + hier_moe(rms_norm(h, ffn_norm[l]), w_group[l], b_group[l], w_expert[l], b_expert[l],
                         w_gate[l], w_up[l], w_down[l])
    return rms_norm(h, final_norm)
```

```cpp
#include <hip/hip_runtime.h>
namespace nv {
constexpr int T = 65536, D = 1024, NB = 32, S = 2048, INC = 3592, HGW = 512, FXW = 512, FXH = 8, FXD = 64, HGH = 4, HGD = 128;
constexpr int NE = 16, EH = 512;
constexpr int RMAX = 2 * T + NE * 256;

__device__ __forceinline__ float wsum(float v) {
#pragma unroll
    for (int o = 1; o < 64; o <<= 1) v += __shfl_xor(v, o);
    return v;
}
__device__ __forceinline__ float siluf(float x) { return x / (1.f + expf(-x)); }
__device__ __forceinline__ float sigm(float x) { return 1.f / (1.f + expf(-x)); }

__global__ void k_lb(const float* __restrict__ lg, float* __restrict__ lb) {
    int i = blockIdx.x * blockDim.x + threadIdx.x;
    if (i < HGW) { float a = lg[i], b = lg[HGW + i]; float m = fmaxf(a, b); float ea = expf(a - m), eb = expf(b - m); lb[i] = ea / (ea + eb); }
}
__global__ void k_rms(const float* __restrict__ x, const float* __restrict__ g, float* __restrict__ y, int rows) {
    int w = (int)((blockIdx.x * (size_t)blockDim.x + threadIdx.x) >> 6), lane = threadIdx.x & 63;
    if (w >= rows) return;
    const float4* xr = (const float4*)(x + (size_t)w * D); const float4* gr = (const float4*)g; float4* yr = (float4*)(y + (size_t)w * D);
    float4 v[4]; float s = 0.f;
#pragma unroll
    for (int j = 0; j < 4; ++j) { v[j] = xr[lane + 64 * j]; s += v[j].x * v[j].x + v[j].y * v[j].y + v[j].z * v[j].z + v[j].w * v[j].w; }
    s = wsum(s); const float r = rsqrtf(s * (1.f / D) + 1e-6f);
#pragma unroll
    for (int j = 0; j < 4; ++j) { float4 gg = gr[lane + 64 * j]; float4 o; o.x = v[j].x * r * gg.x; o.y = v[j].y * r * gg.y; o.z = v[j].z * r * gg.z; o.w = v[j].w * r * gg.w; yr[lane + 64 * j] = o; }
}
struct GemmArgs {
    const float* A; int lda; const int* a_rows;
    const float* B; const float* B2; int ldb;
    const int* tile_e; size_t strideB;
    float* C; int ldc; const float* R; const int* c_rows; const float* roww;
    const int* Mdev; int M, N, K, mode;
};
__global__ void __launch_bounds__(256) k_gemm(GemmArgs a) {
    __shared__ float As[16][64 + 4], Bs[16][64 + 4], Bs2[16][64 + 4];
    const int M = a.Mdev ? *a.Mdev : a.M;
    const int m0 = blockIdx.y * 64, n0 = blockIdx.x * 64;
    if (m0 >= M) return;
    const float* Bp = a.B; const float* B2p = a.B2;
    if (a.tile_e) { int e = a.tile_e[m0 >> 8]; Bp += (size_t)e * a.strideB; if (B2p) B2p += (size_t)e * a.strideB; }
    const int tid = threadIdx.x, tx = tid & 15, ty = tid >> 4;
    const int ar = tid >> 2, ak = (tid & 3) * 4;
    const int bk = tid >> 4, bn = (tid & 15) * 4;
    int arow = m0 + ar; bool aval = arow < M;
    if (aval && a.a_rows) { int g = a.a_rows[arow]; aval = g >= 0; arow = g; }
    const float* Ap = a.A + (size_t)(aval ? arow : 0) * a.lda;
    const bool bval = (n0 + bn + 3) < a.N;
    float acc[4][4] = {}, acc2[4][4] = {};
    const bool dual = a.mode == 2;
    for (int k0 = 0; k0 < a.K; k0 += 16) {
        float4 av = aval ? *(const float4*)(Ap + k0 + ak) : make_float4(0, 0, 0, 0);
        float4 bv = bval ? *(const float4*)(Bp + (size_t)(k0 + bk) * a.ldb + n0 + bn) : make_float4(0, 0, 0, 0);
        float4 bv2 = make_float4(0, 0, 0, 0);
        if (dual) bv2 = bval ? *(const float4*)(B2p + (size_t)(k0 + bk) * a.ldb + n0 + bn) : make_float4(0, 0, 0, 0);
        __syncthreads();
        As[ak + 0][ar] = av.x; As[ak + 1][ar] = av.y; As[ak + 2][ar] = av.z; As[ak + 3][ar] = av.w;
        *(float4*)&Bs[bk][bn] = bv; if (dual) *(float4*)&Bs2[bk][bn] = bv2;
        __syncthreads();
#pragma unroll
        for (int kk = 0; kk < 16; ++kk) {
            float4 a4 = *(const float4*)&As[kk][ty * 4]; float4 b4 = *(const float4*)&Bs[kk][tx * 4];
            float aa[4] = {a4.x, a4.y, a4.z, a4.w}, bb[4] = {b4.x, b4.y, b4.z, b4.w};
#pragma unroll
            for (int i = 0; i < 4; ++i)
#pragma unroll
                for (int j = 0; j < 4; ++j) acc[i][j] = fmaf(aa[i], bb[j], acc[i][j]);
            if (dual) { float4 c4 = *(const float4*)&Bs2[kk][tx * 4]; float cc[4] = {c4.x, c4.y, c4.z, c4.w};
#pragma unroll
                for (int i = 0; i < 4; ++i)
#pragma unroll
                    for (int j = 0; j < 4; ++j) acc2[i][j] = fmaf(aa[i], cc[j], acc2[i][j]); }
        }
    }
#pragma unroll
    for (int i = 0; i < 4; ++i) {
        const int r = m0 + ty * 4 + i; if (r >= M) continue;
        const int c = n0 + tx * 4; if (c + 3 >= a.N) continue;
        float4 o = make_float4(acc[i][0], acc[i][1], acc[i][2], acc[i][3]);
        if (a.mode == 1) { float4 rr = *(const float4*)(a.R + (size_t)r * a.ldc + c); o.x += rr.x; o.y += rr.y; o.z += rr.z; o.w += rr.w; }
        if (a.mode == 2) { o.x = siluf(o.x) * acc2[i][0]; o.y = siluf(o.y) * acc2[i][1]; o.z = siluf(o.z) * acc2[i][2]; o.w = siluf(o.w) * acc2[i][3]; }
        if (a.mode == 3) { int cr = a.c_rows[r]; if (cr < 0) continue; float w = a.roww[r]; float* dst = a.C + (size_t)(cr >> 1) * a.ldc + c;
            atomicAdd(dst + 0, w * o.x); atomicAdd(dst + 1, w * o.y); atomicAdd(dst + 2, w * o.z); atomicAdd(dst + 3, w * o.w); continue; }
        *(float4*)(a.C + (size_t)r * a.ldc + c) = o;
    }
}
__global__ void __launch_bounds__(128) k_hgrn(const float* __restrict__ u, const float* __restrict__ lb, float* __restrict__ oraw) {
    __shared__ float qs[16][128], fs[16][128], ks[16][128];
    const int b = blockIdx.x / HGH, h = blockIdx.x % HGH, v = threadIdx.x;
    float Sr[128];
#pragma unroll
    for (int k = 0; k < 128; ++k) Sr[k] = 0.f;
    const float lbv = lb[h * HGD + v];
    for (int t0 = 0; t0 < S; t0 += 16) {
        __syncthreads();
        for (int i = 0; i < 16; ++i) {
            const float* ur = u + (size_t)(b * S + t0 + i) * INC + h * HGD + v;
            const float qr = ur[0], fr = ur[HGW];
            const float f = lbv + (1.f - lbv) * sigm(fr);
            qs[i][v] = siluf(qr); fs[i][v] = f; ks[i][v] = 1.f - f;
        }
        __syncthreads();
        for (int i = 0; i < 16; ++i) {
            const float iv = u[(size_t)(b * S + t0 + i) * INC + 2 * HGW + h * HGD + v];
            float o = 0.f;
#pragma unroll
            for (int k = 0; k < 128; ++k) { Sr[k] = fmaf(fs[i][k], Sr[k], ks[i][k] * iv); o = fmaf(qs[i][k], Sr[k], o); }
            oraw[(size_t)(b * S + t0 + i) * D + h * HGD + v] = o;
        }
    }
}
__global__ void k_hnorm(const float* oraw, const float* __restrict__ u, const float* __restrict__ gain, float* mix) {
    int w = (int)((blockIdx.x * (size_t)blockDim.x + threadIdx.x) >> 6), lane = threadIdx.x & 63;
    if (w >= T * HGH) return;
    const int t = w / HGH, h = w % HGH;
    const float* orow = oraw + (size_t)t * D + h * HGD;
    float a = orow[lane], c = orow[lane + 64];
    float s = wsum(a * a + c * c); float r = rsqrtf(s * (1.f / HGD) + 1e-6f);
    const float* gr = u + (size_t)t * INC + 3 * HGW + h * HGD;
    mix[(size_t)t * D + h * HGD + lane] = a * r * gain[lane] * siluf(gr[lane]);
    mix[(size_t)t * D + h * HGD + lane + 64] = c * r * gain[lane + 64] * siluf(gr[lane + 64]);
}
__global__ void k_cum(const float* __restrict__ u, const float* __restrict__ fbias, float* __restrict__ cum) {
    int i = blockIdx.x * blockDim.x + threadIdx.x; if (i >= NB * FXH) return;
    const int b = i / FXH, h = i % FXH; double acc = 0.0; const float bias = fbias[h];
    for (int s = 0; s < S; ++s) { float z = u[(size_t)(b * S + s) * INC + 3584 + h] + bias;
        float ls = fminf(z, 0.f) - log1pf(expf(-fabsf(z))); acc += (double)ls; cum[(size_t)(b * S + s) * FXH + h] = (float)acc; }
}
__global__ void __launch_bounds__(64) k_attn(const float* __restrict__ u, const float* __restrict__ cum, const float* __restrict__ gain, float* __restrict__ mix) {
    __shared__ float Ks[64][64], Vs[64][64], Cs[64];
    const int qt = blockIdx.x % (S / 64), bh = blockIdx.x / (S / 64), h = bh % FXH, b = bh / FXH, lane = threadIdx.x;
    const int t = qt * 64 + lane;
    float q[64], o[64];
    const float* qrow = u + (size_t)(b * S + t) * INC + 2048 + h * FXD;
#pragma unroll
    for (int d = 0; d < 64; ++d) { q[d] = qrow[d] * 0.125f; o[d] = 0.f; }
    const float ct = cum[(size_t)(b * S + t) * FXH + h];
    float m = -1e30f, l = 0.f;
    for (int kt = 0; kt <= qt; ++kt) {
        __syncthreads();
        for (int i = 0; i < 64; ++i) { const float* kr = u + (size_t)(b * S + kt * 64 + i) * INC + 2048 + FXW + h * FXD; Ks[i][lane] = kr[lane]; Vs[i][lane] = kr[FXW + lane]; }
        Cs[lane] = cum[(size_t)(b * S + kt * 64 + lane) * FXH + h];
        __syncthreads();
        for (int s = 0; s < 64; ++s) {
            float x = 0.f;
#pragma unroll
            for (int d = 0; d < 64; ++d) x = fmaf(q[d], Ks[s][d], x);
            x += ct - Cs[s];
            const bool ok = (kt * 64 + s) <= t;
            if (!ok) x = -1e30f;
            const float mn = fmaxf(m, x); const float al = expf(m - mn); const float p = ok ? expf(x - mn) : 0.f;
            l = l * al + p; m = mn;
#pragma unroll
            for (int d = 0; d < 64; ++d) o[d] = fmaf(o[d], al, p * Vs[s][d]);
        }
    }
    float ss = 0.f; const float il = 1.f / l;
#pragma unroll
    for (int d = 0; d < 64; ++d) { o[d] *= il; ss += o[d] * o[d]; }
    const float r = rsqrtf(ss * (1.f / FXD) + 1e-6f);
    float* orow = mix + (size_t)(b * S + t) * D + HGW + h * FXD;
#pragma unroll
    for (int d = 0; d < 64; ++d) orow[d] = o[d] * r * gain[d];
}
__global__ void k_route(const float* __restrict__ h1, const float* __restrict__ gain, const float* __restrict__ wg, const float* __restrict__ bg,
                        const float* __restrict__ we, const float* __restrict__ be, float* __restrict__ xn2, int* __restrict__ re, float* __restrict__ rw) {
    int w = (int)((blockIdx.x * (size_t)blockDim.x + threadIdx.x) >> 6), lane = threadIdx.x & 63;
    if (w >= T) return;
    const float4* xr = (const float4*)(h1 + (size_t)w * D); const float4* gr = (const float4*)gain; float4* yr = (float4*)(xn2 + (size_t)w * D);
    float4 v[4]; float s = 0.f;
#pragma unroll
    for (int j = 0; j < 4; ++j) { v[j] = xr[lane + 64 * j]; s += v[j].x * v[j].x + v[j].y * v[j].y + v[j].z * v[j].z + v[j].w * v[j].w; }
    s = wsum(s); const float r = rsqrtf(s * (1.f / D) + 1e-6f);
    float lg[20];
#pragma unroll
    for (int i = 0; i < 20; ++i) lg[i] = 0.f;
#pragma unroll
    for (int j = 0; j < 4; ++j) { float4 gg = gr[lane + 64 * j]; float4 o; o.x = v[j].x * r * gg.x; o.y = v[j].y * r * gg.y; o.z = v[j].z * r * gg.z; o.w = v[j].w * r * gg.w; yr[lane + 64 * j] = o;
        const float tv[4] = {o.x, o.y, o.z, o.w};
#pragma unroll
        for (int c = 0; c < 4; ++c) { const int d = (lane + 64 * j) * 4 + c; const float4 g4 = *(const float4*)(wg + (size_t)d * 4);
            lg[0] = fmaf(tv[c], g4.x, lg[0]); lg[1] = fmaf(tv[c], g4.y, lg[1]); lg[2] = fmaf(tv[c], g4.z, lg[2]); lg[3] = fmaf(tv[c], g4.w, lg[3]);
#pragma unroll
            for (int q = 0; q < 4; ++q) { const float4 e4 = *(const float4*)(we + (size_t)d * 16 + q * 4);
                lg[4 + q * 4 + 0] = fmaf(tv[c], e4.x, lg[4 + q * 4 + 0]); lg[4 + q * 4 + 1] = fmaf(tv[c], e4.y, lg[4 + q * 4 + 1]);
                lg[4 + q * 4 + 2] = fmaf(tv[c], e4.z, lg[4 + q * 4 + 2]); lg[4 + q * 4 + 3] = fmaf(tv[c], e4.w, lg[4 + q * 4 + 3]); } } }
#pragma unroll
    for (int i = 0; i < 20; ++i) lg[i] = wsum(lg[i]);
    if (lane == 0) {
        float g[4]; int gs = 0; float gm;
#pragma unroll
        for (int i = 0; i < 4; ++i) g[i] = lg[i] + bg[i];
        gm = g[0];
#pragma unroll
        for (int i = 1; i < 4; ++i) if (g[i] > gm) { gm = g[i]; gs = i; }
        float den = 0.f;
#pragma unroll
        for (int i = 0; i < 4; ++i) den += expf(g[i] - gm);
        const float pg = 1.f / den;
        float e[4];
#pragma unroll
        for (int i = 0; i < 4; ++i) { float x = 0.f;
#pragma unroll
            for (int q = 0; q < 4; ++q) if (q == gs) x = lg[4 + q * 4 + i] + be[q * 4 + i];
            e[i] = x; }
        int i0 = 0; float e0v = e[0];
#pragma unroll
        for (int i = 1; i < 4; ++i) if (e[i] > e0v) { e0v = e[i]; i0 = i; }
        int i1 = -1; float e1v = -3.0e38f;
#pragma unroll
        for (int i = 0; i < 4; ++i) if (i != i0 && e[i] > e1v) { e1v = e[i]; i1 = i; }
        const float p1r = expf(e1v - e0v); const float w0 = 1.f / (1.f + p1r), w1 = p1r / (1.f + p1r);
        re[w] = (gs * 4 + i0) | ((gs * 4 + i1) << 8);
        rw[w * 2 + 0] = pg * w0; rw[w * 2 + 1] = pg * w1;
    }
}
__global__ void k_assign(const int* __restrict__ re, int* __restrict__ ctl, int* __restrict__ entry) {
    int t = blockIdx.x * blockDim.x + threadIdx.x; if (t >= T) return;
    const int r = re[t];
#pragma unroll
    for (int k = 0; k < 2; ++k) { const int e = (r >> (8 * k)) & 0xff; const int pos = atomicAdd(&ctl[e], 1); entry[(size_t)e * T + pos] = t * 2 + k; }
}
__global__ void k_plan(int* __restrict__ ctl, int* __restrict__ tile_e) {
    if (threadIdx.x == 0 && blockIdx.x == 0) { int base = 0;
        for (int e = 0; e < NE; ++e) { ctl[16 + e] = base; const int nt = (ctl[e] + 255) >> 8; for (int i = 0; i < nt; ++i) tile_e[(base >> 8) + i] = e; base += nt * 256; }
        ctl[32] = base; ctl[33] = base; }
}
__global__ void k_fill(const int* __restrict__ ctl, const int* __restrict__ entry, const float* __restrict__ rw, int* __restrict__ srow, float* __restrict__ sw) {
    int r = blockIdx.x * blockDim.x + threadIdx.x; if (r >= RMAX) return;
    if (r >= ctl[32]) { srow[r] = -1; sw[r] = 0.f; return; }
    int e = 0;
#pragma unroll
    for (int i = 1; i < NE; ++i) if (r >= ctl[16 + i]) e = i;
    const int pos = r - ctl[16 + e];
    if (pos < ctl[e]) { const int tk = entry[(size_t)e * T + pos]; srow[r] = tk; sw[r] = rw[tk]; } else { srow[r] = -1; sw[r] = 0.f; }
}
__global__ void k_srow_tok(const int* __restrict__ srow, int* __restrict__ stok) {
    int r = blockIdx.x * blockDim.x + threadIdx.x; if (r >= RMAX) return; const int v = srow[r]; stok[r] = v < 0 ? -1 : (v >> 1);
}
__global__ void k_final(const float* __restrict__ h1, const float* y, const float* __restrict__ g, float* out) {
    int w = (int)((blockIdx.x * (size_t)blockDim.x + threadIdx.x) >> 6), lane = threadIdx.x & 63;
    if (w >= T) return;
    const float4* xr = (const float4*)(h1 + (size_t)w * D); const float4* y4 = (const float4*)(y + (size_t)w * D); const float4* gr = (const float4*)g; float4* yr = (float4*)(out + (size_t)w * D);
    float4 v[4]; float s = 0.f;
#pragma unroll
    for (int j = 0; j < 4; ++j) { v[j] = xr[lane + 64 * j]; float4 yy = y4[lane + 64 * j]; v[j].x += yy.x; v[j].y += yy.y; v[j].z += yy.z; v[j].w += yy.w; s += v[j].x * v[j].x + v[j].y * v[j].y + v[j].z * v[j].z + v[j].w * v[j].w; }
    s = wsum(s); const float r = rsqrtf(s * (1.f / D) + 1e-6f);
#pragma unroll
    for (int j = 0; j < 4; ++j) { float4 gg = gr[lane + 64 * j]; float4 o; o.x = v[j].x * r * gg.x; o.y = v[j].y * r * gg.y; o.z = v[j].z * r * gg.z; o.w = v[j].w * r * gg.w; yr[lane + 64 * j] = o; }
}
}

extern "C" void kernel_launch(void* const* d_in, const int* in_sizes, int n_in, void* d_out, int out_size, void* d_ws, size_t ws_size, hipStream_t stream) {
    using namespace nv;
    const float* x = (const float*)d_in[0]; const float* attn_norm = (const float*)d_in[1]; const float* w_in = (const float*)d_in[2];
    const float* lb_logits = (const float*)d_in[3]; const float* hg_norm = (const float*)d_in[4]; const float* fbias = (const float*)d_in[5];
    const float* fox_norm = (const float*)d_in[6]; const float* w_out = (const float*)d_in[7]; const float* ffn_norm = (const float*)d_in[8];
    const float* w_group = (const float*)d_in[9]; const float* b_group = (const float*)d_in[10]; const float* w_expert = (const float*)d_in[11];
    const float* b_expert = (const float*)d_in[12]; const float* w_gate = (const float*)d_in[13]; const float* w_up = (const float*)d_in[14];
    const float* w_down = (const float*)d_in[15]; const float* final_norm = (const float*)d_in[16];
    char* ws = (char*)d_ws; const size_t MiB = 1u << 20;
    float* out = (float*)d_out;
    float* U = (float*)ws; float* LB = (float*)(ws + 898 * MiB); float* CUM = (float*)(ws + 899 * MiB);
    float* H1 = (float*)ws; float* XN2 = (float*)(ws + 256 * MiB);
    int* RE = (int*)(ws + 512 * MiB); float* RW = (float*)(ws + 513 * MiB); int* CTL = (int*)(ws + 514 * MiB); int* ENTRY = (int*)(ws + 515 * MiB);
    int* SROW = (int*)(ws + 520 * MiB); float* SW = (float*)(ws + 521 * MiB); int* STOK = (int*)(ws + 522 * MiB); int* TILE_E = (int*)(ws + 523 * MiB);
    float* HB = (float*)(ws + 528 * MiB);
    float* XN = out; float* MIX = out; float* Y = out;
    k_lb<<<2, 256, 0, stream>>>(lb_logits, LB);
    k_rms<<<T / 4, 256, 0, stream>>>(x, attn_norm, XN, T);
    { GemmArgs a{}; a.A = XN; a.lda = D; a.B = w_in; a.ldb = INC; a.C = U; a.ldc = INC; a.M = T; a.N = INC; a.K = D; a.mode = 0;
      k_gemm<<<dim3((INC + 63) / 64, T / 64), 256, 0, stream>>>(a); }
    k_cum<<<1, 256, 0, stream>>>(U, fbias, CUM);
    k_hgrn<<<NB * HGH, 128, 0, stream>>>(U, LB, MIX);
    k_hnorm<<<T * HGH / 4, 256, 0, stream>>>(MIX, U, hg_norm, MIX);
    k_attn<<<NB * FXH * (S / 64), 64, 0, stream>>>(U, CUM, fox_norm, MIX);
    { GemmArgs a{}; a.A = MIX; a.lda = D; a.B = w_out; a.ldb = D; a.C = H1; a.ldc = D; a.R = x; a.M = T; a.N = D; a.K = D; a.mode = 1;
      k_gemm<<<dim3(D / 64, T / 64), 256, 0, stream>>>(a); }
    k_route<<<T / 4, 256, 0, stream>>>(H1, ffn_norm, w_group, b_group, w_expert, b_expert, XN2, RE, RW);
    (void)hipMemsetAsync(CTL, 0, 4096, stream);
    k_assign<<<T / 256, 256, 0, stream>>>(RE, CTL, ENTRY);
    k_plan<<<1, 64, 0, stream>>>(CTL, TILE_E);
    k_fill<<<(RMAX + 255) / 256, 256, 0, stream>>>(CTL, ENTRY, RW, SROW, SW);
    k_srow_tok<<<(RMAX + 255) / 256, 256, 0, stream>>>(SROW, STOK);
    { GemmArgs a{}; a.A = XN2; a.lda = D; a.a_rows = STOK; a.B = w_gate; a.B2 = w_up; a.ldb = EH; a.tile_e = TILE_E; a.strideB = (size_t)D * EH;
      a.C = HB; a.ldc = EH; a.Mdev = CTL + 32; a.M = RMAX; a.N = EH; a.K = D; a.mode = 2;
      k_gemm<<<dim3(EH / 64, RMAX / 64), 256, 0, stream>>>(a); }
    (void)hipMemsetAsync(Y, 0, (size_t)T * D * 4, stream);
    { GemmArgs a{}; a.A = HB; a.lda = EH; a.B = w_down; a.ldb = D; a.tile_e = TILE_E; a.strideB = (size_t)EH * D;
      a.C = Y; a.ldc = D; a.c_rows = SROW; a.roww = SW; a.Mdev = CTL + 32; a.M = RMAX; a.N = D; a.K = EH; a.mode = 3;
      k_gemm<<<dim3(D / 64, RMAX / 64), 256, 0, stream>>>(a); }
    k_final<<<T / 4, 256, 0, stream>>>(H1, Y, final_norm, out);
}
```

```cpp
#include <hip/hip_runtime.h>
#include <hip/hip_bf16.h>
#include <cstdio>
#include <cstdint>
#include <cmath>
#ifndef MK_OPT_MASK
#define MK_OPT_MASK 0xFF
#endif
namespace pg8 {
#define PG8_LAS __attribute__((address_space(3)))
typedef unsigned short bf16_t;
typedef short bf16x8 __attribute__((ext_vector_type(8)));
typedef float f32x4 __attribute__((ext_vector_type(4)));
typedef unsigned u32x4 __attribute__((ext_vector_type(4)));
constexpr int BM = 256, BK = 64, HALF = 128, HTB = HALF * BK * 2  , STAGE_BYTES = 8 * HTB, NXCD = 8, WGM = 8;

__host__ __device__ __forceinline__ int lds_byte(int r, int c) { const int st = (r >> 4) * 2 + (c >> 5), rr = r & 15, cc = c & 31, ob = rr * 64 + cc * 2; return st * 1024 + (ob ^ (((ob >> 9) & 1) << 5)); }
__host__ __device__ __forceinline__ void stage_rc(int b, int& R, int& C) { const int st = b / 1024, sb = b % 1024, swz = sb ^ (((sb >> 9) & 1) << 5); R = (st >> 1) * 16 + swz / 64; C = (st & 1) * 32 + (swz % 64) / 2; }
__host__ __device__ __forceinline__ int perm32(int rho) { const int n = rho >> 4, i = rho & 15; return 8 * (i >> 2) + 4 * n + (i & 3); }

struct Unit { int pm, pn; };
struct Gemm { const bf16_t* A; const bf16_t* Bt; int M, N, K; };

struct StaticOrder {
    int nM, nN, nwg, G, c;
    __host__ __device__ void init(int M, int N, int G_, int c_) { nM = M / BM; nN = N / BM; nwg = nM * nN; G = G_; c = c_; }
    __host__ __device__ bool next(int i, Unit& u) const {
        const long L = (long)i * G + c; if (L >= nwg) return false;
        int wgid = (int)L; { const int q = nwg / NXCD, r = nwg % NXCD, xcd = wgid % NXCD, off = wgid / NXCD; wgid = (xcd < r ? xcd * (q + 1) : r * (q + 1) + (xcd - r) * q) + off; }
        const int nig = WGM * nN, gid = wgid / nig, fm = gid * WGM, gsz = (nM - fm) < WGM ? (nM - fm) : WGM;
        u.pm = fm + ((wgid % nig) % gsz); u.pn = (wgid % nig) / gsz; return true;
    }
    __device__ __forceinline__ void a_ready(const Unit&) const {}
    __device__ __forceinline__ void done(const Unit&) const {}
};

__device__ __forceinline__ unsigned cvt_pk_bf16(float lo, float hi) { unsigned r; asm volatile("v_cvt_pk_bf16_f32 %0, %1, %2" : "=v"(r) : "v"(lo), "v"(hi)); return r; }
typedef float f32x2 __attribute__((ext_vector_type(2)));
__device__ __forceinline__ f32x2 gelu_pk(f32x2 v) {
    const f32x2 av = __builtin_elementwise_abs(v), d = av * 0.2316418882f + 1.0f;
    f32x2 t; t.x = __builtin_amdgcn_rcpf(d.x); t.y = __builtin_amdgcn_rcpf(d.y);
    f32x2 q = t * 0.5307027145f + (-0.7265760135f); q = q * t + 0.7107068705f; q = q * t + (-0.142248368f); q = q * t + 0.127414796f; q = q * t;
    const f32x2 s = (v * v) * (-0.72134752044f);
    f32x2 e; e.x = __builtin_amdgcn_exp2f(s.x); e.y = __builtin_amdgcn_exp2f(s.y);
    const f32x2 m = v * (q * e), r = v - m;
    f32x2 o; o.x = v.x < 0.f ? m.x : r.x; o.y = v.y < 0.f ? m.y : r.y; return o;
}

template <int ACT  > struct EpiBf16 {
    static constexpr bool PERM = true, AFTER_DRAIN = false; static_assert(ACT == 0 || ACT == 1, "EpiBf16: ACT is 0 (none) or 1 (gelu_pk)");
    bf16_t* O; int ldc; const float* bias; int split_cols; size_t split_stride; float scale0;
    __device__ __forceinline__ void operator()(const f32x4 (&acc)[2][2][4][2], const Unit& u, int wr, int wc, int fr, int fq) const {
        const int row0 = u.pm * BM + wr * 64 + fr; int colt = u.pn * BM; bf16_t* base = O;
        float sc = 1.f; if (split_cols) { const int t = colt / split_cols; base += (size_t)t * split_stride; colt -= t * split_cols; if (t == 0) sc = scale0; }
        const int col0 = colt + wc * 32 + 8 * fq, bcol0 = u.pn * BM + wc * 32 + 8 * fq;
        f32x4 bv[2][2];
#pragma unroll
        for (int bj = 0; bj < 2; ++bj)
#pragma unroll
            for (int n = 0; n < 2; ++n) bv[bj][n] = bias ? *(const f32x4*)(bias + bcol0 + bj * HALF + 4 * n) : (f32x4){0.f, 0.f, 0.f, 0.f};
#pragma unroll
        for (int ai = 0; ai < 2; ++ai)
#pragma unroll
            for (int m = 0; m < 4; ++m) { bf16_t* rowp = base + (size_t)(row0 + ai * HALF + m * 16) * ldc + col0;
#pragma unroll
                for (int bj = 0; bj < 2; ++bj) { f32x4 v0 = acc[ai][bj][m][0] + bv[bj][0], v1 = acc[ai][bj][m][1] + bv[bj][1];
                    if (ACT == 1) { f32x2 a = gelu_pk((f32x2){v0[0], v0[1]}), b = gelu_pk((f32x2){v0[2], v0[3]}), c = gelu_pk((f32x2){v1[0], v1[1]}), d = gelu_pk((f32x2){v1[2], v1[3]});
                        v0 = (f32x4){a.x, a.y, b.x, b.y}; v1 = (f32x4){c.x, c.y, d.x, d.y}; }
                    v0 = v0 * sc; v1 = v1 * sc; u32x4 w; w.x = cvt_pk_bf16(v0[0], v0[1]); w.y = cvt_pk_bf16(v0[2], v0[3]); w.z = cvt_pk_bf16(v1[0], v1[1]); w.w = cvt_pk_bf16(v1[2], v1[3]);
                    *(u32x4*)(rowp + bj * HALF) = w; } }
    }
};

struct PanelStats {
    unsigned* xbuf;
    unsigned* cnt;
    unsigned* tmo;
    int ntn; float eps;
    unsigned code;
    __device__ __forceinline__ bool run(const f32x4 (&v)[2][2][4][2], const Unit& u, int wr, int wc, int fr, int fq, PG8_LAS unsigned char* lds, int wid, int lane) const {
        typedef float f32x2v __attribute__((ext_vector_type(2)));
        PG8_LAS f32x2v* P = (PG8_LAS f32x2v*)lds;
        PG8_LAS f32x2v* S = (PG8_LAS f32x2v*)(lds + 8192);
        PG8_LAS unsigned* flag = (PG8_LAS unsigned*)(lds + 8192 + 2048);
#pragma unroll
        for (int ai = 0; ai < 2; ++ai)
#pragma unroll
            for (int m = 0; m < 4; ++m) {
                float s = 0.f;
#pragma unroll
                for (int bj = 0; bj < 2; ++bj)
#pragma unroll
                    for (int n = 0; n < 2; ++n) { const f32x4 x = v[ai][bj][m][n]; s += (x[0] + x[1]) + (x[2] + x[3]); }
                s += __shfl_xor(s, 16); s += __shfl_xor(s, 32);
                const float mw = s * (1.0f / 64.0f); float q = 0.f;
#pragma unroll
                for (int bj = 0; bj < 2; ++bj)
#pragma unroll
                    for (int n = 0; n < 2; ++n) { const f32x4 d = v[ai][bj][m][n] - mw; q += (d[0] * d[0] + d[1] * d[1]) + (d[2] * d[2] + d[3] * d[3]); }
                q += __shfl_xor(q, 16); q += __shfl_xor(q, 32);
                if (fq == 0) P[(ai * HALF + wr * 64 + m * 16 + fr) * 4 + wc] = (f32x2v){mw, q};
            }
        asm volatile("s_waitcnt lgkmcnt(0)" ::: "memory"); __builtin_amdgcn_s_barrier(); asm volatile("" ::: "memory");
#if defined(BROKEN_EXCHANGE_NO_WAIT)
#warning BROKEN CONTROL BUILD: the row-statistics exchange does not wait; results are wrong by design
        if (blockIdx.x >= 64) { const long long t0_ = clock64(); while (clock64() - t0_ < 60000) __builtin_amdgcn_s_sleep(8); }
#endif
        const int row = wid * 32 + (lane & 31);
        if (lane < 32) {
            const f32x2v a = P[row * 4 + 0], b = P[row * 4 + 1], c = P[row * 4 + 2], d = P[row * 4 + 3];
            const float mt = (a.x + b.x + c.x + d.x) * 0.25f;
            const float da = a.x - mt, db = b.x - mt, dc = c.x - mt, dd = d.x - mt;
            const float m2 = (a.y + b.y) + (c.y + d.y) + 64.0f * ((da * da + db * db) + (dc * dc + dd * dd));
            unsigned long long* slot = (unsigned long long*)xbuf + ((size_t)(u.pm * BM + row) * 4 + u.pn);
            __hip_atomic_store(slot, ((unsigned long long)__float_as_uint(m2) << 32) | __float_as_uint(mt), __ATOMIC_RELAXED, __HIP_MEMORY_SCOPE_AGENT);
        }
        asm volatile("s_waitcnt vmcnt(0)" ::: "memory");
        if (lane == 0) __hip_atomic_fetch_add(cnt + 64 * u.pm, 1u, __ATOMIC_RELAXED, __HIP_MEMORY_SCOPE_AGENT);
        if (wid == 0) {
            bool dead = false; const unsigned long long t0 = __builtin_amdgcn_s_memrealtime(); const unsigned want = 8u * (unsigned)ntn;
            for (;;) {
#if defined(BROKEN_EXCHANGE_NO_WAIT)
                break;
#endif
                if ((unsigned)__builtin_amdgcn_readfirstlane(__hip_atomic_load(cnt + 64 * u.pm, __ATOMIC_RELAXED, __HIP_MEMORY_SCOPE_AGENT)) >= want) break;
                if (__builtin_amdgcn_s_memrealtime() - t0 > 2000000ull) {
                    if (lane == 0) { unsigned expect = 0u; __hip_atomic_compare_exchange_strong(tmo + 1, &expect, code | (unsigned)(u.pm & 0xff), __ATOMIC_RELAXED, __ATOMIC_RELAXED, __HIP_MEMORY_SCOPE_AGENT);
                                     __hip_atomic_store(tmo, 1u, __ATOMIC_RELAXED, __HIP_MEMORY_SCOPE_AGENT); }
                    dead = true; break; }
                __builtin_amdgcn_s_sleep(2);
            }
            __builtin_amdgcn_fence(__ATOMIC_ACQUIRE, "agent");
            if (lane == 0) flag[0] = dead ? 1u : 0u;
        }
        asm volatile("s_waitcnt vmcnt(0) lgkmcnt(0)" ::: "memory"); __builtin_amdgcn_s_barrier(); asm volatile("" ::: "memory");
        const bool bad = flag[0] != 0u;
        if (lane < 32) {
            const unsigned long long* slot = (const unsigned long long*)xbuf + (size_t)(u.pm * BM + row) * 4; float mt[4], m2[4]; float ms = 0.f;
#pragma unroll
            for (int t = 0; t < 4; ++t) { if (t < ntn) { const unsigned long long w = __hip_atomic_load(slot + t, __ATOMIC_RELAXED, __HIP_MEMORY_SCOPE_AGENT); mt[t] = __uint_as_float((unsigned)w); m2[t] = __uint_as_float((unsigned)(w >> 32)); } else { mt[t] = 0.f; m2[t] = 0.f; } ms += mt[t]; }
            const float mean = ms / (float)ntn; float q = 0.f;
#pragma unroll
            for (int t = 0; t < 4; ++t) if (t < ntn) { const float dm = mt[t] - mean; q += m2[t] + 256.0f * dm * dm; }
            S[row] = (f32x2v){mean, 1.0f / sqrtf(q / (256.0f * (float)ntn) + eps)};
        }
        asm volatile("s_waitcnt lgkmcnt(0)" ::: "memory"); __builtin_amdgcn_s_barrier(); asm volatile("" ::: "memory");
        return bad;
    }
};
struct EpiLnRes {
    static constexpr bool PERM = false, AFTER_DRAIN = true;
    const float* base; float* out; int ldc; const float* bias; PanelStats st; unsigned poison;
    __device__ __forceinline__ void fused(f32x4 (&acc)[2][2][4][2], const Unit& u, int wr, int wc, int fr, int fq, PG8_LAS unsigned char* lds, int wid, int lane) const {
        typedef float f32x2v __attribute__((ext_vector_type(2)));
        const PG8_LAS f32x2v* S = (const PG8_LAS f32x2v*)(lds + 8192);
        const int col0 = u.pn * BM + wc * 32 + 4 * fq;
#pragma unroll
        for (int bj = 0; bj < 2; ++bj)
#pragma unroll
            for (int n = 0; n < 2; ++n) { const f32x4 bv = bias ? *(const f32x4*)(bias + col0 + bj * HALF + n * 16) : (f32x4){0.f, 0.f, 0.f, 0.f};
#pragma unroll
                for (int ai = 0; ai < 2; ++ai)
#pragma unroll
                    for (int m = 0; m < 4; ++m) acc[ai][bj][m][n] += bv; }
        f32x4 pre[4][2][2];
#pragma unroll
        for (int m = 0; m < 4; ++m) { const size_t off = (size_t)(u.pm * BM + wr * 64 + m * 16 + fr) * ldc + col0;
#pragma unroll
            for (int bj = 0; bj < 2; ++bj)
#pragma unroll
                for (int n = 0; n < 2; ++n) pre[m][bj][n] = *(const f32x4*)(base + off + bj * HALF + n * 16); }
        const bool bad = st.run(acc, u, wr, wc, fr, fq, lds, wid, lane) || poison != 0u;
        const float qnan = __builtin_nanf("");
#pragma unroll
        for (int ai = 0; ai < 2; ++ai)
#pragma unroll
            for (int m = 0; m < 4; ++m) { const int r = ai * HALF + wr * 64 + m * 16 + fr; const f32x2v sr = S[r]; const size_t off = (size_t)(u.pm * BM + r) * ldc + col0;
#pragma unroll
                for (int bj = 0; bj < 2; ++bj)
#pragma unroll
                    for (int n = 0; n < 2; ++n) { const f32x4 bs = ai == 0 ? pre[m][bj][n] : *(const f32x4*)(base + off + bj * HALF + n * 16); f32x4 o = bs + (acc[ai][bj][m][n] - sr.x) * sr.y;
                        if (bad) o = (f32x4){qnan, qnan, qnan, qnan}; *(f32x4*)(out + off + bj * HALF + n * 16) = o; }
                if (m & 1) asm volatile("" ::: "memory"); }
    }
};
struct EpiLnResLn {
    static constexpr bool PERM = false, AFTER_DRAIN = true;
    const float* base; float* out; bf16_t* xn; int ldc; const float* bias; PanelStats st1, st2; unsigned poison;
    __device__ __forceinline__ void fused(f32x4 (&acc)[2][2][4][2], const Unit& u, int wr, int wc, int fr, int fq, PG8_LAS unsigned char* lds, int wid, int lane) const {
        typedef float f32x2v __attribute__((ext_vector_type(2))); typedef unsigned u32x2v __attribute__((ext_vector_type(2)));
        const PG8_LAS f32x2v* S = (const PG8_LAS f32x2v*)(lds + 8192);
        const int col0 = u.pn * BM + wc * 32 + 4 * fq;
#pragma unroll
        for (int bj = 0; bj < 2; ++bj)
#pragma unroll
            for (int n = 0; n < 2; ++n) { const f32x4 bv = bias ? *(const f32x4*)(bias + col0 + bj * HALF + n * 16) : (f32x4){0.f, 0.f, 0.f, 0.f};
#pragma unroll
                for (int ai = 0; ai < 2; ++ai)
#pragma unroll
                    for (int m = 0; m < 4; ++m) acc[ai][bj][m][n] += bv; }
        bool bad = st1.run(acc, u, wr, wc, fr, fq, lds, wid, lane) || poison != 0u;
        const float qnan = __builtin_nanf("");
#pragma unroll
        for (int ai = 0; ai < 2; ++ai)
#pragma unroll
            for (int m = 0; m < 4; ++m) { const int r = ai * HALF + wr * 64 + m * 16 + fr; const f32x2v sr = S[r]; const size_t off = (size_t)(u.pm * BM + r) * ldc + col0;
#pragma unroll
                for (int bj = 0; bj < 2; ++bj)
#pragma unroll
                    for (int n = 0; n < 2; ++n) { const f32x4 bs = *(const f32x4*)(base + off + bj * HALF + n * 16); acc[ai][bj][m][n] = bs + (acc[ai][bj][m][n] - sr.x) * sr.y; }
                asm volatile("" : "+v"(acc[ai][0][m][0]), "+v"(acc[ai][0][m][1]), "+v"(acc[ai][1][m][0]), "+v"(acc[ai][1][m][1]));
                if (m & 1) asm volatile("" ::: "memory"); }
        const bool bad1 = bad;
        bad = st2.run(acc, u, wr, wc, fr, fq, lds, wid, lane) || bad;
#pragma unroll
        for (int ai = 0; ai < 2; ++ai)
#pragma unroll
            for (int m = 0; m < 4; ++m) { const int r = ai * HALF + wr * 64 + m * 16 + fr; const f32x2v sr = S[r]; const size_t off = (size_t)(u.pm * BM + r) * ldc + col0;
#pragma unroll
                for (int bj = 0; bj < 2; ++bj)
#pragma unroll
                    for (int n = 0; n < 2; ++n) { const f32x4 x1 = acc[ai][bj][m][n]; *(f32x4*)(out + off + bj * HALF + n * 16) = bad1 ? (f32x4){qnan, qnan, qnan, qnan} : x1;
                        const f32x4 o = (x1 - sr.x) * sr.y; u32x2v w; w.x = cvt_pk_bf16(o[0], o[1]); w.y = cvt_pk_bf16(o[2], o[3]);
                        if (bad) { w.x = 0x7fc07fc0u; w.y = 0x7fc07fc0u; } *(u32x2v*)(xn + off + bj * HALF + n * 16) = w; }
                asm volatile("" ::: "memory"); }
    }
};

template <class Epi, class Sched, bool ALIGN_EPI = false, bool SP2 = false>
__device__ __forceinline__ void gemm_phase(PG8_LAS unsigned char* lds, const Gemm g, const Sched& S, const Epi& E) {
    const int tid = threadIdx.x, wid = __builtin_amdgcn_readfirstlane(tid >> 6), lane = tid & 63, wr = wid >> 2, wc = wid & 3, fr = lane & 15, fq = lane >> 4;
    const int K = g.K, nt = K / BK;
    unsigned voffA[2], voffB[2];
#pragma unroll
    for (int i = 0; i < 2; ++i) { int R, C; stage_rc(tid * 16 + i * 8192, R, C); const int Rb = Epi::PERM ? ((R & ~31) + perm32(R & 31)) : R;
        voffA[i] = (unsigned)(R * K + C) * 2u; voffB[i] = (unsigned)(Rb * K + C) * 2u; }
    const size_t kstep = (size_t)(BK * 2);
    const size_t hstep = (size_t)HALF * K * 2;
    const size_t tstep = 2 * hstep;
    const unsigned ldsw = (unsigned)wid * 1024u;
    const int aoff = lds_byte(wr * 64 + fr, fq * 8), boff = lds_byte(wc * 32 + fr, fq * 8);
#define PG8_SA(b, h) (((b) * 2 + (h)) * HTB)
#define PG8_SB(b, h) ((4 + (b) * 2 + (h)) * HTB)
#define PG8_STAGE(bufoff, gbase, voff) do { _Pragma("unroll") for (int _i = 0; _i < 2; ++_i) \
        __builtin_amdgcn_global_load_lds((const unsigned*)((const char*)(gbase) + (voff)[_i]), (PG8_LAS unsigned*)(lds + (bufoff) + ldsw + _i * 8192), 16, 0, 0); } while (0)
#define PG8_LDA(dst, b, h) do { _Pragma("unroll") for (int m = 0; m < 4; ++m) _Pragma("unroll") for (int k = 0; k < 2; ++k) dst[m][k] = *(const PG8_LAS bf16x8*)(lds + PG8_SA(b, h) + aoff + m * 2048 + k * 1024); } while (0)
#define PG8_LDB(dst, b, h) do { _Pragma("unroll") for (int n = 0; n < 2; ++n) _Pragma("unroll") for (int k = 0; k < 2; ++k) dst[n][k] = *(const PG8_LAS bf16x8*)(lds + PG8_SB(b, h) + boff + n * 2048 + k * 1024); } while (0)
#define PG8_MMA(ai, bj, At, Bt) do { __builtin_amdgcn_s_setprio(1); _Pragma("unroll") for (int m = 0; m < 4; ++m) _Pragma("unroll") for (int n = 0; n < 2; ++n) _Pragma("unroll") for (int k = 0; k < 2; ++k) \
        acc[ai][bj][m][n] = __builtin_amdgcn_mfma_f32_16x16x32_bf16(Bt[n][k], At[m][k], acc[ai][bj][m][n], 0, 0, 0); __builtin_amdgcn_s_setprio(0); } while (0)
#define PG8_WAIT_V(n) asm volatile("s_waitcnt vmcnt(" #n ")" ::: "memory")
#define PG8_WAIT_L(n) asm volatile("s_waitcnt lgkmcnt(" #n ")" ::: "memory")
#define PG8_BAR __builtin_amdgcn_s_barrier()
#define PG8_SCHED __builtin_amdgcn_sched_barrier(0)
    Unit cur, nxt; int ui = 0;
    if (!S.next(0, cur)) return;
    f32x4 acc[2][2][4][2];
#pragma unroll
    for (int a = 0; a < 2; ++a)
#pragma unroll
        for (int b = 0; b < 2; ++b)
#pragma unroll
            for (int m = 0; m < 4; ++m)
#pragma unroll
                for (int n = 0; n < 2; ++n) acc[a][b][m][n] = (f32x4){0.f, 0.f, 0.f, 0.f};
    bf16x8 At[4][2], B0[2][2], B1[2][2];
    const char* cA = (const char*)g.A + (size_t)cur.pm * tstep; const char* cB = (const char*)g.Bt + (size_t)cur.pn * tstep;
    S.a_ready(cur);
    if constexpr (SP2) {
        PG8_STAGE(PG8_SB(0, 0), cB, voffB); PG8_STAGE(PG8_SB(0, 1), cB + hstep, voffB); PG8_STAGE(PG8_SA(0, 0), cA, voffA); PG8_STAGE(PG8_SA(0, 1), cA + hstep, voffA);
        if (wr == 1) PG8_BAR;
        PG8_WAIT_V(2); PG8_BAR;
        PG8_STAGE(PG8_SB(1, 0), cB + kstep, voffB); PG8_STAGE(PG8_SA(1, 0), cA + kstep, voffA); PG8_STAGE(PG8_SB(1, 1), cB + hstep + kstep, voffB);
        PG8_WAIT_V(6); PG8_BAR;
    } else {
        PG8_STAGE(PG8_SB(0, 0), cB, voffB); PG8_STAGE(PG8_SA(0, 0), cA, voffA); PG8_STAGE(PG8_SB(0, 1), cB + hstep, voffB); PG8_STAGE(PG8_SA(0, 1), cA + hstep, voffA);
        if (wr == 1) PG8_BAR;
        PG8_WAIT_V(4); PG8_BAR;
        PG8_STAGE(PG8_SB(1, 0), cB + kstep, voffB); PG8_STAGE(PG8_SA(1, 0), cA + kstep, voffA); PG8_STAGE(PG8_SB(1, 1), cB + hstep + kstep, voffB);
        PG8_WAIT_V(6); PG8_BAR;
    }
    for (;;) {
        const bool has_next = S.next(ui + 1, nxt);
        const char* nA = has_next ? (const char*)g.A + (size_t)nxt.pm * tstep : cA; const char* nB = has_next ? (const char*)g.Bt + (size_t)nxt.pn * tstep : cB;
        for (int t = 0; t < nt; t += 2) {
            const bool last = (t == nt - 2);
            const char* a1 = cA + (size_t)(t + 1) * kstep;
            const char* a2 = last ? nA : cA + (size_t)(t + 2) * kstep; const char* b2 = last ? nB : cB + (size_t)(t + 2) * kstep;
            const char* a3 = a2 + kstep; const char* b3 = b2 + kstep;
            if (last && has_next) S.a_ready(nxt);
            if constexpr (SP2) {
            PG8_LDB(B0, 0, 0); PG8_LDB(B1, 0, 1); PG8_SCHED; PG8_LDA(At, 0, 0); PG8_STAGE(PG8_SA(1, 1), a1 + hstep, voffA);
            PG8_WAIT_V(8); PG8_WAIT_L(0); PG8_BAR; PG8_MMA(0, 0, At, B0); PG8_MMA(0, 1, At, B1); PG8_BAR; PG8_SCHED;
            PG8_LDA(At, 0, 1); PG8_STAGE(PG8_SB(0, 0), b2, voffB); PG8_STAGE(PG8_SB(0, 1), b2 + hstep, voffB); PG8_STAGE(PG8_SA(0, 0), a2, voffA);
            PG8_WAIT_V(8); PG8_WAIT_L(0); PG8_BAR; PG8_MMA(1, 0, At, B0); PG8_MMA(1, 1, At, B1); PG8_BAR; PG8_SCHED;
            PG8_LDB(B0, 1, 0); PG8_LDB(B1, 1, 1); PG8_SCHED; PG8_LDA(At, 1, 0); PG8_STAGE(PG8_SA(0, 1), a2 + hstep, voffA);
            PG8_WAIT_V(8); PG8_WAIT_L(0); PG8_BAR; PG8_MMA(0, 0, At, B0); PG8_MMA(0, 1, At, B1); PG8_BAR; PG8_SCHED;
            PG8_LDA(At, 1, 1); PG8_STAGE(PG8_SB(1, 0), b3, voffB); PG8_STAGE(PG8_SB(1, 1), b3 + hstep, voffB); PG8_STAGE(PG8_SA(1, 0), a3, voffA);
            PG8_WAIT_V(8); PG8_WAIT_L(0); PG8_BAR; PG8_MMA(1, 0, At, B0); PG8_MMA(1, 1, At, B1); PG8_BAR; PG8_SCHED;
            } else {
            PG8_LDB(B0, 0, 0); PG8_SCHED; PG8_LDA(At, 0, 0); PG8_STAGE(PG8_SA(1, 1), a1 + hstep, voffA);
            PG8_WAIT_L(8); PG8_BAR; PG8_WAIT_L(0); PG8_MMA(0, 0, At, B0); PG8_BAR; PG8_SCHED;
            PG8_LDB(B1, 0, 1); PG8_STAGE(PG8_SB(0, 0), b2, voffB);
            PG8_BAR; PG8_WAIT_L(0); PG8_MMA(0, 1, At, B1); PG8_BAR;
            PG8_LDA(At, 0, 1); PG8_STAGE(PG8_SA(0, 0), a2, voffA);
            PG8_BAR; PG8_WAIT_L(0); PG8_MMA(1, 0, At, B0); PG8_BAR; PG8_SCHED;
            PG8_STAGE(PG8_SB(0, 1), b2 + hstep, voffB);
            PG8_WAIT_V(6); PG8_BAR; PG8_MMA(1, 1, At, B1); PG8_BAR;
            PG8_LDB(B0, 1, 0); PG8_SCHED; PG8_LDA(At, 1, 0); PG8_STAGE(PG8_SA(0, 1), a2 + hstep, voffA);
            PG8_WAIT_L(8); PG8_BAR; PG8_WAIT_L(0); PG8_MMA(0, 0, At, B0); PG8_BAR; PG8_SCHED;
            PG8_LDB(B1, 1, 1); PG8_STAGE(PG8_SB(1, 0), b3, voffB);
            PG8_BAR; PG8_WAIT_L(0); PG8_MMA(0, 1, At, B1); PG8_BAR;
            PG8_LDA(At, 1, 1); PG8_STAGE(PG8_SA(1, 0), a3, voffA);
            PG8_BAR; PG8_WAIT_L(0); PG8_MMA(1, 0, At, B0); PG8_BAR; PG8_SCHED;
            PG8_STAGE(PG8_SB(1, 1), b3 + hstep, voffB);
            PG8_WAIT_V(6); PG8_BAR; PG8_MMA(1, 1, At, B1); PG8_BAR;
            }
        }
        if constexpr (ALIGN_EPI) { if (wr == 0) PG8_BAR; }
        if constexpr (!Epi::AFTER_DRAIN) { E(acc, cur, wr, wc, fr, fq); S.done(cur); }
        if (!has_next) break;
#pragma unroll
        for (int a = 0; a < 2; ++a)
#pragma unroll
            for (int b = 0; b < 2; ++b)
#pragma unroll
                for (int m = 0; m < 4; ++m)
#pragma unroll
                    for (int n = 0; n < 2; ++n) acc[a][b][m][n] = (f32x4){0.f, 0.f, 0.f, 0.f};
        cur = nxt; cA = nA; cB = nB; ++ui;
        if constexpr (ALIGN_EPI) { if (wr == 1) PG8_BAR; }
    }
    PG8_WAIT_V(0);
    if constexpr (!ALIGN_EPI) { if (wr == 0) PG8_BAR; }
    PG8_BAR;
    if constexpr (Epi::AFTER_DRAIN) { E.fused(acc, cur, wr, wc, fr, fq, lds, wid, lane); S.done(cur); }
#undef PG8_SA
#undef PG8_SB
#undef PG8_STAGE
#undef PG8_LDA
#undef PG8_LDB
#undef PG8_MMA
#undef PG8_WAIT_V
#undef PG8_WAIT_L
#undef PG8_BAR
#undef PG8_SCHED
}
}
namespace pg8 {
#define PG8_LOG2E 1.4426950408889634f
__device__ __forceinline__ float fast_sigmoid(float x) { return __builtin_amdgcn_rcpf(1.0f + __builtin_amdgcn_exp2f(-x * PG8_LOG2E)); }
__device__ __forceinline__ float fast_silu(float x) { return x * fast_sigmoid(x); }
struct EpiU {
    static constexpr bool PERM = true, AFTER_DRAIN = false;
    bf16_t* O; int ldc; const float* lb; float qscale; int probe;
    long tab_off;
    template <int CTRL> static __device__ __forceinline__ float dmax(float v) { return fmaxf(v, __builtin_bit_cast(float, __builtin_amdgcn_update_dpp(0, __builtin_bit_cast(int, v), CTRL, 0xf, 0xf, true))); }
    __device__ __forceinline__ void operator()(const f32x4 (&acc)[2][2][4][2], const Unit& u, int wr, int wc, int fr, int fq) const {
        const int row0 = u.pm * BM + wr * 64 + fr; const int colt = u.pn * BM; const int col0 = colt + wc * 32 + 8 * fq;
        const int kind = (probe == 2) ? 2 : (u.pn >> 1);
        f32x4 lbv[2][2];
        if (kind == 1) {
#pragma unroll
            for (int bj = 0; bj < 2; ++bj)
#pragma unroll
                for (int n = 0; n < 2; ++n) lbv[bj][n] = *(const f32x4*)(lb + (col0 - 512) + bj * HALF + 4 * n);
        }
#pragma unroll
        for (int ai = 0; ai < 2; ++ai) { float mx0 = 0.f, mx1 = 0.f;
#pragma unroll
            for (int m = 0; m < 4; ++m) { bf16_t* rowp = O + (size_t)(row0 + ai * HALF + m * 16) * ldc + col0;
#pragma unroll
                for (int bj = 0; bj < 2; ++bj) { f32x4 v0 = acc[ai][bj][m][0], v1 = acc[ai][bj][m][1];
                    if (kind == 0 || kind == 3) {
#pragma unroll
                        for (int c = 0; c < 4; ++c) { v0[c] = fast_silu(v0[c]); v1[c] = fast_silu(v1[c]); }
                    } else if (kind == 1) {
#pragma unroll
                        for (int c = 0; c < 4; ++c) { const float l0 = lbv[bj][0][c], l1 = lbv[bj][1][c];
                            v0[c] = __builtin_amdgcn_logf(l0 + (1.f - l0) * fast_sigmoid(v0[c]));
                            v1[c] = __builtin_amdgcn_logf(l1 + (1.f - l1) * fast_sigmoid(v1[c])); }
                    } else if (kind == 4) { v0 = v0 * qscale; v1 = v1 * qscale; }
                    u32x4 w; w.x = cvt_pk_bf16(v0[0], v0[1]); w.y = cvt_pk_bf16(v0[2], v0[3]); w.z = cvt_pk_bf16(v1[0], v1[1]); w.w = cvt_pk_bf16(v1[2], v1[3]);
                    if (probe != 1) *(u32x4*)(rowp + bj * HALF) = w; else asm volatile("" :: "v"(w));
                    if (kind == 4 || kind == 5) { float ss = 0.f;
#pragma unroll
                        for (int e = 0; e < 4; ++e) { const unsigned ww = e == 0 ? w.x : (e == 1 ? w.y : (e == 2 ? w.z : w.w)); const float a0 = __builtin_bit_cast(float, ww << 16), a1 = __builtin_bit_cast(float, ww & 0xffff0000u); ss += a0 * a0 + a1 * a1; }
                        ss += __builtin_bit_cast(float, __builtin_amdgcn_ds_bpermute(((fq * 16 + fr) ^ 16) << 2, __builtin_bit_cast(int, ss)));
                        ss += __builtin_bit_cast(float, __builtin_amdgcn_ds_bpermute(((fq * 16 + fr) ^ 32) << 2, __builtin_bit_cast(int, ss)));
                        if (bj == 0) mx0 = fmaxf(mx0, ss); else mx1 = fmaxf(mx1, ss); } } }
            if (kind == 4 || kind == 5) {
#pragma unroll
                for (int bj = 0; bj < 2; ++bj) { float mx = bj == 0 ? mx0 : mx1;
                    mx = dmax<0xB1>(mx); mx = dmax<0x4E>(mx); mx = dmax<0x141>(mx); mx = dmax<0x140>(mx);
                    if ((fr | fq) == 0) { unsigned* ktab = (unsigned*)((char*)O + tab_off); unsigned* qtab = ktab + 256 * 2 * 32; const int bh = (u.pm >> 3) * 8 + (u.pn & 1) * 4 + 2 * bj + (wc >> 1), hf = wc & 1;
                        if (kind == 5) __hip_atomic_fetch_max(ktab + (bh * 2 + hf) * 32 + (u.pm & 7) * 4 + ai * 2 + wr, __builtin_bit_cast(unsigned, mx), __ATOMIC_RELAXED, __HIP_MEMORY_SCOPE_AGENT);
                        else __hip_atomic_fetch_max(qtab + (bh * 2 + hf) * 8 + (u.pm & 7), __builtin_bit_cast(unsigned, mx), __ATOMIC_RELAXED, __HIP_MEMORY_SCOPE_AGENT); } } } }
    }
};
struct EpiD {
    static constexpr bool PERM = true, AFTER_DRAIN = false;
    bf16_t* O; int ldc;
    __device__ __forceinline__ void operator()(const f32x4 (&acc)[2][2][4][2], const Unit& u, int wr, int wc, int fr, int fq) const {
        const int row0 = u.pm * BM + wr * 64 + fr; const int col0 = u.pn * BM + wc * 32 + 8 * fq;
#pragma unroll
        for (int ai = 0; ai < 2; ++ai)
#pragma unroll
            for (int m = 0; m < 4; ++m) { bf16_t* rowp = O + (size_t)(row0 + ai * HALF + m * 16) * ldc + col0;
#pragma unroll
                for (int bj = 0; bj < 2; ++bj) { const f32x4 v0 = acc[ai][bj][m][0], v1 = acc[ai][bj][m][1];
                    u32x4 w; w.x = cvt_pk_bf16(v0[0], v0[1]); w.y = cvt_pk_bf16(v0[2], v0[3]); w.z = cvt_pk_bf16(v1[0], v1[1]); w.w = cvt_pk_bf16(v1[2], v1[3]);
                    *(u32x4*)(rowp + bj * HALF) = w; } }
    }
};
struct EpiH1 {
    static constexpr bool PERM = true, AFTER_DRAIN = false;
    const float* gain0; bf16_t* O; int ldc; long xn_off, rms_off;
    __device__ __forceinline__ void operator()(const f32x4 (&acc)[2][2][4][2], const Unit& u, int wr, int wc, int fr, int fq) const {
        const int row0 = u.pm * BM + wr * 64 + fr; const int col0 = u.pn * BM + wc * 32 + 8 * fq;
        const bf16_t* XNp = (const bf16_t*)((const char*)O + xn_off); const float* rms0 = (const float*)((const char*)O + rms_off);
        f32x4 ig[2][2];
#pragma unroll
        for (int bj = 0; bj < 2; ++bj)
#pragma unroll
            for (int n = 0; n < 2; ++n) { const f32x4 gq = *(const f32x4*)(gain0 + col0 + bj * HALF + 4 * n);
#pragma unroll
                for (int c = 0; c < 4; ++c) ig[bj][n][c] = __builtin_amdgcn_rcpf(gq[c]); }
#pragma unroll
        for (int ai = 0; ai < 2; ++ai) { u32x4 xv[4][2]; float rm[4];
#pragma unroll
            for (int m = 0; m < 4; ++m) { const int row = row0 + ai * HALF + m * 16; rm[m] = rms0[row];
#pragma unroll
                for (int bj = 0; bj < 2; ++bj) xv[m][bj] = *(const u32x4*)(XNp + (size_t)row * ldc + col0 + bj * HALF); }
#pragma unroll
            for (int m = 0; m < 4; ++m) { bf16_t* rowp = O + (size_t)(row0 + ai * HALF + m * 16) * ldc + col0;
#pragma unroll
                for (int bj = 0; bj < 2; ++bj) { const u32x4 xw = xv[m][bj];
                    const f32x4 x0 = {__builtin_bit_cast(float, xw.x << 16), __builtin_bit_cast(float, xw.x & 0xffff0000u), __builtin_bit_cast(float, xw.y << 16), __builtin_bit_cast(float, xw.y & 0xffff0000u)};
                    const f32x4 x1 = {__builtin_bit_cast(float, xw.z << 16), __builtin_bit_cast(float, xw.z & 0xffff0000u), __builtin_bit_cast(float, xw.w << 16), __builtin_bit_cast(float, xw.w & 0xffff0000u)};
                    const f32x4 v0 = acc[ai][bj][m][0] + x0 * (ig[bj][0] * rm[m]), v1 = acc[ai][bj][m][1] + x1 * (ig[bj][1] * rm[m]);
                    u32x4 w; w.x = cvt_pk_bf16(v0[0], v0[1]); w.y = cvt_pk_bf16(v0[2], v0[3]); w.z = cvt_pk_bf16(v1[0], v1[1]); w.w = cvt_pk_bf16(v1[2], v1[3]);
                    *(u32x4*)(rowp + bj * HALF) = w; } }
            asm volatile("" ::: "memory"); }
    }
};
struct EpiRes {
    static constexpr bool PERM = false, AFTER_DRAIN = false;
    const float* base; float* out; int ldc;
    __device__ __forceinline__ void operator()(const f32x4 (&acc)[2][2][4][2], const Unit& u, int wr, int wc, int fr, int fq) const {
        const int col0 = u.pn * BM + wc * 32 + 4 * fq;
#pragma unroll
        for (int ai = 0; ai < 2; ++ai)
#pragma unroll
            for (int m = 0; m < 4; ++m) { const size_t off = (size_t)(u.pm * BM + ai * HALF + wr * 64 + m * 16 + fr) * ldc + col0;
#pragma unroll
                for (int bj = 0; bj < 2; ++bj)
#pragma unroll
                    for (int n = 0; n < 2; ++n) { const f32x4 bs = *(const f32x4*)(base + off + bj * HALF + n * 16); *(f32x4*)(out + off + bj * HALF + n * 16) = bs + acc[ai][bj][m][n]; }
                if (m & 1) asm volatile("" ::: "memory"); }
    }
};
struct MUnit { int pm, pn, e, e2, hc, slot, half; };
__host__ __device__ __forceinline__ bool moe_deal(int i, int c, int G, int NU, int& g, int& half, bool quarter = false) {
    const int full = NU / G, rem = NU - full * G;
    if (i < full) { g = i * G + c; half = -1; return true; }
    if (i > full || rem == 0) return false;
    if (quarter && 4 * rem <= G) { if (c >= 4 * rem) return false; g = full * G + (c >> 2); half = 4 + (c & 3); return true; }
    if (2 * rem <= G) { if (c >= 2 * rem) return false; g = full * G + (c >> 1); half = c & 1; return true; }
    if (c >= rem) return false; g = full * G + c; half = -1; return true;
}
struct MGemm { const bf16_t* A; const bf16_t* Bt; int K; int KB; int brows; };
template <int SHIFT> struct MoeOrderP {
    PG8_LAS const int* tb;
    int G, c;
    __device__ __forceinline__ bool next(int i, MUnit& u) const {
        const int NT = __builtin_amdgcn_readfirstlane(tb[24]); int g, half; if (!moe_deal(i, c, G, NT << SHIFT, g, half, SHIFT == 2)) return false;
        const int rt = g >> SHIFT; int bk = 0;
#pragma unroll
        for (int j = 1; j < 24; ++j) { const int b = __builtin_amdgcn_readfirstlane(tb[j]); bk = (rt >= b) ? j : bk; }
        const int grp = bk / 6, p = bk - grp * 6; const int a = p < 3 ? 0 : (p < 5 ? 1 : 2), b2 = p < 3 ? p + 1 : (p < 5 ? p - 1 : 3);
        const int elo = grp * 4 + a, ehi = grp * 4 + b2;
        if (SHIFT == 3) { const int pn8 = g & 7; u.e = (pn8 < 4) ? elo : ehi; u.e2 = u.e; u.pn = pn8 & 3; u.hc = (pn8 >> 2) * 512; }
        else { u.e = elo; u.e2 = ehi; u.pn = g & 3; u.hc = 0; }
        u.pm = rt; u.slot = i; u.half = half; return true;
    }
    __device__ __forceinline__ void a_ready(const MUnit&) const {}
    __device__ __forceinline__ void done(const MUnit&) const {}
};
struct EpiSwiglu {
    static constexpr bool PERM = true, AFTER_DRAIN = false;
    bf16_t* H; PG8_LAS const int* tab;
    __device__ __forceinline__ void operator()(const f32x4 (&acc)[2][2][4][2], const MUnit& u, int wr, int wc, int fr, int fq) const {
        const int row0 = u.pm * BM + wr * 64 + fr; const int col0 = u.hc + u.pn * HALF + wc * 32 + 8 * fq;
#pragma unroll
        for (int ai = 0; ai < 2; ++ai) { if (u.half >= 0 && u.half != ai) continue;
#pragma unroll
            for (int m = 0; m < 4; ++m) { bf16_t* rowp = H + (size_t)(row0 + ai * HALF + m * 16) * 1024 + col0; const int rl = ai * HALF + wr * 64 + m * 16 + fr;
                const float rs = __builtin_bit_cast(float, tab[u.slot * 512 + 256 + rl]); const float w = __builtin_bit_cast(float, (unsigned)tab[u.slot * 512 + rl] & 0xffff0000u);
                f32x4 g0 = acc[ai][0][m][0] * rs, g1 = acc[ai][0][m][1] * rs; const f32x4 u0 = acc[ai][1][m][0] * (rs * w), u1 = acc[ai][1][m][1] * (rs * w);
#pragma unroll
                for (int c = 0; c < 4; ++c) { g0[c] = fast_silu(g0[c]) * u0[c]; g1[c] = fast_silu(g1[c]) * u1[c]; }
                u32x4 wv; wv.x = cvt_pk_bf16(g0[0], g0[1]); wv.y = cvt_pk_bf16(g0[2], g0[3]); wv.z = cvt_pk_bf16(g1[0], g1[1]); wv.w = cvt_pk_bf16(g1[2], g1[3]);
                *(u32x4*)rowp = wv; } }
    }
};
struct EpiDown {
    static constexpr bool PERM = true, AFTER_DRAIN = false;
    bf16_t* Y; PG8_LAS const int* tab;
    __device__ __forceinline__ void operator()(const f32x4 (&acc)[2][2][4][2], const MUnit& u, int wr, int wc, int fr, int fq) const {
        const int col0 = u.pn * BM + wc * 32 + 8 * fq;
#pragma unroll
        for (int ai = 0; ai < 2; ++ai) { if (u.half >= 0 && (u.half & 1) != ai) continue;
#pragma unroll
            for (int m = 0; m < 4; ++m) { const int rl = ai * HALF + wr * 64 + m * 16 + fr; const int t = tab[u.slot * 256 + rl];
                if (t >= 0) { bf16_t* rowp = Y + (size_t)t * 1024 + col0;
#pragma unroll
                    for (int bj = 0; bj < 2; ++bj) { if (u.half >= 4 && ((u.half >> 1) & 1) != bj) continue; const f32x4 v0 = acc[ai][bj][m][0], v1 = acc[ai][bj][m][1];
                        u32x4 o; o.x = cvt_pk_bf16(v0[0], v0[1]); o.y = cvt_pk_bf16(v0[2], v0[3]); o.z = cvt_pk_bf16(v1[0], v1[1]); o.w = cvt_pk_bf16(v1[2], v1[3]);
                        *(u32x4*)(rowp + bj * HALF) = o; } } } }
    }
};
template <class Epi, class Sched, bool GATHER, bool ALIGN_EPI, bool DUALB, int TSTRIDE = 512>
__device__ __forceinline__ void gemm_phase_moe(PG8_LAS unsigned char* lds, PG8_LAS const int* tok, const MGemm g, const Sched& S, const Epi& E) {
    const int tid = threadIdx.x, wid = __builtin_amdgcn_readfirstlane(tid >> 6), lane = tid & 63, wr = wid >> 2, wc = wid & 3, fr = lane & 15, fq = lane >> 4;
    const int K = g.K, KB = g.KB, nt = K / BK, nsw = KB / BK;
    unsigned voffB[2]; int RA[2]; unsigned colA[2];
#pragma unroll
    for (int i = 0; i < 2; ++i) { int R, C; stage_rc(tid * 16 + i * 8192, R, C); const int Rb = Epi::PERM ? ((R & ~31) + perm32(R & 31)) : R;
        RA[i] = R; colA[i] = (unsigned)C * 2u; voffB[i] = (unsigned)(Rb * KB + C) * 2u; }
    const size_t kstep = (size_t)(BK * 2);
    const size_t hstep = (size_t)HALF * KB * 2;
    const size_t tstep = (size_t)2 * HALF * K * 2;
    const unsigned ldsw = (unsigned)wid * 1024u;
    const int aoff = lds_byte(wr * 64 + fr, fq * 8), boff = lds_byte(wc * 32 + fr, fq * 8);
#define PG8_SA(b, h) (((b) * 2 + (h)) * HTB)
#define PG8_SB(b, h) ((4 + (b) * 2 + (h)) * HTB)
#define PG8_STAGE(bufoff, gbase, voff) do { _Pragma("unroll") for (int _i = 0; _i < 2; ++_i) \
        __builtin_amdgcn_global_load_lds((const unsigned*)((const char*)(gbase) + (voff)[_i]), (PG8_LAS unsigned*)(lds + (bufoff) + ldsw + _i * 8192), 16, 0, 0); } while (0)
#define PG8_LDA(dst, b, h) do { _Pragma("unroll") for (int m = 0; m < 4; ++m) _Pragma("unroll") for (int k = 0; k < 2; ++k) dst[m][k] = *(const PG8_LAS bf16x8*)(lds + PG8_SA(b, h) + aoff + m * 2048 + k * 1024); } while (0)
#define PG8_LDB(dst, b, h) do { _Pragma("unroll") for (int n = 0; n < 2; ++n) _Pragma("unroll") for (int k = 0; k < 2; ++k) dst[n][k] = *(const PG8_LAS bf16x8*)(lds + PG8_SB(b, h) + boff + n * 2048 + k * 1024); } while (0)
#define PG8_MMA(ai, bj, At, Bt) do { __builtin_amdgcn_s_setprio(1); _Pragma("unroll") for (int m = 0; m < 4; ++m) _Pragma("unroll") for (int n = 0; n < 2; ++n) _Pragma("unroll") for (int k = 0; k < 2; ++k) \
        acc[ai][bj][m][n] = __builtin_amdgcn_mfma_f32_16x16x32_bf16(Bt[n][k], At[m][k], acc[ai][bj][m][n], 0, 0, 0); __builtin_amdgcn_s_setprio(0); } while (0)
#define PG8_WAIT_V(n) asm volatile("s_waitcnt vmcnt(" #n ")" ::: "memory")
#define PG8_WAIT_L(n) asm volatile("s_waitcnt lgkmcnt(" #n ")" ::: "memory")
#define PG8_BAR __builtin_amdgcn_s_barrier()
#define PG8_SCHED __builtin_amdgcn_sched_barrier(0)
#define PG8_AOFFS(dst, U) do { _Pragma("unroll") for (int _h = 0; _h < 2; ++_h) _Pragma("unroll") for (int _i = 0; _i < 2; ++_i) { \
        if constexpr (GATHER) dst[_h][_i] = ((unsigned)tok[(U).slot * TSTRIDE + _h * HALF + RA[_i]] & 0xffffu) * (unsigned)(K * 2) + colA[_i]; \
        else dst[_h][_i] = (unsigned)((_h * HALF + RA[_i]) * K) * 2u + colA[_i]; } } while (0)
    MUnit cur, nxt; int ui = 0;
    if (!S.next(0, cur)) return;
    f32x4 acc[2][2][4][2];
#pragma unroll
    for (int a = 0; a < 2; ++a)
#pragma unroll
        for (int b = 0; b < 2; ++b)
#pragma unroll
            for (int m = 0; m < 4; ++m)
#pragma unroll
                for (int n = 0; n < 2; ++n) acc[a][b][m][n] = (f32x4){0.f, 0.f, 0.f, 0.f};
    bf16x8 At[4][2], B0[2][2], B1[2][2];
    unsigned cv[2][2], nv[2][2];
    PG8_AOFFS(cv, cur);
    const char* cA = GATHER ? (const char*)g.A : (const char*)g.A + (size_t)cur.pm * tstep;
    const char* cB = (const char*)g.Bt + ((size_t)cur.e * g.brows + (size_t)cur.pn * BM) * KB * 2;
    const char* cB2 = (const char*)g.Bt + ((size_t)cur.e2 * g.brows + (size_t)cur.pn * BM) * KB * 2 - (size_t)nsw * kstep;
    S.a_ready(cur);
    PG8_STAGE(PG8_SB(0, 0), cB, voffB); PG8_STAGE(PG8_SB(0, 1), cB + hstep, voffB); PG8_STAGE(PG8_SA(0, 0), cA, cv[0]); PG8_STAGE(PG8_SA(0, 1), cA, cv[1]);
    if (wr == 1) PG8_BAR;
    PG8_WAIT_V(2); PG8_BAR;
    PG8_STAGE(PG8_SB(1, 0), cB + kstep, voffB); PG8_STAGE(PG8_SA(1, 0), cA + kstep, cv[0]); PG8_STAGE(PG8_SB(1, 1), cB + hstep + kstep, voffB);
    PG8_WAIT_V(6); PG8_BAR;
    for (;;) {
        const bool has_next = S.next(ui + 1, nxt);
        const bool do0 = cur.half < 0 || (cur.half & 1) == 0, do1 = cur.half < 0 || (cur.half & 1) == 1;
        const bool db0 = cur.half < 4 || ((cur.half >> 1) & 1) == 0, db1 = cur.half < 4 || ((cur.half >> 1) & 1) == 1;
        const char* nA = cA; const char* nB = cB; const char* nB2 = cB2;
        if (has_next) { PG8_AOFFS(nv, nxt); nA = GATHER ? (const char*)g.A : (const char*)g.A + (size_t)nxt.pm * tstep; nB = (const char*)g.Bt + ((size_t)nxt.e * g.brows + (size_t)nxt.pn * BM) * KB * 2; nB2 = (const char*)g.Bt + ((size_t)nxt.e2 * g.brows + (size_t)nxt.pn * BM) * KB * 2 - (size_t)nsw * kstep; }
        else {
#pragma unroll
            for (int h = 0; h < 2; ++h)
#pragma unroll
                for (int i = 0; i < 2; ++i) nv[h][i] = cv[h][i]; }
        for (int t = 0; t < nt; t += 2) {
            const bool last = (t == nt - 2);
            const char* a1 = cA + (size_t)(t + 1) * kstep;
            const char* a2 = last ? nA : cA + (size_t)(t + 2) * kstep; const char* b2 = last ? nB : ((DUALB && t + 2 >= nsw) ? cB2 : cB) + (size_t)(t + 2) * kstep;
            const char* a3 = a2 + kstep; const char* b3 = b2 + kstep;
            unsigned v2[2][2];
#pragma unroll
            for (int h = 0; h < 2; ++h)
#pragma unroll
                for (int i = 0; i < 2; ++i) v2[h][i] = last ? nv[h][i] : cv[h][i];
            if (last && has_next) S.a_ready(nxt);
            PG8_LDB(B0, 0, 0); PG8_LDB(B1, 0, 1); PG8_SCHED; PG8_LDA(At, 0, 0); PG8_STAGE(PG8_SA(1, 1), a1, cv[1]);
            PG8_WAIT_V(8); PG8_WAIT_L(0); PG8_BAR; if (do0) { if (db0) PG8_MMA(0, 0, At, B0); if (db1) PG8_MMA(0, 1, At, B1); } PG8_BAR; PG8_SCHED;
            PG8_LDA(At, 0, 1); PG8_STAGE(PG8_SB(0, 0), b2, voffB); PG8_STAGE(PG8_SB(0, 1), b2 + hstep, voffB); PG8_STAGE(PG8_SA(0, 0), a2, v2[0]);
            PG8_WAIT_V(8); PG8_WAIT_L(0); PG8_BAR; if (do1) { if (db0) PG8_MMA(1, 0, At, B0); if (db1) PG8_MMA(1, 1, At, B1); } PG8_BAR; PG8_SCHED;
            PG8_LDB(B0, 1, 0); PG8_LDB(B1, 1, 1); PG8_SCHED; PG8_LDA(At, 1, 0); PG8_STAGE(PG8_SA(0, 1), a2, v2[1]);
            PG8_WAIT_V(8); PG8_WAIT_L(0); PG8_BAR; if (do0) { if (db0) PG8_MMA(0, 0, At, B0); if (db1) PG8_MMA(0, 1, At, B1); } PG8_BAR; PG8_SCHED;
            PG8_LDA(At, 1, 1); PG8_STAGE(PG8_SB(1, 0), b3, voffB); PG8_STAGE(PG8_SB(1, 1), b3 + hstep, voffB); PG8_STAGE(PG8_SA(1, 0), a3, v2[0]);
            PG8_WAIT_V(8); PG8_WAIT_L(0); PG8_BAR; if (do1) { if (db0) PG8_MMA(1, 0, At, B0); if (db1) PG8_MMA(1, 1, At, B1); } PG8_BAR; PG8_SCHED;
        }
        if constexpr (ALIGN_EPI) { if (wr == 0) PG8_BAR; }
        E(acc, cur, wr, wc, fr, fq); S.done(cur);
        if (!has_next) break;
#pragma unroll
        for (int a = 0; a < 2; ++a)
#pragma unroll
            for (int b = 0; b < 2; ++b)
#pragma unroll
                for (int m = 0; m < 4; ++m)
#pragma unroll
                    for (int n = 0; n < 2; ++n) acc[a][b][m][n] = (f32x4){0.f, 0.f, 0.f, 0.f};
        cur = nxt; cA = nA; cB = nB; cB2 = nB2; ++ui;
#pragma unroll
        for (int h = 0; h < 2; ++h)
#pragma unroll
            for (int i = 0; i < 2; ++i) cv[h][i] = nv[h][i];
        if constexpr (ALIGN_EPI) { if (wr == 1) PG8_BAR; }
    }
    PG8_WAIT_V(0);
    if constexpr (!ALIGN_EPI) { if (wr == 0) PG8_BAR; }
    PG8_BAR;
#undef PG8_AOFFS
#undef PG8_SA
#undef PG8_SB
#undef PG8_STAGE
#undef PG8_LDA
#undef PG8_LDB
#undef PG8_MMA
#undef PG8_WAIT_V
#undef PG8_WAIT_L
#undef PG8_BAR
#undef PG8_SCHED
}
}
constexpr int NWAVES = 8;
constexpr int T_ = 65536, DM_ = 1024, NB_ = 32, SEQ_ = 2048, INC_ = 3592, UC_ = 3584;
constexpr int NE_ = 16, EH_ = 512;
constexpr int RMAX_ = 2 * T_ + NE_ * 256;
constexpr int NBK_ = 24, RMAXP_ = T_ + NBK_ * 256;
constexpr float EPS_ = 1e-6f;
constexpr float QSCALE_ = 0.125f * 1.4426950408889634f;
constexpr size_t MiB = 1u << 20;
constexpr size_t WS_CTL = 0, CTL_ZERO_BYTES = 1 * MiB;
constexpr size_t WS_LB = 1 * MiB, WS_WI = 2 * MiB, WS_WO = 9 * MiB, WS_WGU = 11 * MiB, WS_WD = 43 * MiB, WS_FLG = 59 * MiB;
constexpr size_t WS_RE = 61 * MiB, WS_RW = 62 * MiB, WS_ENTRY = 63 * MiB, WS_SROW = 67 * MiB, WS_SW = 68 * MiB, WS_STOK = 69 * MiB, WS_TILEE = 70 * MiB, WS_CUM = 71 * MiB  ;
constexpr size_t WS_RSTD = 73 * MiB;
constexpr size_t WS_XN = 74 * MiB;
constexpr size_t WS_U = 202 * MiB;
constexpr size_t WS_HB = 202 * MiB;
constexpr size_t WS_Y = 346 * MiB;
constexpr size_t WS_D = 650 * MiB;
constexpr size_t WS_ORAW = 650 * MiB;
constexpr size_t WS_MIX = 778 * MiB;
constexpr size_t WS_RMS0 = WS_RE;
constexpr size_t WS_END = 906 * MiB;
constexpr int CW_TMO = 0, CW_CODE = 1;
constexpr int CW_CNT = 64;
constexpr int CW_CLAIM = 256;
constexpr int CW_KT = 65536, CW_QT = CW_KT + 256 * 2 * 32;
constexpr int CW_PLAN = 128;
constexpr int CW_BAR = 4096;
constexpr int RING_OFF = 0, RING_BYTES = 131072;
constexpr int TAB_OFF = RING_BYTES, TAB_BYTES = 24576;
constexpr int LDSCTL_OFF = TAB_OFF + TAB_BYTES, MISC_OFF = LDSCTL_OFF + 320;
constexpr int LDS_BYTES = LDSCTL_OFF + 1024;

#define GAS __attribute__((address_space(1)))
#define LAS __attribute__((address_space(3)))
typedef unsigned short bf16;
typedef unsigned v4u __attribute__((ext_vector_type(4)));
typedef unsigned v2u __attribute__((ext_vector_type(2)));
typedef float f32x4 __attribute__((ext_vector_type(4)));
typedef short bf16x8 __attribute__((ext_vector_type(8)));
typedef GAS unsigned gu32;
#define RLX_AGENT __ATOMIC_RELAXED, __HIP_MEMORY_SCOPE_AGENT
#define LDS_WAIT() asm volatile("s_waitcnt lgkmcnt(0)" ::: "memory")
#define VM_WAIT() asm volatile("s_waitcnt vmcnt(0)" ::: "memory")
__device__ __forceinline__ unsigned f2bf(float f) { unsigned u = __builtin_bit_cast(unsigned, f); return (u + 0x7fffu + ((u >> 16) & 1u)) >> 16; }
__device__ __forceinline__ unsigned pk2(float lo, float hi) { return f2bf(lo) | (f2bf(hi) << 16); }
__device__ __forceinline__ float bf2f(unsigned short b) { return __builtin_bit_cast(float, (unsigned)b << 16); }
__device__ __forceinline__ float bflo(unsigned w) { return __builtin_bit_cast(float, w << 16); }
__device__ __forceinline__ float bfhi(unsigned w) { return __builtin_bit_cast(float, w & 0xffff0000u); }

#define XB_TMO      128
#define XB_XCNT(j)  (256  + 64 * (j))
#define XB_XSUB(j)  (1280 + 64 * (j))
#define XB_XGEN(j)  (2304 + 64 * (j))
#define XB_TOP      3328
#define XB_TOPGEN   3392
#define XCD_BAR_WORDS 3456
#define XB_SPIN_CAP (1u << 18)

__device__ __forceinline__ unsigned xb_ld(unsigned* p)              { return __hip_atomic_load(p, __ATOMIC_RELAXED, __HIP_MEMORY_SCOPE_AGENT); }
__device__ __forceinline__ unsigned xb_add(unsigned* p, unsigned v) { return __hip_atomic_fetch_add(p, v, __ATOMIC_RELAXED, __HIP_MEMORY_SCOPE_AGENT); }
__device__ __forceinline__ unsigned xb_xcc_id() { return (unsigned)__builtin_amdgcn_s_getreg((3 << 11) | 20) & 0xFu; }
#define XB_SPIN(cond, bar) do { unsigned _sp = 0; while (cond) { __builtin_amdgcn_s_sleep(1); \
    if ((++_sp & 255u) == 0u) { if (xb_ld(&(bar)[XB_TMO])) break; if (_sp > XB_SPIN_CAP) { atomicAdd(&(bar)[XB_TMO], 1u); break; } } } } while (0)

struct XcdBarrier {
    unsigned* bar; unsigned x;
    volatile LAS unsigned* st;
};

__device__ __forceinline__ XcdBarrier xcd_barrier_post(unsigned* bar, volatile LAS unsigned* st) {
    XcdBarrier b; b.bar = bar; b.x = xb_xcc_id(); b.st = st;
    if (threadIdx.x == 0) (void)xb_add(&bar[XB_XCNT(b.x)], 1u);
    return b;
}
__device__ __forceinline__ void xcd_barrier_complete(unsigned* bar, unsigned x, unsigned& nloc, unsigned& nx) {
    const unsigned G = gridDim.x * gridDim.y * gridDim.z;
    unsigned sum, cnt, mine, sp = 0u;
    for (;;) {
        sum = 0u; cnt = 0u; mine = 0u;
#pragma unroll
        for (unsigned j = 0; j < 16; ++j) { const unsigned c = xb_ld(&bar[XB_XCNT(j)]); sum += c; cnt += (c > 0u) ? 1u : 0u; mine = (j == x) ? c : mine; }
        if (sum == G) break;
        __builtin_amdgcn_s_sleep(1);
        if ((++sp & 255u) == 0u) { if (xb_ld(&bar[XB_TMO])) break; if (sp > XB_SPIN_CAP) { atomicAdd(&bar[XB_TMO], 1u); break; } }
    }
    nloc = mine > 0u ? mine : 1u; nx = cnt > 0u ? cnt : 1u;
}

__device__ __forceinline__ void xcd_barrier(const XcdBarrier& b) {
    asm volatile("s_waitcnt vmcnt(0)" ::: "memory");
    __syncthreads();
    if (threadIdx.x == 0) {
        unsigned* bar = b.bar;
        __builtin_amdgcn_s_waitcnt(0);
        unsigned nloc = b.st[0], nx = b.st[1];
        if (nloc == 0u) { xcd_barrier_complete(bar, b.x, nloc, nx); b.st[0] = nloc; b.st[1] = nx; }
        const unsigned old = xb_add(&bar[XB_XSUB(b.x)], 1u);
        const unsigned gen = old / nloc;
        if (old + 1u == (gen + 1u) * nloc) {
            __builtin_amdgcn_fence(__ATOMIC_RELEASE, "agent");
            asm volatile("s_waitcnt vmcnt(0)" ::: "memory");
            const unsigned og = xb_add(&bar[XB_TOP], 1u);
            const unsigned tg = og / nx;
            if (og + 1u == (tg + 1u) * nx) xb_add(&bar[XB_TOPGEN], 1u);
            else XB_SPIN(xb_ld(&bar[XB_TOPGEN]) == tg, bar);
            __builtin_amdgcn_fence(__ATOMIC_ACQUIRE, "agent");
            xb_add(&bar[XB_XGEN(b.x)], 1u);
            asm volatile("s_waitcnt vmcnt(0)" ::: "memory");
        } else {
            XB_SPIN(xb_ld(&bar[XB_XGEN(b.x)]) == gen, bar);
            __builtin_amdgcn_fence(__ATOMIC_ACQUIRE, "agent");
            asm volatile("s_waitcnt vmcnt(0)" ::: "memory");
        }
    }
    __syncthreads();
}


struct Frame {
    LAS unsigned char* lds;
    volatile LAS unsigned* MISC;
    gu32* ctl;
    int tid, lane, wave;
    int vcu, G;
    const float* in[17]; float* out; unsigned char* ws;
};
template <int CTRL, int RM> __device__ __forceinline__ float dpp_add(float v) { return v + __builtin_bit_cast(float, __builtin_amdgcn_update_dpp(0, __builtin_bit_cast(int, v), CTRL, RM, 0xf, RM == 0xf)); }
__device__ __forceinline__ float wave_sum(float v) {
    v = dpp_add<0xB1, 0xf>(v); v = dpp_add<0x4E, 0xf>(v); v = dpp_add<0x141, 0xf>(v); v = dpp_add<0x140, 0xf>(v);
    v = dpp_add<0x142, 0xa>(v);
    v = dpp_add<0x143, 0xc>(v);
    return __builtin_bit_cast(float, __builtin_amdgcn_readlane(__builtin_bit_cast(int, v), 63));
}
template <bool SC = false> __device__ __forceinline__ void p0_transpose_block(const float* src, int pitch, bf16* dst, int Kdst, LAS float* scr, int lane, const float* ksc = nullptr) {
#pragma unroll 8
    for (int i = 0; i < 32; ++i) { const int kk = 2 * i + (lane >> 5); float v_ = src[(size_t)kk * pitch + (lane & 31)]; if constexpr (SC) v_ *= ksc[kk]; scr[kk * 33 + (lane & 31)] = v_; }
    LDS_WAIT(); asm volatile("" ::: "memory");
    const int c = lane & 7;
#pragma unroll
    for (int j = 0; j < 4; ++j) { const int n = (lane >> 3) + 8 * j; const LAS float* s = scr + (8 * c) * 33 + n;
        v4u o; o.x = pk2(s[0 * 33], s[1 * 33]); o.y = pk2(s[2 * 33], s[3 * 33]); o.z = pk2(s[4 * 33], s[5 * 33]); o.w = pk2(s[6 * 33], s[7 * 33]);
        *(GAS v4u*)(dst + (size_t)n * Kdst + 8 * c) = o; }
    LDS_WAIT(); asm volatile("" ::: "memory");
}
__device__ __forceinline__ void convert_items(Frame& F, int first, int count, int gw, int NGW) {
    LAS float* scr = (LAS float*)(F.lds + RING_OFF + F.wave * 16384);
    const float* w_in = F.in[2]; const float* w_out = F.in[7]; const float* w_gate = F.in[13]; const float* w_up = F.in[14]; const float* w_down = F.in[15];
    bf16* WI = (bf16*)(F.ws + WS_WI); bf16* WO = (bf16*)(F.ws + WS_WO); bf16* WGU = (bf16*)(F.ws + WS_WGU); bf16* WD = (bf16*)(F.ws + WS_WD);
    constexpr int I_WI = 16 * 112, I_WO = 16 * 32, I_WG = 16 * 256;
    for (int it = first + gw; it < first + count; it += NGW) {
        int r = it;
        if (r < I_WI) { const int kb = r / 112, nb = r % 112; p0_transpose_block(w_in + (size_t)(64 * kb) * INC_ + 32 * nb, INC_, WI + (size_t)(32 * nb) * 1024 + 64 * kb, 1024, scr, F.lane); continue; } r -= I_WI;
        if (r < I_WO) { const int kb = r / 32, nb = r % 32; p0_transpose_block(w_out + (size_t)(64 * kb) * 1024 + 32 * nb, 1024, WO + (size_t)(32 * nb) * 1024 + 64 * kb, 1024, scr, F.lane); continue; } r -= I_WO;
        if (r < 2 * I_WG) { const int up = r >= I_WG; if (up) r -= I_WG; const int e = r / 256, q = r % 256, kb = q / 16, nb = q % 16, n0 = 32 * nb;
            const int drow = (n0 >> 7) * 256 + (n0 & 127) + (up ? 128 : 0);
            p0_transpose_block<true>((up ? w_up : w_gate) + (size_t)e * 1024 * 512 + (size_t)(64 * kb) * 512 + n0, 512, WGU + ((size_t)e * 1024 + drow) * 1024 + 64 * kb, 1024, scr, F.lane, F.in[8] + 64 * kb); continue; }   r -= 2 * I_WG;
        { const int e = r / 256, q = r % 256, kb = q / 32, nb = q % 32;
            p0_transpose_block(w_down + (size_t)e * 512 * 1024 + (size_t)(64 * kb) * 1024 + 32 * nb, 1024, WD + ((size_t)e * 1024 + 32 * nb) * 512 + 64 * kb, 512, scr, F.lane); }
    }
}
constexpr int CONV_I_WI = 16 * 112, CONV_I_REST = 16 * 32 + 2 * 16 * 256 + 16 * 256;
__device__ __forceinline__ void p0_prologue(Frame& F) {
    const int gw = F.vcu * NWAVES + F.wave, NGW = F.G * NWAVES;
    const float* w_in = F.in[2];
    convert_items(F, 0, (F.G == 256 && (MK_OPT_MASK & 4)) ? CONV_I_WI : CONV_I_WI + CONV_I_REST, gw, NGW);
    { float* LB = (float*)(F.ws + WS_LB); const float* lg = F.in[3];
      for (int i = gw * 64 + F.lane; i < 512; i += NGW * 64) { const float a = lg[i], b = lg[512 + i]; LB[i] = 1.f / (1.f + expf(b - a)); } }
    const float* x = F.in[0]; const float* gain = F.in[1]; const float* fb = F.in[5];
    bf16* XN = (bf16*)(F.ws + WS_XN); float* FLG = (float*)(F.ws + WS_FLG);
    f32x4 gv[4]; f32x4 wfa[4][4], wfb[4][4];
#pragma unroll
    for (int j = 0; j < 4; ++j) { gv[j] = *(const GAS f32x4*)(gain + 256 * j + 4 * F.lane);
#pragma unroll
        for (int c = 0; c < 4; ++c) { const float* wp = w_in + (size_t)(256 * j + 4 * F.lane + c) * INC_ + 3584; wfa[j][c] = *(const GAS f32x4*)wp; wfb[j][c] = *(const GAS f32x4*)(wp + 4); } }
    const float fbv = fb[F.lane & 7];
    f32x4 nx[4];
#define P0_LOAD(mm) do { const GAS f32x4* xr_ = (const GAS f32x4*)(x + (size_t)(mm) * DM_) + F.lane; _Pragma("unroll") for (int j = 0; j < 4; ++j) nx[j] = xr_[64 * j]; } while (0)
    if (gw < T_) P0_LOAD(gw);
    for (int m = gw; m < T_; m += NGW) {
        f32x4 v[4]; float s = 0.f;
#pragma unroll
        for (int j = 0; j < 4; ++j) v[j] = nx[j];
        if (m + NGW < T_) P0_LOAD(m + NGW);
#pragma unroll
        for (int j = 0; j < 4; ++j) s += (v[j].x * v[j].x + v[j].y * v[j].y) + (v[j].z * v[j].z + v[j].w * v[j].w);
        const float rms_ = sqrtf(wave_sum(s) * (1.f / DM_) + EPS_); const float rstd = 1.f / rms_;
        if (F.lane == 0) ((float*)(F.ws + WS_RMS0))[m] = rms_;
        f32x4 pa = {0.f, 0.f, 0.f, 0.f}, pb = {0.f, 0.f, 0.f, 0.f};
        GAS unsigned long long* o8 = (GAS unsigned long long*)(XN + (size_t)m * DM_) + F.lane;
#pragma unroll
        for (int j = 0; j < 4; ++j) { v[j] = v[j] * rstd * gv[j];
            o8[64 * j] = (unsigned long long)pk2(v[j].x, v[j].y) | ((unsigned long long)pk2(v[j].z, v[j].w) << 32);
#pragma unroll
            for (int c = 0; c < 4; ++c) { pa += wfa[j][c] * v[j][c]; pb += wfb[j][c] * v[j][c]; } }
        float zz;
        { const float z[8] = {pa.x, pa.y, pa.z, pa.w, pb.x, pb.y, pb.z, pb.w}; const bool b0 = F.lane & 1, b1 = F.lane & 2, b2 = F.lane & 4;
          float y[4], w2[2];
#pragma unroll
          for (int k = 0; k < 4; ++k) { const float keep = b0 ? z[2 * k + 1] : z[2 * k], send = b0 ? z[2 * k] : z[2 * k + 1];
              y[k] = keep + __builtin_bit_cast(float, __builtin_amdgcn_update_dpp(0, __builtin_bit_cast(int, send), 0xB1, 0xf, 0xf, true)); }
#pragma unroll
          for (int j = 0; j < 2; ++j) { const float keep = b1 ? y[2 * j + 1] : y[2 * j], send = b1 ? y[2 * j] : y[2 * j + 1];
              w2[j] = keep + __builtin_bit_cast(float, __builtin_amdgcn_update_dpp(0, __builtin_bit_cast(int, send), 0x4E, 0xf, 0xf, true)); }
          { const float keep = b2 ? w2[1] : w2[0], send = b2 ? w2[0] : w2[1];
            const int h_ = __builtin_amdgcn_update_dpp(0, __builtin_bit_cast(int, send), 0x141, 0xf, 0xf, true);
            zz = keep + __builtin_bit_cast(float, __builtin_amdgcn_update_dpp(0, h_, 0x1B, 0xf, 0xf, true)); }
          { const int m_ = __builtin_amdgcn_update_dpp(0, __builtin_bit_cast(int, zz), 0x140, 0xf, 0xf, true);
            zz += __builtin_bit_cast(float, __builtin_amdgcn_update_dpp(0, m_, 0x141, 0xf, 0xf, true)); }
          zz += __builtin_bit_cast(float, __builtin_amdgcn_ds_bpermute((F.lane ^ 16) << 2, __builtin_bit_cast(int, zz)));
          zz += __builtin_bit_cast(float, __builtin_amdgcn_ds_bpermute((F.lane ^ 32) << 2, __builtin_bit_cast(int, zz))); }
        zz += fbv;
        const float ls = fminf(zz, 0.f) - log1pf(expf(-fabsf(zz)));
        if (F.lane < 8) FLG[(size_t)m * 8 + F.lane] = ls;
    }
}
template <bool DRY  > __device__ __forceinline__ void p4_router(Frame& F) {
    const float* wg = F.in[9]; const float* bg = F.in[10]; const float* we = F.in[11]; const float* be = F.in[12]; const float* gain = F.in[8];
    LAS unsigned char* BIMG = F.lds + RING_OFF;
    LAS float* LGW = (LAS float*)(F.lds + TAB_OFF) + F.wave * 640;
    LAS int* cntL = (LAS int*)(F.lds + TAB_OFF + 8 * 640 * 4);
    LAS int* baseL = cntL + 32;
    LAS int* asg = cntL + 64;
    const int fr = F.lane & 15, g4 = F.lane >> 4;
#pragma unroll 4
    for (int f = F.tid; f < 32 * 2 * 64; f += NWAVES * 64) { const int ks = f >> 7, ct = (f >> 6) & 1, ln = f & 63; const int col = 16 * ct + (ln & 15), k0 = 32 * ks + 8 * (ln >> 4);
        v4u h, l;
#pragma unroll
        for (int jp = 0; jp < 4; ++jp) { float w2[2];
#pragma unroll
            for (int e = 0; e < 2; ++e) { const int k = k0 + 2 * jp + e; w2[e] = (col < 4) ? gain[k] * wg[(size_t)k * 4 + col] : ((col < 20) ? gain[k] * we[(size_t)k * 16 + (col - 4)] : 0.f); }
            const unsigned h0 = f2bf(w2[0]), h1 = f2bf(w2[1]); h[jp] = h0 | (h1 << 16);
            l[jp] = f2bf(w2[0] - bf2f((unsigned short)h0)) | (f2bf(w2[1] - bf2f((unsigned short)h1)) << 16); }
        *(LAS v4u*)(BIMG + (size_t)f * 16) = h; *(LAS v4u*)(BIMG + 65536 + (size_t)f * 16) = l; }
    if (F.tid < 32) cntL[F.tid] = 0;
    __syncthreads();
    const bf16* H1 = (const bf16*)(F.ws + WS_D); float* RSTD = (float*)(F.ws + WS_RSTD); float* RW = (float*)(F.ws + WS_RW);
    float bgv[4], bev[16];
#pragma unroll
    for (int i = 0; i < 4; ++i) bgv[i] = bg[i];
#pragma unroll
    for (int i = 0; i < 16; ++i) bev[i] = be[i];
    for (int blk = F.vcu; blk < T_ / 256; blk += F.G) {
        bf16x8 A0[16], A1[16];
#define P4_LDA(dst, tile, half) do { const GAS bf16x8* p_ = (const GAS bf16x8*)(H1 + (size_t)(blk * 256 + F.wave * 32 + (tile) * 16 + fr) * DM_ + (half) * 512 + 8 * g4); \
        _Pragma("unroll") for (int q_ = 0; q_ < 16; ++q_) dst[q_] = p_[4 * q_]; } while (0)
#define P4_MMA(src, half) do { _Pragma("unroll") for (int q_ = 0; q_ < 16; ++q_) { const int ks_ = (half) * 16 + q_; \
            const bf16x8 bh0 = *(const LAS bf16x8*)(BIMG + (ks_ * 2 + 0) * 1024 + F.lane * 16), bh1 = *(const LAS bf16x8*)(BIMG + (ks_ * 2 + 1) * 1024 + F.lane * 16); \
            const bf16x8 bl0 = *(const LAS bf16x8*)(BIMG + 65536 + (ks_ * 2 + 0) * 1024 + F.lane * 16), bl1 = *(const LAS bf16x8*)(BIMG + 65536 + (ks_ * 2 + 1) * 1024 + F.lane * 16); \
            acc0 = __builtin_amdgcn_mfma_f32_16x16x32_bf16(src[q_], bh0, acc0, 0, 0, 0); acc1 = __builtin_amdgcn_mfma_f32_16x16x32_bf16(src[q_], bh1, acc1, 0, 0, 0); \
            acc0 = __builtin_amdgcn_mfma_f32_16x16x32_bf16(src[q_], bl0, acc0, 0, 0, 0); acc1 = __builtin_amdgcn_mfma_f32_16x16x32_bf16(src[q_], bl1, acc1, 0, 0, 0); \
            accs = __builtin_amdgcn_mfma_f32_16x16x32_bf16(src[q_], src[q_], accs, 0, 0, 0); } } while (0)
        P4_LDA(A0, 0, 0); P4_LDA(A1, 0, 1);
#pragma unroll
        for (int tile = 0; tile < 2; ++tile) {
            f32x4 acc0 = {0.f, 0.f, 0.f, 0.f}, acc1 = {0.f, 0.f, 0.f, 0.f}, accs = {0.f, 0.f, 0.f, 0.f};
            P4_MMA(A0, 0); if (tile == 0) P4_LDA(A0, 1, 0);
            P4_MMA(A1, 1); if (tile == 0) P4_LDA(A1, 1, 1);
#pragma unroll
            for (int rg = 0; rg < 4; ++rg) { LGW[(4 * g4 + rg) * 33 + fr] = acc0[rg]; LGW[(4 * g4 + rg) * 33 + 16 + fr] = acc1[rg]; }
            { const float d = (fr & 3) == 0 ? accs[0] : ((fr & 3) == 1 ? accs[1] : ((fr & 3) == 2 ? accs[2] : accs[3])); if ((fr >> 2) == g4) LGW[528 + fr] = d; }
            asm volatile("s_waitcnt lgkmcnt(0)" ::: "memory");
            if (F.lane < 16) { const int rl = F.wave * 32 + tile * 16 + F.lane; const int tok = blk * 256 + rl;
                float lg[20];
#pragma unroll
                for (int q = 0; q < 20; ++q) lg[q] = LGW[F.lane * 33 + q];
                const float rq = 1.f / sqrtf(LGW[528 + F.lane] * (1.f / DM_) + EPS_);
                float g[4]; int gs = 0;
#pragma unroll
                for (int i = 0; i < 4; ++i) g[i] = lg[i] * rq + bgv[i];
                float gm = g[0];
#pragma unroll
                for (int i = 1; i < 4; ++i) if (g[i] > gm) { gm = g[i]; gs = i; }
                float den = 0.f;
#pragma unroll
                for (int i = 0; i < 4; ++i) den += expf(g[i] - gm);
                const float pg = 1.f / den;
                float e[4];
#pragma unroll
                for (int i = 0; i < 4; ++i) { float xx = 0.f;
#pragma unroll
                    for (int q = 0; q < 4; ++q) xx = (q == gs) ? (lg[4 + q * 4 + i] * rq + bev[q * 4 + i]) : xx;
                    e[i] = xx; }
                int i0 = 0; float e0v = e[0];
#pragma unroll
                for (int i = 1; i < 4; ++i) if (e[i] > e0v) { e0v = e[i]; i0 = i; }
                int i1 = -1; float e1v = -3.0e38f;
#pragma unroll
                for (int i = 0; i < 4; ++i) if (i != i0 && e[i] > e1v) { e1v = e[i]; i1 = i; }
                if (i1 < 0) i1 = (i0 + 1) & 3;
                const float p1r = expf(e1v - e0v); const float w0 = pg / (1.f + p1r), w1 = pg * p1r / (1.f + p1r);
                const int a = i0 < i1 ? i0 : i1, b2 = i0 < i1 ? i1 : i0; const int pidx = (a == 0) ? (b2 - 1) : ((a == 1) ? (b2 + 1) : 5); const int bk = gs * 6 + pidx;
                RW[tok * 2] = (i0 < i1) ? w0 : w1; RW[tok * 2 + 1] = (i0 < i1) ? w1 : w0; RSTD[tok] = rq;
                const int la = __hip_atomic_fetch_add(cntL + bk, 1, __ATOMIC_RELAXED, __HIP_MEMORY_SCOPE_WORKGROUP);
                asg[rl] = bk | (la << 8); }
            asm volatile("s_waitcnt lgkmcnt(0)" ::: "memory");
        }
#undef P4_LDA
#undef P4_MMA
    __syncthreads();
    if (!DRY && F.tid < NBK_) { const int c = cntL[F.tid]; baseL[F.tid] = (int)__hip_atomic_fetch_add((unsigned*)(F.ctl + CW_CNT + F.tid), (unsigned)c, RLX_AGENT); }
    __syncthreads();
    if (!DRY && F.tid < 256) { int* ENTRY = (int*)(F.ws + WS_ENTRY); const int a = asg[F.tid]; const int bk = a & 0xff, lp = a >> 8;
      ENTRY[(size_t)bk * T_ + baseL[bk] + lp] = blk * 256 + F.tid; }
    __syncthreads();
    if (F.tid < 32) cntL[F.tid] = 0;
    __syncthreads();
    }
}
constexpr int TB_OFF = TAB_OFF + 23 * 1024;
__device__ __forceinline__ void moe_tables(Frame& F, bool down) {
    LAS int* tb = (LAS int*)(F.lds + TB_OFF);
    if (F.tid < NBK_) tb[32 + F.tid] = (int)F.ctl[CW_CNT + F.tid];
    __syncthreads();
    if (F.tid == 0) { int base = 0;
        for (int b = 0; b < NBK_; ++b) { tb[b] = base; base += (tb[32 + b] + 255) >> 8; }
        tb[NBK_] = base; }
    __syncthreads();
    const int NT = tb[NBK_]; const int sh = down ? 2 : 3; const int* ENTRY = (const int*)(F.ws + WS_ENTRY); const float* RW = (const float*)(F.ws + WS_RW); const float* RSTD = (const float*)(F.ws + WS_RSTD);
    int tbr[NBK_];
#pragma unroll
    for (int j = 0; j < NBK_; ++j) tbr[j] = tb[j];
    int tkv[11];
#pragma unroll
    for (int i = 0; i < 11; ++i) { int g, half; tkv[i] = -1;
        if (pg8::moe_deal(i, F.vcu, F.G, NT << sh, g, half, down) && F.tid < 256) { const int rt = g >> sh; int bk = 0;
#pragma unroll
            for (int j = 1; j < NBK_; ++j) bk = (rt >= tbr[j]) ? j : bk;
            const int cnt = tb[32 + bk]; const int pos = (rt - tb[bk]) * 256 + F.tid;
            if (pos < cnt) tkv[i] = ENTRY[(size_t)bk * T_ + pos]; } }
#pragma unroll
    for (int i = 0; i < 11; ++i) { int g, half;
        if (pg8::moe_deal(i, F.vcu, F.G, NT << sh, g, half, down) && F.tid < 256) { const int t = tkv[i]; const bool valid = t >= 0;
            if (!down) { const float w = valid ? RW[t * 2 + ((g >> 2) & 1)] : 0.f;
                ((LAS unsigned*)(F.lds + TAB_OFF))[i * 512 + F.tid] = valid ? ((unsigned)t | (f2bf(w) << 16)) : 0u; ((LAS float*)(F.lds + TAB_OFF))[i * 512 + 256 + F.tid] = valid ? RSTD[t] : 0.f; }
            else ((LAS int*)(F.lds + TAB_OFF))[i * 256 + F.tid] = t; } }
    __syncthreads();
}
template <bool DRY  > __device__ __forceinline__ void p7_final(Frame& F) {
    const int gw = F.vcu * NWAVES + F.wave, NGW = F.G * NWAVES;
    const float* gain = F.in[16]; const bf16* Y = (const bf16*)(F.ws + WS_Y); const bf16* H1 = (const bf16*)(F.ws + WS_D);
    f32x4 gv[4];
#pragma unroll
    for (int j = 0; j < 4; ++j) gv[j] = *(const GAS f32x4*)(gain + 256 * j + 4 * F.lane);
    const bool poison = __hip_atomic_load(F.ctl + 2, RLX_AGENT) != 0u;
    v2u na[4], nd[4];
#define P7_LOAD(mm) do { const GAS v2u* d_ = (const GAS v2u*)(H1 + (size_t)(mm) * DM_) + F.lane; const GAS v2u* y0_ = (const GAS v2u*)(Y + (size_t)(mm) * DM_) + F.lane; \
        _Pragma("unroll") for (int j = 0; j < 4; ++j) { na[j] = y0_[64 * j]; nd[j] = d_[64 * j]; } } while (0)
    if (gw < T_) P7_LOAD(gw);
    for (int m = gw; m < T_; m += NGW) {
        GAS f32x4* xr = (GAS f32x4*)((DRY ? (float*)(F.ws + 778 * MiB) : F.out) + (size_t)(DRY ? (m & 32767) : m) * DM_) + F.lane;
        f32x4 v[4]; v2u ya[4]; float s = 0.f;
#pragma unroll
        for (int j = 0; j < 4; ++j) { const v2u d = nd[j]; v[j] = (f32x4){bflo(d.x), bfhi(d.x), bflo(d.y), bfhi(d.y)}; ya[j] = na[j]; }
        if (m + NGW < T_) P7_LOAD(m + NGW);
#pragma unroll
        for (int j = 0; j < 4; ++j) { const v2u a = ya[j];
            v[j].x += bflo(a.x); v[j].y += bfhi(a.x); v[j].z += bflo(a.y); v[j].w += bfhi(a.y);
            s += (v[j].x * v[j].x + v[j].y * v[j].y) + (v[j].z * v[j].z + v[j].w * v[j].w); }
        const float rstd = 1.f / sqrtf(wave_sum(s) * (1.f / DM_) + EPS_);
#pragma unroll
        for (int j = 0; j < 4; ++j) xr[64 * j] = v[j] * (poison ? 1.5f * rstd : rstd) * gv[j];
    }
#undef P7_LOAD
}
namespace attn_body {
using bf16=__hip_bfloat16;
using bf16x8=__attribute__((ext_vector_type(8)))short;
using s16x4=__attribute__((ext_vector_type(4)))short;
using f32x16=__attribute__((ext_vector_type(16)))float;
using u32x4=__attribute__((ext_vector_type(4)))unsigned;
constexpr int BATCH=32,NHEAD=8,SEQ=2048,D=64,DM=3584,DMO=1024;
constexpr int NW=8,QBLK=32,QB=QBLK*NW,KVBLK=64,NQB=SEQ/QB;
constexpr int ATTN_PITCH=DM, ATTN_UNIT_ROWS=QB;
__device__ __forceinline__ int crow(int r,int hi){return (r&3)+8*(r>>2)+4*hi;}
#define SBAR() __builtin_amdgcn_sched_barrier(0)
__device__ __forceinline__ void cmask(f32x16&p0,f32x16&p1,int jb,int qrel,int hi){
  const float NEG=-INFINITY; int kb=64*jb+4*hi;
  #pragma unroll
  for(int r=0;r<16;++r){int kv=kb+(r&3)+8*(r>>2); if(kv>qrel)p0[r]=NEG; if(kv+32>qrel)p1[r]=NEG;}
}

constexpr int NSLOT=3, SLOTB=8192;
constexpr int LDS_K=0, LDS_V=NSLOT*SLOTB, LDS_WS=2*NSLOT*SLOTB, LDS_OST=LDS_WS+NW*64*4, LDS_KB=LDS_OST+NW*4096, LDS_SCAN=LDS_KB+SEQ*16, LDS_NRM=LDS_SCAN+64, LDS_TIL=LDS_NRM+2*SEQ*4, LDS_BYTES=LDS_TIL+512;
typedef float f32x4_t __attribute__((ext_vector_type(4)));
constexpr float C2=0.125f*1.4426950408889634f;
__device__ __forceinline__ void glds16s(const void*sbase,unsigned voff,unsigned lds_dst){unsigned keep;
  asm volatile("s_mov_b32 %0, m0\n\ts_mov_b32 m0, %3\n\ts_nop 0\n\tglobal_load_lds_dwordx4 %1, %2\n\ts_mov_b32 m0, %0":"=&s"(keep):"v"(voff),"s"(sbase),"s"(lds_dst):"memory");}
__device__ __forceinline__ void glds16(const void*gsrc,unsigned lds_dst){unsigned keep;
  asm volatile("s_mov_b32 %0, m0\n\ts_mov_b32 m0, %2\n\ts_nop 0\n\tglobal_load_lds_dwordx4 %1, off\n\ts_mov_b32 m0, %0":"=&s"(keep):"v"(gsrc),"s"(lds_dst):"memory");}
__device__ __forceinline__ float max3f(float a,float b,float c){float r;asm("v_max3_f32 %0, %1, %2, %3":"=v"(r):"v"(a),"v"(b),"v"(c));return r;}
__device__ __forceinline__ float max2f(float a,float b){float r;asm("v_max_f32_e32 %0, %1, %2":"=v"(r):"v"(a),"v"(b));return r;}
__device__ __forceinline__ float fadd_s(float a,float b){float r;asm("v_add_f32_e32 %0, %1, %2":"=v"(r):"v"(a),"v"(b));return r;}
__device__ __forceinline__ float fsub_s(float a,float b){float r;asm("v_sub_f32_e32 %0, %1, %2":"=v"(r):"v"(a),"v"(b));return r;}
typedef float f32x2_t __attribute__((ext_vector_type(2))); typedef __bf16 bf16x2_t __attribute__((ext_vector_type(2)));
__device__ __forceinline__ unsigned cvtpk_s(float lo,float hi){f32x2_t v={lo,hi};bf16x2_t b=__builtin_convertvector(v,bf16x2_t);return __builtin_bit_cast(unsigned,b);}
#define WAIT_BAR(N) asm volatile("s_waitcnt vmcnt(" #N ") lgkmcnt(0)\n\ts_barrier":::"memory")

__device__ __forceinline__ void qkt(f32x16&p0,f32x16&p1,const char*Kslot,const bf16x8*qr,const f32x16&negm,int r32,int hi){
  const char*kb=Kslot+hi*1024+r32*16;
  #pragma unroll
  for(int d0=0;d0<4;++d0){
    const bf16x8 b0=*reinterpret_cast<const bf16x8*>(kb+d0*2048);
    const bf16x8 b1=*reinterpret_cast<const bf16x8*>(kb+d0*2048+512);
    if(d0==0){p0=__builtin_amdgcn_mfma_f32_32x32x16_bf16(b0,qr[0],negm,0,0,0);p1=__builtin_amdgcn_mfma_f32_32x32x16_bf16(b1,qr[0],negm,0,0,0);}
    else{p0=__builtin_amdgcn_mfma_f32_32x32x16_bf16(b0,qr[d0],p0,0,0,0);p1=__builtin_amdgcn_mfma_f32_32x32x16_bf16(b1,qr[d0],p1,0,0,0);}}
}
typedef __attribute__((address_space(3))) const char* lds_cptr;
typedef short v4i16_t __attribute__((ext_vector_type(4)));
__device__ __forceinline__ void kload8(bf16x8*kf,lds_cptr kp){
  kf[0]=*(const __attribute__((address_space(3))) bf16x8*)(kp);      kf[1]=*(const __attribute__((address_space(3))) bf16x8*)(kp+512);
  kf[2]=*(const __attribute__((address_space(3))) bf16x8*)(kp+2048); kf[3]=*(const __attribute__((address_space(3))) bf16x8*)(kp+2560);
  kf[4]=*(const __attribute__((address_space(3))) bf16x8*)(kp+4096); kf[5]=*(const __attribute__((address_space(3))) bf16x8*)(kp+4608);
  kf[6]=*(const __attribute__((address_space(3))) bf16x8*)(kp+6144); kf[7]=*(const __attribute__((address_space(3))) bf16x8*)(kp+6656);
}
__device__ __forceinline__ void kload2(bf16x8*kf,lds_cptr kp,int j){ kf[2*j]=*(const __attribute__((address_space(3))) bf16x8*)(kp+j*2048); kf[2*j+1]=*(const __attribute__((address_space(3))) bf16x8*)(kp+j*2048+512); }
__device__ __forceinline__ s16x4 vtr(lds_cptr p){ return __builtin_bit_cast(s16x4,__builtin_amdgcn_ds_read_tr16_b64_v4i16((__attribute__((address_space(3))) v4i16_t*)p)); }
__device__ __forceinline__ float rowmax(const f32x16&p0,const f32x16&p1){
  float a=max3f(p0[0],p0[1],p1[0]),b=max3f(p0[2],p0[3],p1[1]);a=max3f(a,p1[2],p1[3]);
  #pragma unroll
  for(int r=4;r<16;r+=4){a=max3f(a,p0[r],p0[r+1]);b=max3f(b,p0[r+2],p0[r+3]);a=max3f(a,p1[r],p1[r+1]);b=max3f(b,p1[r+2],p1[r+3]);}
  const float m=max2f(a,b);
  auto rr=__builtin_amdgcn_permlane32_swap(__float_as_uint(m),__float_as_uint(m),false,false);
  return max2f(__uint_as_float(rr[0]),__uint_as_float(rr[1]));
}
__device__ __forceinline__ void pv(f32x16*o,int vb,bf16x8 pa0,bf16x8 pa1,bf16x8 pa2,bf16x8 pa3){
  #pragma unroll
  for(int d0=0;d0<2;++d0){s16x4 lo[4],hi[4];
    #pragma unroll
    for(int ks=0;ks<4;++ks){
      asm volatile("ds_read_b64_tr_b16 %0,%1 offset:%c2":"=&v"(lo[ks]):"v"(vb),"i"(d0*4096+ks*1024):"memory");
      asm volatile("ds_read_b64_tr_b16 %0,%1 offset:%c2":"=&v"(hi[ks]):"v"(vb),"i"(d0*4096+ks*1024+512):"memory");}
    asm volatile("s_waitcnt lgkmcnt(0)":::"memory");SBAR();
    #define PK(k) (bf16x8){lo[k][0],lo[k][1],lo[k][2],lo[k][3],hi[k][0],hi[k][1],hi[k][2],hi[k][3]}
    o[d0]=__builtin_amdgcn_mfma_f32_32x32x16_bf16(pa0,PK(0),o[d0],0,0,0);
    o[d0]=__builtin_amdgcn_mfma_f32_32x32x16_bf16(pa1,PK(1),o[d0],0,0,0);
    o[d0]=__builtin_amdgcn_mfma_f32_32x32x16_bf16(pa2,PK(2),o[d0],0,0,0);
    o[d0]=__builtin_amdgcn_mfma_f32_32x32x16_bf16(pa3,PK(3),o[d0],0,0,0);
    #undef PK
  }
}

#ifndef ATTN_STORE16
#define ATTN_STORE16(p,v) (*(u32x4*)(p)=(v))
#endif
template<int CTRL> __device__ __forceinline__ float dpp_f(float v){ return __int_as_float(__builtin_amdgcn_update_dpp(0,__float_as_int(v),CTRL,0xf,0xf,true)); }
__device__ __forceinline__ void split3(float x,unsigned&h,unsigned&m,unsigned&l){
  h=cvtpk_s(x,0.f)&0xffffu; const float r1=x-__uint_as_float(h<<16); m=cvtpk_s(r1,0.f)&0xffffu; const float r2=r1-__uint_as_float(m<<16); l=cvtpk_s(r2,0.f)&0xffffu; }
__device__ __forceinline__ bf16x8 mkqp(float s,int hi){ unsigned h,m,l; split3(s,h,m,l); u32x4 w; w[0]=0x3f803f80u; w[1]=0x3f80u|(h<<16); w[2]=m|(l<<16); w[3]=0u; if(hi){w[0]=0u;w[1]=0u;w[2]=0u;} return __builtin_bit_cast(bf16x8,w); }
template<int THRL> __device__ __forceinline__ void attn_unit(int b,int h,int qb,const bf16*Q,const bf16*__restrict__ K,const bf16*__restrict__ V,bf16*O,const float*__restrict__ gain,char*shm,int t0,bf16x8(&qr)[4],const bool primed,int&qbn,const int t0n_,unsigned*claim){
  int t0n=t0n_; const bool dyn=claim!=nullptr;
  int tid_=threadIdx.x; asm volatile("":"+v"(tid_));
  const int tid=tid_,lane=tid&63,r32=lane&31,hi=lane>>5; const int wid=__builtin_amdgcn_readfirstlane(tid>>6);
  int claimv=0; if(dyn&&tid==0)claimv=(int)__hip_atomic_fetch_add(claim,1u,__ATOMIC_RELAXED,__HIP_MEMORY_SCOPE_AGENT);
  const long rowbase=(long)b*SEQ; const int q0=qb*QB;
  const bf16*Qw=Q+(rowbase+q0+wid*QBLK)*DM+h*D;
  const bf16*Kh=K+(rowbase+(long)t0*KVBLK)*DM+h*D,*Vh=V+(rowbase+(long)t0*KVBLK)*DM+h*D;
  const unsigned lds0=(unsigned)(uintptr_t)shm;
  float*wsf=(float*)(shm+LDS_WS)+wid*64;
  const unsigned koff=(unsigned)(lane*DM+wid*8)*2u;
  const unsigned voff=(unsigned)((16*(wid&3)+(lane>>2))*DM+(wid>>2)*32+(lane&3)*8)*2u;
  const unsigned kdst=lds0+LDS_K+wid*1024, vdst=lds0+LDS_V+wid*1024;
  #define DMA_KP(base,t,slot) glds16s((base)+(long)(t)*KVBLK*DM,koff,(unsigned)__builtin_amdgcn_readfirstlane(kdst+(slot)))
  #define DMA_VP(base,t,slot) glds16s((base)+(long)(t)*KVBLK*DM,voff,(unsigned)__builtin_amdgcn_readfirstlane(vdst+(slot)))
  #define DMA_K(t,slot) DMA_KP(Kh,t,slot)
  #define DMA_V(t,slot) DMA_VP(Vh,t,slot)
  #define PRIME(KB,VB,QW,QR) do{ DMA_KP(KB,0,0);DMA_VP(VB,0,0);DMA_KP(KB,1,SLOTB); \
    _Pragma("unroll") for(int d0=0;d0<4;++d0)QR[d0]=*reinterpret_cast<const bf16x8*>(&(QW)[(long)r32*DM+d0*16+hi*8]); DMA_KP(KB,2,2*SLOTB); }while(0)
  const int vb0=(int)(lds0+LDS_V)+((lane>>4)&1)*32+(lane&3)*8+(4*hi+((lane&15)>>2))*64;
  const char*Kbase=shm+LDS_K; bf16x8 kf[8];
  const lds_cptr shm3=(lds_cptr)shm; const lds_cptr kp0=shm3+LDS_K+hi*1024+r32*16; const lds_cptr vp0=shm3+LDS_V+((lane>>4)&1)*32+(lane&3)*8+(4*hi+((lane&15)>>2))*64;
  const int NT=(q0+QB)/KVBLK-t0;
  if(!primed){ PRIME(Kh,Vh,Qw,qr); }
  const int qrel=wid*QBLK+r32;
  const lds_cptr kb3=(lds_cptr)shm+LDS_KB+t0*1024+r32*16;
  float cq; { const u32x4 e=*(const __attribute__((address_space(3))) u32x4*)((lds_cptr)shm+LDS_KB+(q0+qrel)*16); cq=-((__uint_as_float(e[0]<<16)+__uint_as_float(e[0]&0xffff0000u))+__uint_as_float(e[1]<<16)); }
  float mhat=0.f,l_reg=0.f;f32x16 o[2];o[0]=f32x16{};o[1]=f32x16{}; const f32x16 negm=f32x16{};
  bf16x8 qp=mkqp(cq,hi);
  #define CMASK(P0,P1,t) do{int jb_=(t)-(NT-4); if(jb_>=0)cmask(P0,P1,jb_,qrel,hi);}while(0)
  bool resc=false;
  #define START(P0,P1) do{ const float rm=rowmax(P0,P1); resc=false; \
    { const float dl=__builtin_fmaxf(rm,0.f); mhat=fadd_s(mhat,dl); \
      _Pragma("unroll") for(int r=0;r<16;++r){P0[r]=fsub_s(P0[r],dl);P1[r]=fsub_s(P1[r],dl);} \
      qp=mkqp(cq-mhat,hi); } \
    _Pragma("unroll") for(int r=0;r<16;++r)P0[r]=__builtin_amdgcn_exp2f(P0[r]); }while(0)
  #define RESC() do{ if(resc){ asm volatile("s_waitcnt lgkmcnt(0)":::"memory"); \
      _Pragma("unroll") for(int d_=0;d_<2;++d_) _Pragma("unroll") for(int r=0;r<16;++r)o[d_][r]*=wsf[crow(r,hi)]; } }while(0)
  f32x16 pA0,pA1,pB0,pB1;
  int sl_prev=0,sl_cur=0,sl_next=SLOTB;
  #define ROT() do{sl_prev=sl_cur;sl_cur=sl_next;sl_next=(sl_next==(NSLOT-1)*SLOTB)?0:sl_next+SLOTB;}while(0)
  WAIT_BAR(3);
  if(dyn&&tid==0)((int*)(shm+LDS_TIL))[104]=claimv;
  qkt(pA0,pA1,Kbase,qr,negm,r32,hi);
  { const bf16x8 kb0_=*(const __attribute__((address_space(3))) bf16x8*)(kb3), kb1_=*(const __attribute__((address_space(3))) bf16x8*)(kb3+512);
    pA0=__builtin_amdgcn_mfma_f32_32x32x16_bf16(kb0_,qp,pA0,0,0,0); pA1=__builtin_amdgcn_mfma_f32_32x32x16_bf16(kb1_,qp,pA1,0,0,0); }
  asm volatile("s_nop 15\n\ts_nop 7":"+v"(pA0),"+v"(pA1));CMASK(pA0,pA1,0);
  START(pA0,pA1);
  _Pragma("unroll") for(int r=0;r<16;++r)pA1[r]=__builtin_amdgcn_exp2f(pA1[r]);
  WAIT_BAR(0);
  DMA_K(3,0);DMA_V(1,SLOTB);
  ROT();
  kload8(kf,kp0+sl_cur);
  WAIT_BAR(2);
  s16x4 vlo[8],vhi[8]; u32x4 pw0,pw1,pw2,pw3;
  #define PKW(P,B) cvtpk_s(P[B],P[B+1])
  #define PAF(k) __builtin_bit_cast(bf16x8,pw##k)
  #define VFR(i) (bf16x8){vlo[i][0],vlo[i][1],vlo[i][2],vlo[i][3],vhi[i][0],vhi[i][1],vhi[i][2],vhi[i][3]}
  #define PIN(x) asm volatile("":"+v"(x))
  #define MX3(a,b,c) __builtin_fmaxf(__builtin_fmaxf((a),(b)),(c))
  #define GAPA(MF,A0,A1,A2,A3,W0,W1,PW) do{ MF; sacc+=A0; sacc+=A1; sacc+=A2; sacc+=A3; PIN(sacc); W0; W1; PIN(PW); SBAR(); }while(0)
  #define EX(v) __builtin_amdgcn_exp2f(v)
  #define GAPB(MF,X,B) do{ MF; X[B]=EX(X[B]); X[B+1]=EX(X[B+1]); X[B+2]=EX(X[B+2]); X[B+3]=EX(X[B+3]); PIN(X); SBAR(); }while(0)
  #define VRD(i) do{ vlo[i]=vtr(vp_+(((i)>>2)*4096+((i)&3)*1024)); vhi[i]=vtr(vp_+(((i)>>2)*4096+((i)&3)*1024+512)); }while(0)
  #define KRD(G,j) do{ if(G){ kload2(kf,kp0+sl_next,j); SBAR(); } }while(0)
  #define STEP(C0,C1,P0,P1,t,GK,GV,GL) do{ SBAR(); \
    const lds_cptr vp_=vp0+sl_prev; \
    const bf16x8 kb0_=*(const __attribute__((address_space(3))) bf16x8*)(kb3+(t)*1024), kb1_=*(const __attribute__((address_space(3))) bf16x8*)(kb3+(t)*1024+512); \
    VRD(0); SBAR(); float sacc=(P0[0]+P0[1]); \
    GAPA(C0=__builtin_amdgcn_mfma_f32_32x32x16_bf16(kf[0],qr[0],negm,0,0,0), P0[2],P0[3],P0[4],P0[5],     pw0[0]=PKW(P0,0), pw0[1]=PKW(P0,2), pw0); \
    VRD(4); SBAR(); GAPA(C1=__builtin_amdgcn_mfma_f32_32x32x16_bf16(kf[1],qr[0],negm,0,0,0), P0[6],P0[7],P0[8],P0[9],     pw0[2]=PKW(P0,4), pw0[3]=PKW(P0,6), pw0); \
    VRD(1); SBAR(); GAPA(C0=__builtin_amdgcn_mfma_f32_32x32x16_bf16(kf[2],qr[1],C0,0,0,0),   P0[10],P0[11],P0[12],P0[13], pw1[0]=PKW(P0,8), pw1[1]=PKW(P0,10), pw1); \
    VRD(5); SBAR(); GAPA(C1=__builtin_amdgcn_mfma_f32_32x32x16_bf16(kf[3],qr[1],C1,0,0,0),   P0[14],P0[15],P1[0],P1[1],   pw1[2]=PKW(P0,12),pw1[3]=PKW(P0,14), pw1); \
    VRD(2); SBAR(); GAPA(C0=__builtin_amdgcn_mfma_f32_32x32x16_bf16(kf[4],qr[2],C0,0,0,0),   P1[2],P1[3],P1[4],P1[5],     pw2[0]=PKW(P1,0), pw2[1]=PKW(P1,2), pw2); \
    VRD(6); SBAR(); GAPA(C1=__builtin_amdgcn_mfma_f32_32x32x16_bf16(kf[5],qr[2],C1,0,0,0),   P1[6],P1[7],P1[8],P1[9],     pw2[2]=PKW(P1,4), pw2[3]=PKW(P1,6), pw2); \
    VRD(3); SBAR(); GAPA(C0=__builtin_amdgcn_mfma_f32_32x32x16_bf16(kf[6],qr[3],C0,0,0,0),   P1[10],P1[11],P1[12],P1[13], pw3[0]=PKW(P1,8), pw3[1]=PKW(P1,10), pw3); \
    VRD(7); SBAR(); GAPA(C1=__builtin_amdgcn_mfma_f32_32x32x16_bf16(kf[7],qr[3],C1,0,0,0),   P1[14],P1[15],0.f,0.f,       pw3[2]=PKW(P1,12),pw3[3]=PKW(P1,14), pw3); \
    C0=__builtin_amdgcn_mfma_f32_32x32x16_bf16(kb0_,qp,C0,0,0,0); C1=__builtin_amdgcn_mfma_f32_32x32x16_bf16(kb1_,qp,C1,0,0,0); \
    l_reg+=sacc; \
    if(GK){DMA_K((t)+3,sl_cur);} if(GV){DMA_V((t)+1,sl_next);} \
    CMASK(C0,C1,t); \
    { float a=MX3(C0[0],C0[1],C1[0]),b=MX3(C0[2],C0[3],C1[1]); a=MX3(a,C1[2],C1[3]); \
      _Pragma("unroll") for(int r=4;r<16;r+=4){a=MX3(a,C0[r],C0[r+1]);b=MX3(b,C0[r+2],C0[r+3]);a=MX3(a,C1[r],C1[r+1]);b=MX3(b,C1[r+2],C1[r+3]);} \
      float rm=__builtin_fmaxf(a,b); { auto rr=__builtin_amdgcn_permlane32_swap(__float_as_uint(rm),__float_as_uint(rm),false,false); rm=__builtin_fmaxf(__uint_as_float(rr[0]),__uint_as_float(rr[1])); } \
      resc=false; \
      if(__builtin_expect(__any(rm>(float)THRL),0)){ const float dl=__builtin_fmaxf(rm,0.f); mhat+=dl; \
        _Pragma("unroll") for(int r=0;r<16;++r){C0[r]-=dl;C1[r]-=dl;} \
        qp=mkqp(cq-mhat,hi); \
        const float f=__builtin_amdgcn_exp2f(-dl); l_reg*=f; if(hi==0)wsf[r32]=f; resc=true; } } \
    SBAR(); \
    GAPB(o[0]=__builtin_amdgcn_mfma_f32_32x32x16_bf16(PAF(0),VFR(0),o[0],0,0,0), C0,0); \
    GAPB(o[1]=__builtin_amdgcn_mfma_f32_32x32x16_bf16(PAF(0),VFR(4),o[1],0,0,0), C0,4); \
    KRD(GL,0); GAPB(o[0]=__builtin_amdgcn_mfma_f32_32x32x16_bf16(PAF(1),VFR(1),o[0],0,0,0), C0,8); \
    KRD(GL,1); GAPB(o[1]=__builtin_amdgcn_mfma_f32_32x32x16_bf16(PAF(1),VFR(5),o[1],0,0,0), C0,12); \
    KRD(GL,2); GAPB(o[0]=__builtin_amdgcn_mfma_f32_32x32x16_bf16(PAF(2),VFR(2),o[0],0,0,0), C1,0); \
    KRD(GL,3); GAPB(o[1]=__builtin_amdgcn_mfma_f32_32x32x16_bf16(PAF(2),VFR(6),o[1],0,0,0), C1,4); \
    GAPB(o[0]=__builtin_amdgcn_mfma_f32_32x32x16_bf16(PAF(3),VFR(3),o[0],0,0,0), C1,8); \
    GAPB(o[1]=__builtin_amdgcn_mfma_f32_32x32x16_bf16(PAF(3),VFR(7),o[1],0,0,0), C1,12); \
    }while(0)
  int t=1;
  #undef CMASK
  #define CMASK(P0,P1,t) do{}while(0)
  for(;t+5<NT;t+=2){
    STEP(pB0,pB1,pA0,pA1,t,true,true,true);     WAIT_BAR(2); RESC(); ROT();
    STEP(pA0,pA1,pB0,pB1,t+1,true,true,true);   WAIT_BAR(2); RESC(); ROT();
  }
  #undef CMASK
  #define CMASK(P0,P1,t) do{int jb_=(t)-(NT-4); if(jb_>=0)cmask(P0,P1,jb_,qrel,hi);}while(0)
  #define ENDW(tt) do{ if((tt)+3<NT){WAIT_BAR(2);} else if((tt)+2<NT){WAIT_BAR(1);} else {WAIT_BAR(0);} }while(0)
  for(;t+1<NT;t+=2){
    STEP(pB0,pB1,pA0,pA1,t,(t+3<NT),(t+1<NT),(t+1<NT));       ENDW(t);   RESC(); ROT();
    STEP(pA0,pA1,pB0,pB1,t+1,(t+4<NT),(t+2<NT),(t+2<NT));     ENDW(t+1); RESC(); ROT();
  }
  STEP(pB0,pB1,pA0,pA1,NT-1,false,false,false); RESC();
  { float sacc=pB0[0]+pB0[1]; _Pragma("unroll") for(int r=2;r<16;++r)sacc+=pB0[r]; _Pragma("unroll") for(int r=0;r<16;++r)sacc+=pB1[r]; l_reg+=sacc;
    pw0=(u32x4){PKW(pB0,0),PKW(pB0,2),PKW(pB0,4),PKW(pB0,6)};pw1=(u32x4){PKW(pB0,8),PKW(pB0,10),PKW(pB0,12),PKW(pB0,14)};pw2=(u32x4){PKW(pB1,0),PKW(pB1,2),PKW(pB1,4),PKW(pB1,6)};pw3=(u32x4){PKW(pB1,8),PKW(pB1,10),PKW(pB1,12),PKW(pB1,14)};
    SBAR(); pv(o,vb0+sl_cur,PAF(0),PAF(1),PAF(2),PAF(3)); }
  asm volatile("s_waitcnt lgkmcnt(0)\n\ts_barrier":::"memory");
  if(dyn){ const int n_=__builtin_amdgcn_readfirstlane(((const int*)(shm+LDS_TIL))[104]); qbn=(n_<NQB)?NQB-1-n_:-1; t0n=__builtin_amdgcn_readfirstlane(((const int*)(shm+LDS_TIL))[96+(qbn<0?0:qbn)]); }
  bf16x8 qn[4];
  if(qbn>=0){ const bf16*Khn=K+(rowbase+(long)t0n*KVBLK)*DM+h*D,*Vhn=V+(rowbase+(long)t0n*KVBLK)*DM+h*D; const bf16*Qwn=Q+(rowbase+qbn*QB+wid*QBLK)*DM+h*D; PRIME(Khn,Vhn,Qwn,qn); }
  #undef PKW
  #undef PAF
  #undef VFR
  #undef PIN
  #undef MX3
  #undef GAPA
  #undef GAPB
  #undef EX
  #undef VRD
  #undef KRD
  #undef STEP
  #undef ENDW
  {auto rr=__builtin_amdgcn_permlane32_swap(__float_as_uint(l_reg),__float_as_uint(l_reg),false,false);l_reg=__uint_as_float(rr[0])+__uint_as_float(rr[1]);}
  if(hi==0)wsf[32+r32]=l_reg;asm volatile("s_waitcnt lgkmcnt(0)":::"memory");
  float rli[16];
  #pragma unroll
  for(int r=0;r<16;++r)rli[r]=__builtin_amdgcn_rcpf(wsf[32+crow(r,hi)]);
  bf16*Ow=O+(rowbase+q0+wid*QBLK)*DMO+h*D;
  { bf16*stg=(bf16*)(shm+LDS_OST)+wid*2048;
    #pragma unroll
    for(int r=0;r<16;++r){const int orow=crow(r,hi);
      #pragma unroll
      for(int d0=0;d0<2;++d0)stg[orow*64+d0*32+r32]=__float2bfloat16(o[d0][r]*rli[r]);}
    asm volatile("s_waitcnt lgkmcnt(0)":::"memory");
    const int ch=lane&7; const f32x4_t g0=*(const f32x4_t*)(gain+ch*8), g1=*(const f32x4_t*)(gain+ch*8+4);
    #pragma unroll
    for(int i=0;i<4;++i){const int row=i*8+(lane>>3); const u32x4 v=*(const u32x4*)(stg+row*64+ch*8);
      float f[8];
      #pragma unroll
      for(int e=0;e<4;++e){ f[2*e]=__uint_as_float(v[e]<<16); f[2*e+1]=__uint_as_float(v[e]&0xffff0000u); }
      float ss=(f[0]*f[0]+f[1]*f[1])+(f[2]*f[2]+f[3]*f[3])+(f[4]*f[4]+f[5]*f[5])+(f[6]*f[6]+f[7]*f[7]);
      ss+=dpp_f<0xB1>(ss); ss+=dpp_f<0x4E>(ss); ss+=dpp_f<0x141>(ss);
      const float rs=__builtin_amdgcn_rsqf(ss*(1.f/64.f)+1e-6f);
      u32x4 w; w[0]=cvtpk_s(f[0]*rs*g0[0],f[1]*rs*g0[1]); w[1]=cvtpk_s(f[2]*rs*g0[2],f[3]*rs*g0[3]); w[2]=cvtpk_s(f[4]*rs*g1[0],f[5]*rs*g1[1]); w[3]=cvtpk_s(f[6]*rs*g1[2],f[7]*rs*g1[3]);
      ATTN_STORE16(Ow+(long)row*DMO+ch*8,w);} }
  if(qbn>=0){
    #pragma unroll
    for(int d0=0;d0<4;++d0)qr[d0]=qn[d0]; }
  #undef DMA_K
  #undef DMA_V
  #undef DMA_KP
  #undef DMA_VP
  #undef PRIME
  #undef CMASK
  #undef START
  #undef RESC
  #undef ROT
}
constexpr int ATTN_LDS_BYTES=LDS_BYTES;
template<int THRL=8> __device__ __forceinline__ void attn_bh(char*lds,const bf16*U,bf16*MIX,const float*__restrict__ FLG,const float*__restrict__ gain,int bh,int qlo,int qhi,unsigned*claim,const unsigned*ktab,const unsigned*qtab){
  const int tid=threadIdx.x,lane=tid&63,wid=tid>>6;
  { const int b=bh/NHEAD,h=bh%NHEAD;
    { float a[4];
      #pragma unroll
      for(int i=0;i<4;++i)a[i]=FLG[((size_t)b*SEQ+4*tid+i)*8+h];
      a[1]+=a[0];a[2]+=a[1];a[3]+=a[2];
      float sc=a[3];
      int lo_=lane; asm volatile("":"+v"(lo_));
      #pragma unroll
      for(int o=1;o<64;o<<=1){const float n=__int_as_float(__builtin_amdgcn_ds_bpermute(((lo_-o)&63)<<2,__float_as_int(sc))); if(lo_>=o)sc+=n;}
      float*ws=(float*)(lds+LDS_SCAN);
      if(lane==63)ws[wid]=sc;
      __syncthreads();
      float base=0.f;
      #pragma unroll
      for(int w=0;w<NW;++w)base+=(w<wid)?ws[w]:0.f;
      const float ex=base+sc-a[3];
      #pragma unroll
      for(int i=0;i<4;++i){ unsigned hh,mm,ll; split3(-(ex+a[i])*1.4426950408889634f,hh,mm,ll); u32x4 e; e[0]=hh|(mm<<16); e[1]=ll|0x3f800000u; e[2]=0x3f803f80u; e[3]=0u; *(u32x4*)(lds+LDS_KB+16*(4*tid+i))=e; }
      __syncthreads(); }
    { float* til=(float*)(lds+LDS_TIL); unsigned* tilu=(unsigned*)(lds+LDS_TIL);
      if(tid<128)tilu[tid]=0u;
      __syncthreads();
      if(tid<32)til[tid]=__uint_as_float(ktab[(bh*2+0)*32+tid])+__uint_as_float(ktab[(bh*2+1)*32+tid]);
      else if(tid>=64&&tid<72)til[tid]=__uint_as_float(qtab[(bh*2+0)*8+(tid-64)])+__uint_as_float(qtab[(bh*2+1)*8+(tid-64)]);
      if(tid<32){ const u32x4 e=*(const u32x4*)(lds+LDS_KB+16*(64*tid+63)); til[32+tid]=-((__uint_as_float(e[0]<<16)+__uint_as_float(e[0]&0xffff0000u))+__uint_as_float(e[1]<<16)); }
      else if(tid<40){ const int bq=tid-32; const u32x4 e=*(const u32x4*)(lds+LDS_KB+16*(256*bq)); til[72+bq]=-((__uint_as_float(e[0]<<16)+__uint_as_float(e[0]&0xffff0000u))+__uint_as_float(e[1]<<16)); }
      __syncthreads(); }
    if(tid<NQB){ const float* til=(const float*)(lds+LDS_TIL); const int qb=tid; const float qn2=til[64+qb]*1.0001f, cq0=til[72+qb]; int t0=4*qb;
      for(int j=0;j<4*qb;++j){ const float bound=sqrtf(qn2*til[j])*1.0001f+cq0-til[32+j]; if(!(bound<-150.f)){ t0=j; break; } }
      ((int*)(lds+LDS_TIL))[96+qb]=t0&~1; }
    __syncthreads();
    { bf16x8 qr[4]; bool primed=false; const bool dyn=claim!=nullptr; const int* t0t=(const int*)(lds+LDS_TIL)+96;
      int qb=qhi-1;
      if(dyn){ if(tid==0)((int*)(lds+LDS_TIL))[105]=(int)__hip_atomic_fetch_add(claim,1u,__ATOMIC_RELAXED,__HIP_MEMORY_SCOPE_AGENT); __syncthreads(); const int n_=__builtin_amdgcn_readfirstlane(((const int*)(lds+LDS_TIL))[105]); qb=(n_<NQB)?NQB-1-n_:-1; }
      while(qb>=qlo){ const int t0=__builtin_amdgcn_readfirstlane(t0t[qb]);
        int qbn=(!dyn&&qb>qlo)?qb-1:-1; const int t0n=__builtin_amdgcn_readfirstlane(t0t[qbn<0?0:qbn]);
        attn_unit<THRL>(b,h,qb,U+2048,U+2560,U+3072,MIX+512,gain,lds,t0,qr,primed,qbn,t0n,claim); primed=(qbn>=0); qb=qbn; } }
    __syncthreads();
  }
}
template<int THRL=8,class Pre> __device__ __forceinline__ void attn_phase(char*lds,const bf16*U,bf16*MIX,const float*__restrict__ FLG,const float*__restrict__ gain,int vcu,int G,unsigned*claims,const unsigned*ktab,const unsigned*qtab,const Pre&pre){
  for(int it=0;;++it){ int bh,qlo=0,qhi=NQB; unsigned*claim=nullptr;
    if(G==256){ if(vcu<128){ if(it>0)break; bh=vcu; claim=claims+vcu; } else { if(it>1)break; bh=it?vcu-128:vcu; if(it)claim=claims+(vcu-128); } }
    else { bh=vcu+it*G; if(bh>=BATCH*NHEAD)break; }
    pre(it);
    attn_bh<THRL>(lds,U,MIX,FLG,gain,bh,qlo,qhi,claim,ktab,qtab); }
  pre(-1);
}
#undef SBAR
#undef WAIT_BAR
}
namespace hgrn_body {
typedef unsigned short bf16;
typedef short bf16x8 __attribute__((ext_vector_type(8)));
typedef short s16x4 __attribute__((ext_vector_type(4)));
typedef float f32x4 __attribute__((ext_vector_type(4)));
typedef float f32x2 __attribute__((ext_vector_type(2)));
typedef unsigned u32x4 __attribute__((ext_vector_type(4)));
typedef unsigned u32x2 __attribute__((ext_vector_type(2)));
#define HL __attribute__((address_space(3)))
constexpr int SEQ = 2048, NCH = SEQ / 64, UP = 3584, MP = 1024, NUNITS = 32 * 4;
constexpr int QS = 272, PS = 144, OS = 132;
constexpr int QSET = 64 * QS;
constexpr int L_Q = 0, L_K = L_Q + 2 * QSET, L_P = L_K + 2 * QSET, L_V = L_P + 64 * PS, L_O = L_V + 2 * 16384, L_SEG = L_O + 64 * OS * 4, L_ER = L_SEG + 8 * 128 * 4, L_END = L_ER + 2 * 1024;
static_assert(L_END <= 155648, "HGRN LDS map");
__device__ __forceinline__ unsigned pk(float lo, float hi) { typedef __bf16 b2 __attribute__((ext_vector_type(2))); const f32x2 v = {lo, hi}; const b2 b = __builtin_convertvector(v, b2); return __builtin_bit_cast(unsigned, b); }
__device__ __forceinline__ float blo(unsigned w) { return __builtin_bit_cast(float, w << 16); }
__device__ __forceinline__ float bhi(unsigned w) { return __builtin_bit_cast(float, w & 0xffff0000u); }
__device__ __forceinline__ float ex2(float x) { return __builtin_amdgcn_exp2f(x); }
template <int CTRL> __device__ __forceinline__ float dppf(float v) { return __builtin_bit_cast(float, __builtin_amdgcn_update_dpp(0, __builtin_bit_cast(int, v), CTRL, 0xf, 0xf, true)); }
__device__ __forceinline__ s16x4 trd(HL char* p) { return __builtin_bit_cast(s16x4, __builtin_amdgcn_ds_read_tr16_b64_v4i16((HL s16x4*)p)); }
#define HBAR() do { asm volatile("s_waitcnt lgkmcnt(0)" ::: "memory"); __builtin_amdgcn_s_barrier(); asm volatile("" ::: "memory"); } while (0)
#define HMF(a, b, c) __builtin_amdgcn_mfma_f32_16x16x32_bf16((a), (b), (c), 0, 0, 0)

template <int VAR  >
__device__ __forceinline__ void hgrn_unit(char* lds_, const bf16* __restrict__ U, bf16* MIX, const float* __restrict__ gain, int b, int h) {
    HL char* lds = (HL char*)lds_;
    int tid_ = threadIdx.x; asm volatile("" : "+v"(tid_));
    const int tid = tid_, lane = tid & 63, w = __builtin_amdgcn_readfirstlane(tid >> 6), fr = lane & 15, g = lane >> 4;
    const size_t row0 = (size_t)b * SEQ;
    const bf16* Uq = U + row0 * UP + h * 128;
    const int ot = tid >> 3, oj = tid & 7;
    f32x4 gn[4];
#pragma unroll
    for (int i = 0; i < 4; ++i) gn[i] = *(const f32x4*)(gain + 16 * oj + 4 * i);
    unsigned rq[8], rl[8]; u32x4 sgc0, sgc1;
    float cx[8], cy[8];
    f32x4 S[8];
#pragma unroll
    for (int i = 0; i < 8; ++i) S[i] = (f32x4){0.f, 0.f, 0.f, 0.f};
#define H_LOAD_RAW(c) do { _Pragma("unroll") for (int i_ = 0; i_ < 8; ++i_) { const bf16* p_ = Uq + (size_t)((c) * 64 + 8 * w + i_) * UP + 2 * lane; rq[i_] = *(const unsigned*)p_; rl[i_] = *(const unsigned*)(p_ + 512); } } while (0)
#define H_DMA_V(c, slot) do { _Pragma("unroll") for (int i_ = 0; i_ < 2; ++i_) \
        __builtin_amdgcn_global_load_lds((const unsigned*)(Uq + 1024 + (size_t)((c) * 64 + 8 * w + 4 * i_ + (lane >> 4)) * UP + (lane & 15) * 8), (HL unsigned*)(lds + L_V + (slot) * 16384 + (8 * w + 4 * i_) * 256), 16, 0, 0); } while (0)
#define H_LOAD_SG(c, d0, d1) do { const bf16* p_ = Uq + 1536 + (size_t)((c) * 64 + ot) * UP + 16 * oj; d0 = *(const u32x4*)p_; d1 = *(const u32x4*)(p_ + 8); } while (0)
#define H_PREP1() do { float ax_ = 0.f, ay_ = 0.f; \
        _Pragma("unroll") for (int i = 0; i < 8; ++i) { ax_ += blo(rl[i]); ay_ += bhi(rl[i]); cx[i] = ax_; cy[i] = ay_; } \
        *(HL f32x2*)(lds + L_SEG + (w * 128 + 2 * lane) * 4) = (f32x2){ax_, ay_}; } while (0)
#define H_PREP2(set) do { float px = 0.f, py = 0.f, rx = 0.f, ry = 0.f, tx = 0.f, ty = 0.f; \
        _Pragma("unroll") for (int ww = 0; ww < 8; ++ww) { const f32x2 s = *(HL f32x2*)(lds + L_SEG + (ww * 128 + 2 * lane) * 4); \
            px += (ww < w) ? s.x : 0.f; py += (ww < w) ? s.y : 0.f; if (ww < 4) { rx += s.x; ry += s.y; } tx += s.x; ty += s.y; } \
        _Pragma("unroll") for (int i = 0; i < 8; ++i) { const float bx = px + cx[i], by = py + cy[i]; \
            const float qx = blo(rq[i]) * ex2(bx - rx), qy = bhi(rq[i]) * ex2(by - ry); \
            const float kx = (1.f - ex2(blo(rl[i]))) * ex2(rx - bx), ky = (1.f - ex2(bhi(rl[i]))) * ex2(ry - by); \
            const int t = 8 * w + i; \
            *(HL unsigned*)(lds + L_Q + (set) * QSET + t * QS + 4 * lane) = pk(qx, qy); \
            *(HL unsigned*)(lds + L_K + (set) * QSET + t * QS + 4 * lane) = pk(kx, ky); } \
        if (w == 0) { *(HL f32x2*)(lds + L_ER + (set) * 1024 + (2 * lane) * 4) = (f32x2){ex2(rx), ex2(ry)}; *(HL f32x2*)(lds + L_ER + (set) * 1024 + 512 + (2 * lane) * 4) = (f32x2){ex2(tx - rx), ex2(ty - ry)}; } } while (0)
#define H_OUTPUT(cc) do { f32x4 o[4]; float ss = 0.f; \
        _Pragma("unroll") for (int i = 0; i < 4; ++i) { o[i] = *(HL f32x4*)(lds + L_O + (ot * OS + 16 * oj + 4 * i) * 4); ss += (o[i][0] * o[i][0] + o[i][1] * o[i][1]) + (o[i][2] * o[i][2] + o[i][3] * o[i][3]); } \
        ss += dppf<0xB1>(ss); ss += dppf<0x4E>(ss); ss += dppf<0x141>(ss); \
        const float rs = __builtin_amdgcn_rsqf(ss * (1.f / 128.f) + 1e-6f); \
        const unsigned sgw[8] = {sgc0[0], sgc0[1], sgc0[2], sgc0[3], sgc1[0], sgc1[1], sgc1[2], sgc1[3]}; \
        u32x4 y0, y1; \
        _Pragma("unroll") for (int i = 0; i < 4; ++i) { const float a0 = o[i][0] * rs * gn[i][0] * blo(sgw[2 * i]), a1 = o[i][1] * rs * gn[i][1] * bhi(sgw[2 * i]); \
            const float a2 = o[i][2] * rs * gn[i][2] * blo(sgw[2 * i + 1]), a3 = o[i][3] * rs * gn[i][3] * bhi(sgw[2 * i + 1]); \
            if (i < 2) { y0[2 * i] = pk(a0, a1); y0[2 * i + 1] = pk(a2, a3); } else { y1[2 * (i - 2)] = pk(a0, a1); y1[2 * (i - 2) + 1] = pk(a2, a3); } } \
        bf16* op = MIX + (row0 + (size_t)(cc) * 64 + ot) * MP + h * 128 + 16 * oj; \
        *(u32x4*)op = y0; *(u32x4*)(op + 8) = y1; } while (0)
    H_LOAD_RAW(0); H_DMA_V(0, 0); sgc0 = (u32x4){0u, 0u, 0u, 0u}; sgc1 = sgc0;
    H_PREP1(); HBAR(); H_PREP2(0); H_LOAD_RAW(1); HBAR();
    for (int c = 0; c < NCH; ++c) {
        const int set = c & 1;
        asm volatile("s_waitcnt vmcnt(0)" ::: "memory");
        if (VAR != 1 && c + 1 < NCH) H_DMA_V(c + 1, (c + 1) & 1);
        if (c > 0) H_OUTPUT(c - 1);
        if (VAR != 1) H_LOAD_SG(c, sgc0, sgc1);
        if (VAR != 2 && c + 1 < NCH) H_PREP1();
#pragma unroll
        for (int q = 0; q < 2; ++q) { const int ti = 2 * w + q, tt = ti >> 2, st = ti & 3;
            f32x4 acc = {0.f, 0.f, 0.f, 0.f};
            if (st <= tt) {
                bf16x8 pa[4], pb[4];
#pragma unroll
                for (int ks = 0; ks < 4; ++ks) { pa[ks] = *(HL bf16x8*)(lds + L_K + set * QSET + (16 * st + fr) * QS + (32 * ks + 8 * g) * 2); pb[ks] = *(HL bf16x8*)(lds + L_Q + set * QSET + (16 * tt + fr) * QS + (32 * ks + 8 * g) * 2); }
#pragma unroll
                for (int ks = 0; ks < 4; ++ks) if (VAR != 3) acc = HMF(pa[ks], pb[ks], acc);
                const int dlt = 16 * (tt - st) + fr - 4 * g;
#pragma unroll
                for (int r = 0; r < 4; ++r) acc[r] = (r > dlt) ? 0.f : acc[r];
                asm volatile("" : "+v"(acc));
            }
            *(HL u32x2*)(lds + L_P + (16 * tt + fr) * PS + (16 * st + 4 * g) * 2) = (u32x2){pk(acc[0], acc[1]), pk(acc[2], acc[3])}; }
        f32x4 O[4];
#pragma unroll
        for (int i = 0; i < 4; ++i) O[i] = (f32x4){0.f, 0.f, 0.f, 0.f};
#pragma unroll
        for (int kt = 0; kt < 8; ++kt) S[kt] = S[kt] * *(HL f32x4*)(lds + L_ER + set * 1024 + (16 * kt + 4 * g) * 4);
        bf16x8 sf[4];
#pragma unroll
        for (int ks = 0; ks < 4; ++ks) { u32x4 p; p[0] = pk(S[2 * ks][0], S[2 * ks][1]); p[1] = pk(S[2 * ks][2], S[2 * ks][3]); p[2] = pk(S[2 * ks + 1][0], S[2 * ks + 1][1]); p[3] = pk(S[2 * ks + 1][2], S[2 * ks + 1][3]); sf[ks] = __builtin_bit_cast(bf16x8, p); }
#pragma unroll
        for (int th = 0; th < 2; ++th) {
            u32x2 flo[2][4], fhi[2][4];
#pragma unroll
            for (int t2 = 0; t2 < 2; ++t2)
#pragma unroll
                for (int ks = 0; ks < 4; ++ks) { const int tt = 2 * th + t2; flo[t2][ks] = *(HL u32x2*)(lds + L_Q + set * QSET + (16 * tt + fr) * QS + (32 * ks + 4 * g) * 2); fhi[t2][ks] = *(HL u32x2*)(lds + L_Q + set * QSET + (16 * tt + fr) * QS + (32 * ks + 16 + 4 * g) * 2); }
#pragma unroll
            for (int ks = 0; ks < 4; ++ks)
#pragma unroll
                for (int t2 = 0; t2 < 2; ++t2) { const u32x4 a4 = {flo[t2][ks][0], flo[t2][ks][1], fhi[t2][ks][0], fhi[t2][ks][1]}; if (VAR != 3) O[2 * th + t2] = HMF(__builtin_bit_cast(bf16x8, a4), sf[ks], O[2 * th + t2]); } }
        HBAR();
        if (c + 1 < NCH) { if (VAR != 2) H_PREP2(set ^ 1); if (VAR != 1 && c + 2 < NCH) H_LOAD_RAW(c + 2); }
        bf16x8 vf[2];
        { HL char* vb = lds + L_V + set * 16384 + (8 * g + (fr >> 2)) * 256 + (16 * w + 4 * (fr & 3)) * 2;
#pragma unroll
          for (int st = 0; st < 2; ++st) { const s16x4 lo = trd(vb + st * 32 * 256), hi = trd(vb + st * 32 * 256 + 4 * 256); vf[st] = (bf16x8){lo[0], lo[1], lo[2], lo[3], hi[0], hi[1], hi[2], hi[3]}; } }
        { bf16x8 pf[4][2];
#pragma unroll
          for (int tt = 0; tt < 4; ++tt)
#pragma unroll
            for (int st = 0; st < 2; ++st) { if (st == 1 && tt < 2) continue; pf[tt][st] = *(HL bf16x8*)(lds + L_P + (16 * tt + fr) * PS + (32 * st + 8 * g) * 2); }
#pragma unroll
          for (int st = 0; st < 2; ++st)
#pragma unroll
            for (int tt = 0; tt < 4; ++tt) { if (st == 1 && tt < 2) continue; if (VAR != 3) O[tt] = HMF(pf[tt][st], vf[st], O[tt]); } }
        { HL char* kb = lds + L_K + set * QSET + (8 * g + (fr >> 2)) * QS + (4 * (fr & 3)) * 2;
#pragma unroll
          for (int kh = 0; kh < 2; ++kh) {
            s16x4 tlo[4][2], thi[4][2];
#pragma unroll
            for (int k4 = 0; k4 < 4; ++k4)
#pragma unroll
                for (int st = 0; st < 2; ++st) { const int kt = 4 * kh + k4; tlo[k4][st] = trd(kb + st * 32 * QS + kt * 32); thi[k4][st] = trd(kb + st * 32 * QS + 4 * QS + kt * 32); }
#pragma unroll
            for (int st = 0; st < 2; ++st)
#pragma unroll
                for (int k4 = 0; k4 < 4; ++k4) { const bf16x8 a = (bf16x8){tlo[k4][st][0], tlo[k4][st][1], tlo[k4][st][2], tlo[k4][st][3], thi[k4][st][0], thi[k4][st][1], thi[k4][st][2], thi[k4][st][3]};
                    if (VAR != 3) S[4 * kh + k4] = HMF(a, vf[st], S[4 * kh + k4]); else asm volatile("" :: "v"(a)); } } }
#pragma unroll
        for (int kt = 0; kt < 8; ++kt) S[kt] = S[kt] * *(HL f32x4*)(lds + L_ER + set * 1024 + 512 + (16 * kt + 4 * g) * 4);
#pragma unroll
        for (int tt = 0; tt < 4; ++tt)
#pragma unroll
            for (int r = 0; r < 4; ++r) *(HL float*)(lds + L_O + ((16 * tt + 4 * g + r) * OS + 16 * w + fr) * 4) = O[tt][r];
        HBAR();
    }
    H_OUTPUT(NCH - 1);
#undef H_OUTPUT
#undef H_PREP1
#undef H_PREP2
#undef H_LOAD_RAW
#undef H_DMA_V
#undef H_LOAD_SG
}
template <int VAR = 0> __device__ __forceinline__ void hgrn_phase(char* lds, const bf16* U, bf16* MIX, const float* gain, int vcu, int G) {
    for (int u = vcu; u < NUNITS; u += G) { hgrn_unit<VAR>(lds, U, MIX, gain, u >> 2, u & 3); __syncthreads(); }
    __syncthreads();
}
#undef HL
#undef HBAR
#undef HMF
}
#if MK_OPT_MASK != 0xFF || defined(MK_NAIVE_HGRN) || defined(MK_NAIVE_ATTN) || defined(MK_OVERWRITE)
namespace nb {
__device__ __forceinline__ float wsum(float v) {
#pragma unroll
    for (int o = 1; o < 64; o <<= 1) v += __shfl_xor(v, o);
    return v;
}
__device__ __forceinline__ float siluf(float x) { return x / (1.f + expf(-x)); }
__device__ __forceinline__ float sigm(float x) { return 1.f / (1.f + expf(-x)); }
__device__ __forceinline__ unsigned short tobf(float f) { return (unsigned short)f2bf(f); }
struct NG { const bf16* A; int lda; const int* a_rows; const bf16* Bt; int ldb; const int* tile_e; size_t strideB; int M, N, K, mode; const int* Mdev;
            void* C; const float* R; const float* lb; const int* c_rows; const float* roww; };
__global__ void __launch_bounds__(256) k_ngemm(NG a) {
    __shared__ float As[32][68], Bs[32][68], Bs2[32][68];
    const int M = a.Mdev ? *a.Mdev : a.M;
    const int m0 = blockIdx.y * 64, n0 = blockIdx.x * 64;
    if (m0 >= M) return;
    const bf16* Bp = a.Bt; if (a.tile_e) Bp += (size_t)a.tile_e[m0 >> 8] * a.strideB;
    const int tid = threadIdx.x, tx = tid & 15, ty = tid >> 4;
    const int lr = tid >> 2, lk = (tid & 3) * 8;
    int arow = m0 + lr; bool aval = arow < M;
    if (aval && a.a_rows) { const int g = a.a_rows[arow]; aval = g >= 0; arow = g; }
    const bf16* Ap = a.A + (size_t)(aval ? arow : 0) * a.lda;
    const int j = n0 + lr; const bool dual = a.mode == 2;
    const int brow = dual ? ((j >> 7) * 256 + (j & 127)) : j;
    const bf16* Bq = Bp + (size_t)brow * a.ldb; const bf16* Bq2 = Bq + (size_t)128 * a.ldb;
    float acc[4][4] = {}, acc2[4][4] = {};
    for (int k0 = 0; k0 < a.K; k0 += 32) {
        uint4 av = aval ? *(const uint4*)(Ap + k0 + lk) : make_uint4(0, 0, 0, 0);
        uint4 bv = *(const uint4*)(Bq + k0 + lk); uint4 bv2 = make_uint4(0, 0, 0, 0); if (dual) bv2 = *(const uint4*)(Bq2 + k0 + lk);
        __syncthreads();
        { const unsigned w[4] = {av.x, av.y, av.z, av.w}; const unsigned x[4] = {bv.x, bv.y, bv.z, bv.w}; const unsigned y[4] = {bv2.x, bv2.y, bv2.z, bv2.w};
#pragma unroll
          for (int q = 0; q < 4; ++q) { As[lk + 2 * q][lr] = bflo(w[q]); As[lk + 2 * q + 1][lr] = bfhi(w[q]); Bs[lk + 2 * q][lr] = bflo(x[q]); Bs[lk + 2 * q + 1][lr] = bfhi(x[q]);
              if (dual) { Bs2[lk + 2 * q][lr] = bflo(y[q]); Bs2[lk + 2 * q + 1][lr] = bfhi(y[q]); } } }
        __syncthreads();
#pragma unroll
        for (int kk = 0; kk < 32; ++kk) {
            const float4 a4 = *(const float4*)&As[kk][ty * 4]; const float4 b4 = *(const float4*)&Bs[kk][tx * 4];
            const float aa[4] = {a4.x, a4.y, a4.z, a4.w}, bb[4] = {b4.x, b4.y, b4.z, b4.w};
#pragma unroll
            for (int i = 0; i < 4; ++i)
#pragma unroll
                for (int jj = 0; jj < 4; ++jj) acc[i][jj] = fmaf(aa[i], bb[jj], acc[i][jj]);
            if (dual) { const float4 c4 = *(const float4*)&Bs2[kk][tx * 4]; const float cc[4] = {c4.x, c4.y, c4.z, c4.w};
#pragma unroll
                for (int i = 0; i < 4; ++i)
#pragma unroll
                    for (int jj = 0; jj < 4; ++jj) acc2[i][jj] = fmaf(aa[i], cc[jj], acc2[i][jj]); }
        }
    }
#pragma unroll
    for (int i = 0; i < 4; ++i) {
        const int r = m0 + ty * 4 + i; if (r >= M) continue;
        const int c = n0 + tx * 4;
        float o[4] = {acc[i][0], acc[i][1], acc[i][2], acc[i][3]};
        if (a.mode == 0) { const int kind = c >> 9;
#pragma unroll
            for (int q = 0; q < 4; ++q) { float v = o[q];
                if (kind == 0 || kind == 3) v = siluf(v); else if (kind == 1) { const float l = a.lb[c + q - 512]; v = log2f(l + (1.f - l) * sigm(v)); } else if (kind == 4) v *= QSCALE_;
                ((bf16*)a.C)[(size_t)r * UC_ + c + q] = tobf(v); }
        } else if (a.mode == 1) {
#pragma unroll
            for (int q = 0; q < 4; ++q) ((bf16*)a.C)[(size_t)r * DM_ + c + q] = tobf(o[q]);
        } else if (a.mode == 2) {
#pragma unroll
            for (int q = 0; q < 4; ++q) ((bf16*)a.C)[(size_t)r * 512 + c + q] = tobf(siluf(o[q]) * acc2[i][q]);
        } else { const int cr = a.c_rows[r]; if (cr < 0) continue; const float w = a.roww[r];
            bf16* dst = (bf16*)a.C + (size_t)(cr & 1) * T_ * DM_ + (size_t)(cr >> 1) * DM_ + c;
#pragma unroll
            for (int q = 0; q < 4; ++q) dst[q] = tobf(w * o[q]); }
    }
}
__global__ void k_cum(const float* __restrict__ flg, float* __restrict__ cum) {
    const int i = blockIdx.x * blockDim.x + threadIdx.x; if (i >= NB_ * 8) return;
    const int b = i / 8, h = i % 8; double acc = 0.0;
    for (int s = 0; s < SEQ_; ++s) { acc += (double)flg[(size_t)(b * SEQ_ + s) * 8 + h]; cum[(size_t)(b * SEQ_ + s) * 8 + h] = (float)acc; }
}
__global__ void __launch_bounds__(128) k_hgrn(const bf16* __restrict__ u, float* __restrict__ oraw) {
    __shared__ float qs[16][128], fs[16][128], ks[16][128];
    const int b = blockIdx.x / 4, h = blockIdx.x % 4, v = threadIdx.x;
    float Sr[128];
#pragma unroll
    for (int k = 0; k < 128; ++k) Sr[k] = 0.f;
    for (int t0 = 0; t0 < SEQ_; t0 += 16) {
        __syncthreads();
        for (int i = 0; i < 16; ++i) { const bf16* ur = u + (size_t)(b * SEQ_ + t0 + i) * UC_ + h * 128 + v;
            const float f = exp2f(bf2f(ur[512])); qs[i][v] = bf2f(ur[0]); fs[i][v] = f; ks[i][v] = 1.f - f; }
        __syncthreads();
        for (int i = 0; i < 16; ++i) { const float iv = bf2f(u[(size_t)(b * SEQ_ + t0 + i) * UC_ + 1024 + h * 128 + v]); float o = 0.f;
#pragma unroll
            for (int k = 0; k < 128; ++k) { Sr[k] = fmaf(fs[i][k], Sr[k], ks[i][k] * iv); o = fmaf(qs[i][k], Sr[k], o); }
            oraw[(size_t)(b * SEQ_ + t0 + i) * 512 + h * 128 + v] = o; }
    }
}
__global__ void k_hnorm(const float* __restrict__ oraw, const bf16* __restrict__ u, const float* __restrict__ gain, bf16* __restrict__ mix) {
    const int w = (int)((blockIdx.x * (size_t)blockDim.x + threadIdx.x) >> 6), lane = threadIdx.x & 63;
    if (w >= T_ * 4) return;
    const int t = w / 4, h = w % 4;
    const float* orow = oraw + (size_t)t * 512 + h * 128; const float a = orow[lane], c = orow[lane + 64];
    const float r = rsqrtf(wsum(a * a + c * c) * (1.f / 128) + EPS_);
    const bf16* gr = u + (size_t)t * UC_ + 1536 + h * 128;
    mix[(size_t)t * DM_ + h * 128 + lane] = tobf(a * r * gain[lane] * bf2f(gr[lane]));
    mix[(size_t)t * DM_ + h * 128 + lane + 64] = tobf(c * r * gain[lane + 64] * bf2f(gr[lane + 64]));
}
__global__ void __launch_bounds__(64) k_attn(const bf16* __restrict__ u, const float* __restrict__ cum, const float* __restrict__ gain, bf16* __restrict__ mix) {
    __shared__ float Ks[64][64], Vs[64][64], Cs[64];
    const int qt = blockIdx.x % (SEQ_ / 64), bh = blockIdx.x / (SEQ_ / 64), h = bh % 8, b = bh / 8, lane = threadIdx.x;
    const int t = qt * 64 + lane;
    float q[64], o[64];
    const bf16* qrow = u + (size_t)(b * SEQ_ + t) * UC_ + 2048 + h * 64;
#pragma unroll
    for (int d = 0; d < 64; ++d) { q[d] = bf2f(qrow[d]); o[d] = 0.f; }
    const float ct = cum[(size_t)(b * SEQ_ + t) * 8 + h] * 1.4426950408889634f;
    float m = -1e30f, l = 0.f;
    for (int kt = 0; kt <= qt; ++kt) {
        __syncthreads();
        for (int i = 0; i < 64; ++i) { const bf16* kr = u + (size_t)(b * SEQ_ + kt * 64 + i) * UC_ + 2560 + h * 64; Ks[i][lane] = bf2f(kr[lane]); Vs[i][lane] = bf2f(kr[512 + lane]); }
        Cs[lane] = cum[(size_t)(b * SEQ_ + kt * 64 + lane) * 8 + h] * 1.4426950408889634f;
        __syncthreads();
        for (int s = 0; s < 64; ++s) {
            float x = 0.f;
#pragma unroll
            for (int d = 0; d < 64; ++d) x = fmaf(q[d], Ks[s][d], x);
            x += ct - Cs[s];
            const bool ok = (kt * 64 + s) <= t; if (!ok) x = -1e30f;
            const float mn = fmaxf(m, x); const float al = exp2f(m - mn); const float p = ok ? exp2f(x - mn) : 0.f;
            l = l * al + p; m = mn;
#pragma unroll
            for (int d = 0; d < 64; ++d) o[d] = fmaf(o[d], al, p * Vs[s][d]);
        }
    }
    float ss = 0.f; const float il = 1.f / l;
#pragma unroll
    for (int d = 0; d < 64; ++d) { o[d] *= il; ss += o[d] * o[d]; }
    const float r = rsqrtf(ss * (1.f / 64) + EPS_);
    bf16* orow = mix + (size_t)(b * SEQ_ + t) * DM_ + 512 + h * 64;
#pragma unroll
    for (int d = 0; d < 64; ++d) orow[d] = tobf(o[d] * r * gain[d]);
}
__global__ void k_route(const float* __restrict__ x0, const bf16* __restrict__ dd, const float* __restrict__ gain, const float* __restrict__ wg, const float* __restrict__ bg,
                        const float* __restrict__ we, const float* __restrict__ be, bf16* __restrict__ xn2, int* __restrict__ re, float* __restrict__ rw) {
    const int w = (int)((blockIdx.x * (size_t)blockDim.x + threadIdx.x) >> 6), lane = threadIdx.x & 63;
    if (w >= T_) return;
    const float4* xr = (const float4*)(x0 + (size_t)w * DM_); const float4* gr = (const float4*)gain;
    float4 v[4]; float s = 0.f;
#pragma unroll
    for (int j = 0; j < 4; ++j) { v[j] = xr[lane + 64 * j]; const bf16* dp = dd + (size_t)w * DM_ + (lane + 64 * j) * 4; v[j].x += bf2f(dp[0]); v[j].y += bf2f(dp[1]); v[j].z += bf2f(dp[2]); v[j].w += bf2f(dp[3]); s += v[j].x * v[j].x + v[j].y * v[j].y + v[j].z * v[j].z + v[j].w * v[j].w; }
    s = wsum(s); const float r = rsqrtf(s * (1.f / DM_) + EPS_);
    float lg[20];
#pragma unroll
    for (int i = 0; i < 20; ++i) lg[i] = 0.f;
#pragma unroll
    for (int j = 0; j < 4; ++j) { const float4 gg = gr[lane + 64 * j]; const float tv[4] = {v[j].x * r * gg.x, v[j].y * r * gg.y, v[j].z * r * gg.z, v[j].w * r * gg.w};
        bf16* xo = xn2 + (size_t)w * DM_ + (lane + 64 * j) * 4;
#pragma unroll
        for (int c = 0; c < 4; ++c) { xo[c] = tobf(tv[c]); const int d = (lane + 64 * j) * 4 + c; const float4 g4 = *(const float4*)(wg + (size_t)d * 4);
            lg[0] = fmaf(tv[c], g4.x, lg[0]); lg[1] = fmaf(tv[c], g4.y, lg[1]); lg[2] = fmaf(tv[c], g4.z, lg[2]); lg[3] = fmaf(tv[c], g4.w, lg[3]);
#pragma unroll
            for (int q = 0; q < 4; ++q) { const float4 e4 = *(const float4*)(we + (size_t)d * 16 + q * 4);
                lg[4 + q * 4 + 0] = fmaf(tv[c], e4.x, lg[4 + q * 4 + 0]); lg[4 + q * 4 + 1] = fmaf(tv[c], e4.y, lg[4 + q * 4 + 1]);
                lg[4 + q * 4 + 2] = fmaf(tv[c], e4.z, lg[4 + q * 4 + 2]); lg[4 + q * 4 + 3] = fmaf(tv[c], e4.w, lg[4 + q * 4 + 3]); } } }
#pragma unroll
    for (int i = 0; i < 20; ++i) lg[i] = wsum(lg[i]);
    if (lane == 0) {
        float g[4]; int gs = 0;
#pragma unroll
        for (int i = 0; i < 4; ++i) g[i] = lg[i] + bg[i];
        float gm = g[0];
#pragma unroll
        for (int i = 1; i < 4; ++i) if (g[i] > gm) { gm = g[i]; gs = i; }
        float den = 0.f;
#pragma unroll
        for (int i = 0; i < 4; ++i) den += expf(g[i] - gm);
        const float pg = 1.f / den;
        float e[4];
#pragma unroll
        for (int i = 0; i < 4; ++i) { float x = 0.f;
#pragma unroll
            for (int q = 0; q < 4; ++q) if (q == gs) x = lg[4 + q * 4 + i] + be[q * 4 + i];
            e[i] = x; }
        int i0 = 0; float e0v = e[0];
#pragma unroll
        for (int i = 1; i < 4; ++i) if (e[i] > e0v) { e0v = e[i]; i0 = i; }
        int i1 = -1; float e1v = -3.0e38f;
#pragma unroll
        for (int i = 0; i < 4; ++i) if (i != i0 && e[i] > e1v) { e1v = e[i]; i1 = i; }
        const float p1r = expf(e1v - e0v);
        re[w] = (gs * 4 + i0) | ((gs * 4 + i1) << 8);
        rw[w * 2 + 0] = pg / (1.f + p1r); rw[w * 2 + 1] = pg * p1r / (1.f + p1r);
    }
}
__global__ void k_assign(const int* __restrict__ re, int* __restrict__ cnt, int* __restrict__ entry) {
    const int t = blockIdx.x * blockDim.x + threadIdx.x; if (t >= T_) return;
    const int r = re[t];
#pragma unroll
    for (int k = 0; k < 2; ++k) { const int e = (r >> (8 * k)) & 0xff; const int pos = atomicAdd(&cnt[e], 1); entry[(size_t)e * T_ + pos] = t * 2 + k; }
}
__global__ void k_plan(const int* __restrict__ cnt, int* __restrict__ plan, int* __restrict__ tile_e) {
    if (threadIdx.x == 0 && blockIdx.x == 0) { int base = 0;
        for (int e = 0; e < NE_; ++e) { plan[e] = base; const int nt = (cnt[e] + 255) >> 8; for (int i = 0; i < nt; ++i) tile_e[(base >> 8) + i] = e; base += nt * 256; }
        plan[16] = base; plan[32] = base; }
}
__global__ void k_fill(const int* __restrict__ cnt, const int* __restrict__ plan, const int* __restrict__ entry, const float* __restrict__ rw, int* __restrict__ srow, float* __restrict__ sw, int* __restrict__ stok) {
    const int r = blockIdx.x * blockDim.x + threadIdx.x; if (r >= RMAX_) return;
    int tk = -1; float w = 0.f;
    if (r < plan[16]) { int e = 0;
#pragma unroll
        for (int i = 1; i < NE_; ++i) if (r >= plan[i]) e = i;
        const int pos = r - plan[e];
        if (pos < cnt[e]) { tk = entry[(size_t)e * T_ + pos]; w = rw[tk]; } }
    srow[r] = tk; sw[r] = w; stok[r] = tk < 0 ? -1 : (tk >> 1);
}
__global__ void k_final(const float* x0, const bf16* __restrict__ dd, const bf16* __restrict__ y, const float* __restrict__ g, float* out) {
    const int w = (int)((blockIdx.x * (size_t)blockDim.x + threadIdx.x) >> 6), lane = threadIdx.x & 63;
    if (w >= T_) return;
    const float4* xr = (const float4*)(x0 + (size_t)w * DM_); const float4* gr = (const float4*)g; float4* yr = (float4*)(out + (size_t)w * DM_);
    float4 v[4]; float s = 0.f;
#pragma unroll
    for (int j = 0; j < 4; ++j) { v[j] = xr[lane + 64 * j]; { const bf16* dp = dd + (size_t)w * DM_ + (lane + 64 * j) * 4; v[j].x += bf2f(dp[0]); v[j].y += bf2f(dp[1]); v[j].z += bf2f(dp[2]); v[j].w += bf2f(dp[3]); } const bf16* y0 = y + (size_t)w * DM_ + (lane + 64 * j) * 4; const bf16* y1 = y0 + (size_t)T_ * DM_;
        v[j].x += bf2f(y0[0]) + bf2f(y1[0]); v[j].y += bf2f(y0[1]) + bf2f(y1[1]); v[j].z += bf2f(y0[2]) + bf2f(y1[2]); v[j].w += bf2f(y0[3]) + bf2f(y1[3]);
        s += v[j].x * v[j].x + v[j].y * v[j].y + v[j].z * v[j].z + v[j].w * v[j].w; }
    s = wsum(s); const float r = rsqrtf(s * (1.f / DM_) + EPS_);
#pragma unroll
    for (int j = 0; j < 4; ++j) { const float4 gg = gr[lane + 64 * j]; float4 o; o.x = v[j].x * r * gg.x; o.y = v[j].y * r * gg.y; o.z = v[j].z * r * gg.z; o.w = v[j].w * r * gg.w; yr[lane + 64 * j] = o; }
}
}
#endif
constexpr int N_PHASES = 8;
struct Args { const float* in[17]; float* out; unsigned char* ws; int ph_lo, ph_hi, li, pad; };
__global__ void __launch_bounds__(NWAVES * 64, 2) mk_fwd(Args args) {
    extern __shared__ __attribute__((aligned(16))) unsigned char lds[];
    Frame F;
    F.lds = (LAS unsigned char*)lds;
    F.MISC = (volatile LAS unsigned*)(F.lds + MISC_OFF);
    F.tid = threadIdx.x; F.lane = F.tid & 63; F.wave = __builtin_amdgcn_readfirstlane(F.tid >> 6);
    F.G = gridDim.x; { const int bx = blockIdx.x; F.vcu = (F.G % 8 == 0) ? (bx % 8) * (F.G / 8) + bx / 8 : bx; }
    F.ws = args.ws; F.out = args.out;
#pragma unroll
    for (int i = 0; i < 17; ++i) F.in[i] = args.in[i];
    F.ctl = (gu32*)(args.ws + WS_CTL);
#if defined(MK_ZERO_LDS)
    for (int u = F.tid; u < LDSCTL_OFF / 4; u += NWAVES * 64) ((LAS unsigned*)(F.lds))[u] = 0u;
#endif
    for (int u = F.tid; u < (LDS_BYTES - LDSCTL_OFF) / 4; u += NWAVES * 64) ((LAS unsigned*)(F.lds + LDSCTL_OFF))[u] = 0u;
    __syncthreads();
    const int lo = args.ph_lo, hi = args.ph_hi;
    XcdBarrier bar; bar.bar = (unsigned*)(F.ctl + CW_BAR) + args.li * XCD_BAR_WORDS; bar.x = 0; bar.st = nullptr;
    if (hi - lo > 1) bar = xcd_barrier_post((unsigned*)(F.ctl + CW_BAR) + args.li * XCD_BAR_WORDS, F.MISC + 8);
#ifndef MK_PH_EN
#define MK_PH_EN 0xFF
#endif
#define IN(k) (((MK_PH_EN >> (k)) & 1) && lo <= (k) && (k) < hi)
#define BOTH(k) (IN(k) && IN((k) + 1))
#define GRID_BAR() xcd_barrier(bar)
#define P1_PROBE 0
#ifndef MK_REP_PHASE
#define MK_REP_PHASE -1
#endif
#ifndef MK_REP_SUB
#define MK_REP_SUB 0
#endif
#define NREP(k) ((MK_REP_PHASE == (k)) ? 2 : 1)
    bf16* XN = (bf16*)(F.ws + WS_XN); bf16* U = (bf16*)(F.ws + WS_U);

    if (IN(0)) { p0_prologue(F); if (BOTH(0)) GRID_BAR(); }

    if (IN(1)) {
        pg8::Gemm g{XN, (const bf16*)(F.ws + WS_WI), T_, UC_, DM_}; pg8::StaticOrder S; S.init(T_, UC_, F.G, (int)blockIdx.x);
        pg8::EpiU E{U, UC_, (const float*)(F.ws + WS_LB), QSCALE_, P1_PROBE, (long)(WS_CTL + (size_t)CW_KT * 4) - (long)WS_U};
        pg8::gemm_phase<pg8::EpiU, pg8::StaticOrder, true, true>(F.lds + RING_OFF, g, S, E);
        if (BOTH(1)) GRID_BAR();
    }

    if (IN(2)) {
#if !defined(MK_NAIVE_HGRN)
#if MK_REP_SUB == 1
#ifndef MK_HG_VAR
#define MK_HG_VAR 0
#endif
        hgrn_body::hgrn_phase<MK_HG_VAR>((char*)lds + RING_OFF, (const bf16*)U, (bf16*)(F.ws + WS_MIX), F.in[4], F.vcu, F.G);
#endif
        hgrn_body::hgrn_phase((char*)lds + RING_OFF, (const bf16*)U, (bf16*)(F.ws + WS_MIX), F.in[4], F.vcu, F.G);
#endif
#if defined(MK_SELFCHECK_HGRN)
#if defined(MK_SCRAMBLE_LDS)
        __syncthreads(); for (int u = F.tid; u < LDSCTL_OFF / 4; u += NWAVES * 64) ((LAS unsigned*)(F.lds))[u] = 0xFFFFFFFFu; __syncthreads();
#endif
        hgrn_body::hgrn_phase((char*)lds + RING_OFF, (const bf16*)U, (bf16*)(F.ws + WS_ORAW), F.in[4], F.vcu, F.G);
        asm volatile("s_waitcnt vmcnt(0)" ::: "memory"); __syncthreads();
        if (F.vcu < 128) { const int ub = F.vcu >> 2, uh = F.vcu & 3; unsigned bad = 0u;
            for (int i = F.tid; i < 2048 * 16; i += NWAVES * 64) { const size_t off = ((size_t)ub * 2048 + (i >> 4)) * 1024 + uh * 128 + (i & 15) * 8;
                const unsigned long long a0 = __hip_atomic_load((const unsigned long long*)(XN + off), RLX_AGENT), a1 = __hip_atomic_load((const unsigned long long*)(XN + off) + 1, RLX_AGENT);
                const unsigned long long b0 = __hip_atomic_load((const unsigned long long*)((const bf16*)(F.ws + WS_ORAW) + off), RLX_AGENT), b1 = __hip_atomic_load((const unsigned long long*)((const bf16*)(F.ws + WS_ORAW) + off) + 1, RLX_AGENT);
                bad |= (a0 != b0 || a1 != b1) ? 1u : 0u; }
            if (bad) __hip_atomic_store(F.ctl + 2, 1u, RLX_AGENT); }
        __syncthreads();
#endif
#if !defined(MK_NAIVE_ATTN)
        attn_body::attn_phase<8>((char*)lds + RING_OFF, (const attn_body::bf16*)U, (attn_body::bf16*)(F.ws + WS_MIX), (const float*)(F.ws + WS_FLG), F.in[6], F.vcu, F.G, (unsigned*)(F.ctl + CW_CLAIM), (const unsigned*)(F.ctl + CW_KT), (const unsigned*)(F.ctl + CW_QT),
            [&](int it) { if (F.G == 256 && it < 0) { __syncthreads(); Frame F2 = F; { int l_ = F.lane; asm volatile("" : "+v"(l_)); F2.lane = l_; }
                convert_items(F2, CONV_I_WI, CONV_I_REST, F.vcu * NWAVES + F.wave, F.G * NWAVES); __syncthreads(); } });
#endif
#if MK_REP_SUB == 2
        attn_body::attn_phase<8>((char*)lds + RING_OFF, (const attn_body::bf16*)U, (attn_body::bf16*)(F.ws + WS_MIX), (const float*)(F.ws + WS_FLG), F.in[6], F.vcu, F.G, (unsigned*)(F.ctl + CW_CLAIM), (const unsigned*)(F.ctl + CW_KT), (const unsigned*)(F.ctl + CW_QT),
            [&](int it) { if (F.G == 256 && it < 0) { __syncthreads(); Frame F2 = F; { int l_ = F.lane; asm volatile("" : "+v"(l_)); F2.lane = l_; }
                convert_items(F2, CONV_I_WI, CONV_I_REST, F.vcu * NWAVES + F.wave, F.G * NWAVES); __syncthreads(); } });
#endif

        if (BOTH(2)) GRID_BAR();
    }

    if (IN(3)) {
        pg8::Gemm g{(const bf16*)(F.ws + WS_MIX), (const bf16*)(F.ws + WS_WO), T_, DM_, DM_}; pg8::StaticOrder S; S.init(T_, DM_, F.G, (int)blockIdx.x);
        pg8::EpiH1 E{F.in[1], (bf16*)(F.ws + WS_D), DM_, (long)WS_XN - (long)WS_D, (long)WS_RMS0 - (long)WS_D};
        pg8::gemm_phase<pg8::EpiH1, pg8::StaticOrder, true, true>(F.lds + RING_OFF, g, S, E);
        if (BOTH(3)) GRID_BAR();
    }

#if defined(MK_TIME_P4)
    if (IN(4)) { p4_router<true>(F); GRID_BAR(); }
#endif
    if (IN(4)) { p4_router<false>(F); if (BOTH(4)) GRID_BAR(); }

    if (IN(5)) {
        moe_tables(F, false);
        pg8::MGemm g{(const bf16*)(F.ws + WS_D), (const bf16*)(F.ws + WS_WGU), DM_, DM_, 1024}; pg8::MoeOrderP<3> S{(LAS const int*)(F.lds + TB_OFF), F.G, F.vcu};
        pg8::EpiSwiglu E{(bf16*)(F.ws + WS_HB), (LAS const int*)(F.lds + TAB_OFF)};
        pg8::gemm_phase_moe<pg8::EpiSwiglu, pg8::MoeOrderP<3>, true, true, false>(F.lds + RING_OFF, (LAS const int*)(F.lds + TAB_OFF), g, S, E);
        if (BOTH(5)) GRID_BAR();
    }

    if (IN(6)) {
        moe_tables(F, true);
        pg8::MGemm g{(const bf16*)(F.ws + WS_HB), (const bf16*)(F.ws + WS_WD), 2 * EH_, EH_, 1024}; pg8::MoeOrderP<2> S{(LAS const int*)(F.lds + TB_OFF), F.G, F.vcu};
        pg8::EpiDown E{(bf16*)(F.ws + WS_Y), (LAS const int*)(F.lds + TAB_OFF)};
        pg8::gemm_phase_moe<pg8::EpiDown, pg8::MoeOrderP<2>, false, true, true>(F.lds + RING_OFF, (LAS const int*)(F.lds + TAB_OFF), g, S, E);
        if (BOTH(6)) GRID_BAR();
    }

#if defined(MK_TIME_P7)
    if (IN(7)) { p7_final<true>(F); GRID_BAR(); }
#endif
    if (IN(7)) { p7_final<false>(F); }
#undef IN
#undef BOTH
#undef GRID_BAR
}
extern "C" void kernel_launch(void* const* d_in, const int* in_sizes, int n_in, void* d_out, int out_size, void* d_ws, size_t ws_size, hipStream_t stream) {
    static int grid = 0;
    if (grid == 0) {
        if (n_in != 17 || in_sizes[0] != T_ * DM_ || out_size != T_ * DM_ || ws_size < WS_END) { fprintf(stderr, "kernel_launch: unexpected shapes (n_in %d, in0 %d, out %d, ws %zu); nothing launched\n", n_in, n_in > 0 ? in_sizes[0] : -1, out_size, ws_size); grid = -1; return; }
        int dev = 0, cus = 0, per_cu = 0;
        if (hipGetDevice(&dev) != hipSuccess || hipDeviceGetAttribute(&cus, hipDeviceAttributeMultiprocessorCount, dev) != hipSuccess) { grid = -1; return; }
        if (hipFuncSetAttribute((const void*)mk_fwd, hipFuncAttributeMaxDynamicSharedMemorySize, LDS_BYTES) != hipSuccess) { fprintf(stderr, "kernel_launch: hipFuncSetAttribute failed\n"); grid = -1; return; }
        if (hipOccupancyMaxActiveBlocksPerMultiprocessor(&per_cu, (const void*)mk_fwd, NWAVES * 64, LDS_BYTES) != hipSuccess || per_cu < 1)
            fprintf(stderr, "kernel_launch: note: occupancy query reports %d workgroups per CU\n", per_cu);
        (void)hipGetLastError();
        grid = cus;
    }
    if (grid < 0) return;
    unsigned char* ws = (unsigned char*)d_ws;
    if (hipMemsetAsync(ws + WS_CTL, 0, CTL_ZERO_BYTES, stream) != hipSuccess) return;
    Args a{};
    for (int i = 0; i < 17; ++i) a.in[i] = (const float*)d_in[i];
    a.out = (float*)d_out; a.ws = ws;
    int li = 0;
    for (int p = 0; p < N_PHASES;) {
        if ((MK_OPT_MASK >> p) & 1) { int q = p; while (q < N_PHASES && ((MK_OPT_MASK >> q) & 1)) ++q;
#if defined(MK_NAIVE_HGRN) || defined(MK_NAIVE_ATTN)
            if (p < 2 && q > 2) q = 2;
#endif
#if defined(MK_NAIVE_HGRN)
            if (p == 2) { nb::k_hgrn<<<NB_ * 4, 128, 0, stream>>>((const bf16*)(ws + WS_U), (float*)(ws + WS_ORAW)); nb::k_hnorm<<<T_ * 4 / 4, 256, 0, stream>>>((const float*)(ws + WS_ORAW), (const bf16*)(ws + WS_U), (const float*)d_in[4], (bf16*)(ws + WS_XN)); }
#endif
#if defined(MK_NAIVE_ATTN)
            if (p == 2) { nb::k_cum<<<1, 256, 0, stream>>>((const float*)(ws + WS_FLG), (float*)(ws + WS_CUM)); nb::k_attn<<<NB_ * 8 * (SEQ_ / 64), 64, 0, stream>>>((const bf16*)(ws + WS_U), (const float*)(ws + WS_CUM), (const float*)d_in[6], (bf16*)(ws + WS_XN)); }
#endif
#if defined(MK_OVERWRITE)
            { int c = p; while (c < q && !((MK_OVERWRITE >> c) & 1) && !(c == 2 && (MK_OVERWRITE & 0x300))) ++c; if (c < q) q = c + 1; }
#endif
            a.ph_lo = p; a.ph_hi = q; a.li = li++;
            hipLaunchKernelGGL(mk_fwd, dim3(grid), dim3(NWAVES * 64), LDS_BYTES, stream, a);
#if defined(MK_OVERWRITE)
            { const int k = q - 1; bf16* XNb = (bf16*)(ws + WS_XN); bf16* Ub = (bf16*)(ws + WS_U); float* outf = (float*)d_out;
              int* CNT = (int*)(ws + WS_CTL) + CW_CNT; int* PLAN = (int*)(ws + WS_CTL) + CW_PLAN;
              if (k == 1 && ((MK_OVERWRITE >> 1) & 1)) { nb::NG g{}; g.A = XNb; g.lda = DM_; g.Bt = (const bf16*)(ws + WS_WI); g.ldb = DM_; g.M = T_; g.N = UC_; g.K = DM_; g.mode = 0; g.C = Ub; g.lb = (const float*)(ws + WS_LB);
                  nb::k_ngemm<<<dim3(UC_ / 64, T_ / 64), 256, 0, stream>>>(g); }
              if (k == 2 && (MK_OVERWRITE & 0x100)) { nb::k_hgrn<<<NB_ * 4, 128, 0, stream>>>(Ub, (float*)(ws + WS_ORAW)); nb::k_hnorm<<<T_ * 4 / 4, 256, 0, stream>>>((const float*)(ws + WS_ORAW), Ub, (const float*)d_in[4], XNb); }
              if (k == 2 && (MK_OVERWRITE & 0x200)) { nb::k_cum<<<1, 256, 0, stream>>>((const float*)(ws + WS_FLG), (float*)(ws + WS_CUM)); nb::k_attn<<<NB_ * 8 * (SEQ_ / 64), 64, 0, stream>>>(Ub, (const float*)(ws + WS_CUM), (const float*)d_in[6], XNb); }
              if (k == 3 && ((MK_OVERWRITE >> 3) & 1)) { nb::NG g{}; g.A = XNb; g.lda = DM_; g.Bt = (const bf16*)(ws + WS_WO); g.ldb = DM_; g.M = T_; g.N = DM_; g.K = DM_; g.mode = 1; g.C = (bf16*)(ws + WS_D);
                  nb::k_ngemm<<<dim3(DM_ / 64, T_ / 64), 256, 0, stream>>>(g); }
              if ((k == 5 && ((MK_OVERWRITE >> 5) & 1)) || (k == 6 && ((MK_OVERWRITE >> 6) & 1))) {
                  nb::k_plan<<<1, 64, 0, stream>>>(CNT, PLAN, (int*)(ws + WS_TILEE)); nb::k_fill<<<(RMAX_ + 255) / 256, 256, 0, stream>>>(CNT, PLAN, (const int*)(ws + WS_ENTRY), (const float*)(ws + WS_RW), (int*)(ws + WS_SROW), (float*)(ws + WS_SW), (int*)(ws + WS_STOK));
                  nb::NG g{}; g.tile_e = (const int*)(ws + WS_TILEE); g.Mdev = PLAN + 16; g.M = RMAX_;
                  if (k == 5) { g.A = XNb; g.lda = DM_; g.a_rows = (const int*)(ws + WS_STOK); g.Bt = (const bf16*)(ws + WS_WGU); g.ldb = DM_; g.strideB = (size_t)1024 * 1024; g.N = 512; g.K = DM_; g.mode = 2; g.C = (bf16*)(ws + WS_HB);
                      nb::k_ngemm<<<dim3(512 / 64, RMAX_ / 64), 256, 0, stream>>>(g); }
                  else { g.A = (const bf16*)(ws + WS_HB); g.lda = 512; g.Bt = (const bf16*)(ws + WS_WD); g.ldb = 512; g.strideB = (size_t)1024 * 512; g.N = DM_; g.K = 512; g.mode = 3; g.C = (bf16*)(ws + WS_Y); g.c_rows = (const int*)(ws + WS_SROW); g.roww = (const float*)(ws + WS_SW);
                      nb::k_ngemm<<<dim3(DM_ / 64, RMAX_ / 64), 256, 0, stream>>>(g); } } }
#endif
            p = q; continue; }
#if MK_OPT_MASK != 0xFF
        bf16* XN = (bf16*)(ws + WS_XN); bf16* U = (bf16*)(ws + WS_U); float* out = (float*)d_out;
        int* CNT = (int*)(ws + WS_CTL) + CW_CNT; int* PLAN = (int*)(ws + WS_CTL) + CW_PLAN;
        int* RE = (int*)(ws + WS_RE); float* RW = (float*)(ws + WS_RW); int* ENTRY = (int*)(ws + WS_ENTRY); int* SROW = (int*)(ws + WS_SROW); float* SW = (float*)(ws + WS_SW);
        int* STOK = (int*)(ws + WS_STOK); int* TILEE = (int*)(ws + WS_TILEE); float* CUM = (float*)(ws + WS_CUM); float* ORAW = (float*)(ws + WS_ORAW);
        bf16* HB = (bf16*)(ws + WS_HB); bf16* Y = (bf16*)(ws + WS_Y);
        if (p == 1) { nb::NG g{}; g.A = XN; g.lda = DM_; g.Bt = (const bf16*)(ws + WS_WI); g.ldb = DM_; g.M = T_; g.N = UC_; g.K = DM_; g.mode = 0; g.C = U; g.lb = (const float*)(ws + WS_LB);
            nb::k_ngemm<<<dim3(UC_ / 64, T_ / 64), 256, 0, stream>>>(g); }
        else if (p == 2) { nb::k_cum<<<1, 256, 0, stream>>>((const float*)(ws + WS_FLG), CUM);
            nb::k_hgrn<<<NB_ * 4, 128, 0, stream>>>(U, ORAW); nb::k_hnorm<<<T_ * 4 / 4, 256, 0, stream>>>(ORAW, U, (const float*)d_in[4], XN);
            nb::k_attn<<<NB_ * 8 * (SEQ_ / 64), 64, 0, stream>>>(U, CUM, (const float*)d_in[6], XN); }
        else if (p == 3) { nb::NG g{}; g.A = XN; g.lda = DM_; g.Bt = (const bf16*)(ws + WS_WO); g.ldb = DM_; g.M = T_; g.N = DM_; g.K = DM_; g.mode = 1; g.C = (bf16*)(ws + WS_D);
            nb::k_ngemm<<<dim3(DM_ / 64, T_ / 64), 256, 0, stream>>>(g); }
        else if (p == 4) { nb::k_route<<<T_ / 4, 256, 0, stream>>>((const float*)d_in[0], (const bf16*)(ws + WS_D), (const float*)d_in[8], (const float*)d_in[9], (const float*)d_in[10], (const float*)d_in[11], (const float*)d_in[12], XN, RE, RW);
            nb::k_assign<<<T_ / 256, 256, 0, stream>>>(RE, CNT, ENTRY); }
        else if (p == 5 || p == 6) { nb::k_plan<<<1, 64, 0, stream>>>(CNT, PLAN, TILEE); nb::k_fill<<<(RMAX_ + 255) / 256, 256, 0, stream>>>(CNT, PLAN, ENTRY, RW, SROW, SW, STOK);
            nb::NG g{}; g.tile_e = TILEE; g.Mdev = PLAN + 16; g.M = RMAX_;
            if (p == 5) { g.A = XN; g.lda = DM_; g.a_rows = STOK; g.Bt = (const bf16*)(ws + WS_WGU); g.ldb = DM_; g.strideB = (size_t)1024 * 1024; g.N = 512; g.K = DM_; g.mode = 2; g.C = HB;
                nb::k_ngemm<<<dim3(512 / 64, RMAX_ / 64), 256, 0, stream>>>(g); }
            else { g.A = HB; g.lda = 512; g.Bt = (const bf16*)(ws + WS_WD); g.ldb = 512; g.strideB = (size_t)1024 * 512; g.N = DM_; g.K = 512; g.mode = 3; g.C = Y; g.c_rows = SROW; g.roww = SW;
                nb::k_ngemm<<<dim3(DM_ / 64, RMAX_ / 64), 256, 0, stream>>>(g); } }
        else if (p == 7) { nb::k_final<<<T_ / 4, 256, 0, stream>>>((const float*)d_in[0], (const bf16*)(ws + WS_D), Y, (const float*)d_in[16], out); }
#endif
        ++p;
    }
}
```

```cpp
#include <hip/hip_runtime.h>
#include <hip/hip_bf16.h>
#include <cstdio>
#include <cstdint>
#include <cmath>
#ifndef MK_OPT_MASK
#define MK_OPT_MASK 0xFF
#endif
namespace pg8 {
#define PG8_LAS __attribute__((address_space(3)))
typedef unsigned short bf16_t;
typedef short bf16x8 __attribute__((ext_vector_type(8)));
typedef float f32x4 __attribute__((ext_vector_type(4)));
typedef unsigned u32x4 __attribute__((ext_vector_type(4)));
constexpr int BM = 256, BK = 64, HALF = 128, HTB = HALF * BK * 2  , STAGE_BYTES = 8 * HTB, NXCD = 8, WGM = 8;

__host__ __device__ __forceinline__ int lds_byte(int r, int c) { const int st = (r >> 4) * 2 + (c >> 5), rr = r & 15, cc = c & 31, ob = rr * 64 + cc * 2; return st * 1024 + (ob ^ (((ob >> 9) & 1) << 5)); }
__host__ __device__ __forceinline__ void stage_rc(int b, int& R, int& C) { const int st = b / 1024, sb = b % 1024, swz = sb ^ (((sb >> 9) & 1) << 5); R = (st >> 1) * 16 + swz / 64; C = (st & 1) * 32 + (swz % 64) / 2; }
__host__ __device__ __forceinline__ int perm32(int rho) { const int n = rho >> 4, i = rho & 15; return 8 * (i >> 2) + 4 * n + (i & 3); }

struct Unit { int pm, pn; };
struct Gemm { const bf16_t* A; const bf16_t* Bt; int M, N, K; };

struct StaticOrder {
    int nM, nN, nwg, G, c;
    __host__ __device__ void init(int M, int N, int G_, int c_) { nM = M / BM; nN = N / BM; nwg = nM * nN; G = G_; c = c_; }
    __host__ __device__ bool next(int i, Unit& u) const {
        const long L = (long)i * G + c; if (L >= nwg) return false;
        int wgid = (int)L; { const int q = nwg / NXCD, r = nwg % NXCD, xcd = wgid % NXCD, off = wgid / NXCD; wgid = (xcd < r ? xcd * (q + 1) : r * (q + 1) + (xcd - r) * q) + off; }
        const int nig = WGM * nN, gid = wgid / nig, fm = gid * WGM, gsz = (nM - fm) < WGM ? (nM - fm) : WGM;
        u.pm = fm + ((wgid % nig) % gsz); u.pn = (wgid % nig) / gsz; return true;
    }
    __device__ __forceinline__ void a_ready(const Unit&) const {}
    __device__ __forceinline__ void done(const Unit&) const {}
};

__device__ __forceinline__ unsigned cvt_pk_bf16(float lo, float hi) { unsigned r; asm volatile("v_cvt_pk_bf16_f32 %0, %1, %2" : "=v"(r) : "v"(lo), "v"(hi)); return r; }
typedef float f32x2 __attribute__((ext_vector_type(2)));
__device__ __forceinline__ f32x2 gelu_pk(f32x2 v) {
    const f32x2 av = __builtin_elementwise_abs(v), d = av * 0.2316418882f + 1.0f;
    f32x2 t; t.x = __builtin_amdgcn_rcpf(d.x); t.y = __builtin_amdgcn_rcpf(d.y);
    f32x2 q = t * 0.5307027145f + (-0.7265760135f); q = q * t + 0.7107068705f; q = q * t + (-0.142248368f); q = q * t + 0.127414796f; q = q * t;
    const f32x2 s = (v * v) * (-0.72134752044f);
    f32x2 e; e.x = __builtin_amdgcn_exp2f(s.x); e.y = __builtin_amdgcn_exp2f(s.y);
    const f32x2 m = v * (q * e), r = v - m;
    f32x2 o; o.x = v.x < 0.f ? m.x : r.x; o.y = v.y < 0.f ? m.y : r.y; return o;
}

template <int ACT  > struct EpiBf16 {
    static constexpr bool PERM = true, AFTER_DRAIN = false; static_assert(ACT == 0 || ACT == 1, "EpiBf16: ACT is 0 (none) or 1 (gelu_pk)");
    bf16_t* O; int ldc; const float* bias; int split_cols; size_t split_stride; float scale0;
    __device__ __forceinline__ void operator()(const f32x4 (&acc)[2][2][4][2], const Unit& u, int wr, int wc, int fr, int fq) const {
        const int row0 = u.pm * BM + wr * 64 + fr; int colt = u.pn * BM; bf16_t* base = O;
        float sc = 1.f; if (split_cols) { const int t = colt / split_cols; base += (size_t)t * split_stride; colt -= t * split_cols; if (t == 0) sc = scale0; }
        const int col0 = colt + wc * 32 + 8 * fq, bcol0 = u.pn * BM + wc * 32 + 8 * fq;
        f32x4 bv[2][2];
#pragma unroll
        for (int bj = 0; bj < 2; ++bj)
#pragma unroll
            for (int n = 0; n < 2; ++n) bv[bj][n] = bias ? *(const f32x4*)(bias + bcol0 + bj * HALF + 4 * n) : (f32x4){0.f, 0.f, 0.f, 0.f};
#pragma unroll
        for (int ai = 0; ai < 2; ++ai)
#pragma unroll
            for (int m = 0; m < 4; ++m) { bf16_t* rowp = base + (size_t)(row0 + ai * HALF + m * 16) * ldc + col0;
#pragma unroll
                for (int bj = 0; bj < 2; ++bj) { f32x4 v0 = acc[ai][bj][m][0] + bv[bj][0], v1 = acc[ai][bj][m][1] + bv[bj][1];
                    if (ACT == 1) { f32x2 a = gelu_pk((f32x2){v0[0], v0[1]}), b = gelu_pk((f32x2){v0[2], v0[3]}), c = gelu_pk((f32x2){v1[0], v1[1]}), d = gelu_pk((f32x2){v1[2], v1[3]});
                        v0 = (f32x4){a.x, a.y, b.x, b.y}; v1 = (f32x4){c.x, c.y, d.x, d.y}; }
                    v0 = v0 * sc; v1 = v1 * sc; u32x4 w; w.x = cvt_pk_bf16(v0[0], v0[1]); w.y = cvt_pk_bf16(v0[2], v0[3]); w.z = cvt_pk_bf16(v1[0], v1[1]); w.w = cvt_pk_bf16(v1[2], v1[3]);
                    *(u32x4*)(rowp + bj * HALF) = w; } }
    }
};

struct PanelStats {
    unsigned* xbuf;
    unsigned* cnt;
    unsigned* tmo;
    int ntn; float eps;
    unsigned code;
    __device__ __forceinline__ bool run(const f32x4 (&v)[2][2][4][2], const Unit& u, int wr, int wc, int fr, int fq, PG8_LAS unsigned char* lds, int wid, int lane) const {
        typedef float f32x2v __attribute__((ext_vector_type(2)));
        PG8_LAS f32x2v* P = (PG8_LAS f32x2v*)lds;
        PG8_LAS f32x2v* S = (PG8_LAS f32x2v*)(lds + 8192);
        PG8_LAS unsigned* flag = (PG8_LAS unsigned*)(lds + 8192 + 2048);
#pragma unroll
        for (int ai = 0; ai < 2; ++ai)
#pragma unroll
            for (int m = 0; m < 4; ++m) {
                float s = 0.f;
#pragma unroll
                for (int bj = 0; bj < 2; ++bj)
#pragma unroll
                    for (int n = 0; n < 2; ++n) { const f32x4 x = v[ai][bj][m][n]; s += (x[0] + x[1]) + (x[2] + x[3]); }
                s += __shfl_xor(s, 16); s += __shfl_xor(s, 32);
                const float mw = s * (1.0f / 64.0f); float q = 0.f;
#pragma unroll
                for (int bj = 0; bj < 2; ++bj)
#pragma unroll
                    for (int n = 0; n < 2; ++n) { const f32x4 d = v[ai][bj][m][n] - mw; q += (d[0] * d[0] + d[1] * d[1]) + (d[2] * d[2] + d[3] * d[3]); }
                q += __shfl_xor(q, 16); q += __shfl_xor(q, 32);
                if (fq == 0) P[(ai * HALF + wr * 64 + m * 16 + fr) * 4 + wc] = (f32x2v){mw, q};
            }
        asm volatile("s_waitcnt lgkmcnt(0)" ::: "memory"); __builtin_amdgcn_s_barrier(); asm volatile("" ::: "memory");
#if defined(BROKEN_EXCHANGE_NO_WAIT)
#warning BROKEN CONTROL BUILD: the row-statistics exchange does not wait; results are wrong by design
        if (blockIdx.x >= 64) { const long long t0_ = clock64(); while (clock64() - t0_ < 60000) __builtin_amdgcn_s_sleep(8); }
#endif
        const int row = wid * 32 + (lane & 31);
        if (lane < 32) {
            const f32x2v a = P[row * 4 + 0], b = P[row * 4 + 1], c = P[row * 4 + 2], d = P[row * 4 + 3];
            const float mt = (a.x + b.x + c.x + d.x) * 0.25f;
            const float da = a.x - mt, db = b.x - mt, dc = c.x - mt, dd = d.x - mt;
            const float m2 = (a.y + b.y) + (c.y + d.y) + 64.0f * ((da * da + db * db) + (dc * dc + dd * dd));
            unsigned long long* slot = (unsigned long long*)xbuf + ((size_t)(u.pm * BM + row) * 4 + u.pn);
            __hip_atomic_store(slot, ((unsigned long long)__float_as_uint(m2) << 32) | __float_as_uint(mt), __ATOMIC_RELAXED, __HIP_MEMORY_SCOPE_AGENT);
        }
        asm volatile("s_waitcnt vmcnt(0)" ::: "memory");
        if (lane == 0) __hip_atomic_fetch_add(cnt + 64 * u.pm, 1u, __ATOMIC_RELAXED, __HIP_MEMORY_SCOPE_AGENT);
        if (wid == 0) {
            bool dead = false; const unsigned long long t0 = __builtin_amdgcn_s_memrealtime(); const unsigned want = 8u * (unsigned)ntn;
            for (;;) {
#if defined(BROKEN_EXCHANGE_NO_WAIT)
                break;
#endif
                if ((unsigned)__builtin_amdgcn_readfirstlane(__hip_atomic_load(cnt + 64 * u.pm, __ATOMIC_RELAXED, __HIP_MEMORY_SCOPE_AGENT)) >= want) break;
                if (__builtin_amdgcn_s_memrealtime() - t0 > 2000000ull) {
                    if (lane == 0) { unsigned expect = 0u; __hip_atomic_compare_exchange_strong(tmo + 1, &expect, code | (unsigned)(u.pm & 0xff), __ATOMIC_RELAXED, __ATOMIC_RELAXED, __HIP_MEMORY_SCOPE_AGENT);
                                     __hip_atomic_store(tmo, 1u, __ATOMIC_RELAXED, __HIP_MEMORY_SCOPE_AGENT); }
                    dead = true; break; }
                __builtin_amdgcn_s_sleep(2);
            }
            __builtin_amdgcn_fence(__ATOMIC_ACQUIRE, "agent");
            if (lane == 0) flag[0] = dead ? 1u : 0u;
        }
        asm volatile("s_waitcnt vmcnt(0) lgkmcnt(0)" ::: "memory"); __builtin_amdgcn_s_barrier(); asm volatile("" ::: "memory");
        const bool bad = flag[0] != 0u;
        if (lane < 32) {
            const unsigned long long* slot = (const unsigned long long*)xbuf + (size_t)(u.pm * BM + row) * 4; float mt[4], m2[4]; float ms = 0.f;
#pragma unroll
            for (int t = 0; t < 4; ++t) { if (t < ntn) { const unsigned long long w = __hip_atomic_load(slot + t, __ATOMIC_RELAXED, __HIP_MEMORY_SCOPE_AGENT); mt[t] = __uint_as_float((unsigned)w); m2[t] = __uint_as_float((unsigned)(w >> 32)); } else { mt[t] = 0.f; m2[t] = 0.f; } ms += mt[t]; }
            const float mean = ms / (float)ntn; float q = 0.f;
#pragma unroll
            for (int t = 0; t < 4; ++t) if (t < ntn) { const float dm = mt[t] - mean; q += m2[t] + 256.0f * dm * dm; }
            S[row] = (f32x2v){mean, 1.0f / sqrtf(q / (256.0f * (float)ntn) + eps)};
        }
        asm volatile("s_waitcnt lgkmcnt(0)" ::: "memory"); __builtin_amdgcn_s_barrier(); asm volatile("" ::: "memory");
        return bad;
    }
};
struct EpiLnRes {
    static constexpr bool PERM = false, AFTER_DRAIN = true;
    const float* base; float* out; int ldc; const float* bias; PanelStats st; unsigned poison;
    __device__ __forceinline__ void fused(f32x4 (&acc)[2][2][4][2], const Unit& u, int wr, int wc, int fr, int fq, PG8_LAS unsigned char* lds, int wid, int lane) const {
        typedef float f32x2v __attribute__((ext_vector_type(2)));
        const PG8_LAS f32x2v* S = (const PG8_LAS f32x2v*)(lds + 8192);
        const int col0 = u.pn * BM + wc * 32 + 4 * fq;
#pragma unroll
        for (int bj = 0; bj < 2; ++bj)
#pragma unroll
            for (int n = 0; n < 2; ++n) { const f32x4 bv = bias ? *(const f32x4*)(bias + col0 + bj * HALF + n * 16) : (f32x4){0.f, 0.f, 0.f, 0.f};
#pragma unroll
                for (int ai = 0; ai < 2; ++ai)
#pragma unroll
                    for (int m = 0; m < 4; ++m) acc[ai][bj][m][n] += bv; }
        f32x4 pre[4][2][2];
#pragma unroll
        for (int m = 0; m < 4; ++m) { const size_t off = (size_t)(u.pm * BM + wr * 64 + m * 16 + fr) * ldc + col0;
#pragma unroll
            for (int bj = 0; bj < 2; ++bj)
#pragma unroll
                for (int n = 0; n < 2; ++n) pre[m][bj][n] = *(const f32x4*)(base + off + bj * HALF + n * 16); }
        const bool bad = st.run(acc, u, wr, wc, fr, fq, lds, wid, lane) || poison != 0u;
        const float qnan = __builtin_nanf("");
#pragma unroll
        for (int ai = 0; ai < 2; ++ai)
#pragma unroll
            for (int m = 0; m < 4; ++m) { const int r = ai * HALF + wr * 64 + m * 16 + fr; const f32x2v sr = S[r]; const size_t off = (size_t)(u.pm * BM + r) * ldc + col0;
#pragma unroll
                for (int bj = 0; bj < 2; ++bj)
#pragma unroll
                    for (int n = 0; n < 2; ++n) { const f32x4 bs = ai == 0 ? pre[m][bj][n] : *(const f32x4*)(base + off + bj * HALF + n * 16); f32x4 o = bs + (acc[ai][bj][m][n] - sr.x) * sr.y;
                        if (bad) o = (f32x4){qnan, qnan, qnan, qnan}; *(f32x4*)(out + off + bj * HALF + n * 16) = o; }
                if (m & 1) asm volatile("" ::: "memory"); }
    }
};
struct EpiLnResLn {
    static constexpr bool PERM = false, AFTER_DRAIN = true;
    const float* base; float* out; bf16_t* xn; int ldc; const float* bias; PanelStats st1, st2; unsigned poison;
    __device__ __forceinline__ void fused(f32x4 (&acc)[2][2][4][2], const Unit& u, int wr, int wc, int fr, int fq, PG8_LAS unsigned char* lds, int wid, int lane) const {
        typedef float f32x2v __attribute__((ext_vector_type(2))); typedef unsigned u32x2v __attribute__((ext_vector_type(2)));
        const PG8_LAS f32x2v* S = (const PG8_LAS f32x2v*)(lds + 8192);
        const int col0 = u.pn * BM + wc * 32 + 4 * fq;
#pragma unroll
        for (int bj = 0; bj < 2; ++bj)
#pragma unroll
            for (int n = 0; n < 2; ++n) { const f32x4 bv = bias ? *(const f32x4*)(bias + col0 + bj * HALF + n * 16) : (f32x4){0.f, 0.f, 0.f, 0.f};
#pragma unroll
                for (int ai = 0; ai < 2; ++ai)
#pragma unroll
                    for (int m = 0; m < 4; ++m) acc[ai][bj][m][n] += bv; }
        bool bad = st1.run(acc, u, wr, wc, fr, fq, lds, wid, lane) || poison != 0u;
        const float qnan = __builtin_nanf("");
#pragma unroll
        for (int ai = 0; ai < 2; ++ai)
#pragma unroll
            for (int m = 0; m < 4; ++m) { const int r = ai * HALF + wr * 64 + m * 16 + fr; const f32x2v sr = S[r]; const size_t off = (size_t)(u.pm * BM + r) * ldc + col0;
#pragma unroll
                for (int bj = 0; bj < 2; ++bj)
#pragma unroll
                    for (int n = 0; n < 2; ++n) { const f32x4 bs = *(const f32x4*)(base + off + bj * HALF + n * 16); acc[ai][bj][m][n] = bs + (acc[ai][bj][m][n] - sr.x) * sr.y; }
                asm volatile("" : "+v"(acc[ai][0][m][0]), "+v"(acc[ai][0][m][1]), "+v"(acc[ai][1][m][0]), "+v"(acc[ai][1][m][1]));
                if (m & 1) asm volatile("" ::: "memory"); }
        const bool bad1 = bad;
        bad = st2.run(acc, u, wr, wc, fr, fq, lds, wid, lane) || bad;
#pragma unroll
        for (int ai = 0; ai < 2; ++ai)
#pragma unroll
            for (int m = 0; m < 4; ++m) { const int r = ai * HALF + wr * 64 + m * 16 + fr; const f32x2v sr = S[r]; const size_t off = (size_t)(u.pm * BM + r) * ldc + col0;
#pragma unroll
                for (int bj = 0; bj < 2; ++bj)
#pragma unroll
                    for (int n = 0; n < 2; ++n) { const f32x4 x1 = acc[ai][bj][m][n]; *(f32x4*)(out + off + bj * HALF + n * 16) = bad1 ? (f32x4){qnan, qnan, qnan, qnan} : x1;
                        const f32x4 o = (x1 - sr.x) * sr.y; u32x2v w; w.x = cvt_pk_bf16(o[0], o[1]); w.y = cvt_pk_bf16(o[2], o[3]);
                        if (bad) { w.x = 0x7fc07fc0u; w.y = 0x7fc07fc0u; } *(u32x2v*)(xn + off + bj * HALF + n * 16) = w; }
                asm volatile("" ::: "memory"); }
    }
};

template <class Epi, class Sched, bool ALIGN_EPI = false, bool SP2 = false>
__device__ __forceinline__ void gemm_phase(PG8_LAS unsigned char* lds, const Gemm g, const Sched& S, const Epi& E) {
    const int tid = threadIdx.x, wid = __builtin_amdgcn_readfirstlane(tid >> 6), lane = tid & 63, wr = wid >> 2, wc = wid & 3, fr = lane & 15, fq = lane >> 4;
    const int K = g.K, nt = K / BK;
    unsigned voffA[2], voffB[2];
#pragma unroll
    for (int i = 0; i < 2; ++i) { int R, C; stage_rc(tid * 16 + i * 8192, R, C); const int Rb = Epi::PERM ? ((R & ~31) + perm32(R & 31)) : R;
        voffA[i] = (unsigned)(R * K + C) * 2u; voffB[i] = (unsigned)(Rb * K + C) * 2u; }
    const size_t kstep = (size_t)(BK * 2);
    const size_t hstep = (size_t)HALF * K * 2;
    const size_t tstep = 2 * hstep;
    const unsigned ldsw = (unsigned)wid * 1024u;
    const int aoff = lds_byte(wr * 64 + fr, fq * 8), boff = lds_byte(wc * 32 + fr, fq * 8);
#define PG8_SA(b, h) (((b) * 2 + (h)) * HTB)
#define PG8_SB(b, h) ((4 + (b) * 2 + (h)) * HTB)
#define PG8_STAGE(bufoff, gbase, voff) do { _Pragma("unroll") for (int _i = 0; _i < 2; ++_i) \
        __builtin_amdgcn_global_load_lds((const unsigned*)((const char*)(gbase) + (voff)[_i]), (PG8_LAS unsigned*)(lds + (bufoff) + ldsw + _i * 8192), 16, 0, 0); } while (0)
#define PG8_LDA(dst, b, h) do { _Pragma("unroll") for (int m = 0; m < 4; ++m) _Pragma("unroll") for (int k = 0; k < 2; ++k) dst[m][k] = *(const PG8_LAS bf16x8*)(lds + PG8_SA(b, h) + aoff + m * 2048 + k * 1024); } while (0)
#define PG8_LDB(dst, b, h) do { _Pragma("unroll") for (int n = 0; n < 2; ++n) _Pragma("unroll") for (int k = 0; k < 2; ++k) dst[n][k] = *(const PG8_LAS bf16x8*)(lds + PG8_SB(b, h) + boff + n * 2048 + k * 1024); } while (0)
#define PG8_MMA(ai, bj, At, Bt) do { __builtin_amdgcn_s_setprio(1); _Pragma("unroll") for (int m = 0; m < 4; ++m) _Pragma("unroll") for (int n = 0; n < 2; ++n) _Pragma("unroll") for (int k = 0; k < 2; ++k) \
        acc[ai][bj][m][n] = __builtin_amdgcn_mfma_f32_16x16x32_bf16(Bt[n][k], At[m][k], acc[ai][bj][m][n], 0, 0, 0); __builtin_amdgcn_s_setprio(0); } while (0)
#define PG8_WAIT_V(n) asm volatile("s_waitcnt vmcnt(" #n ")" ::: "memory")
#define PG8_WAIT_L(n) asm volatile("s_waitcnt lgkmcnt(" #n ")" ::: "memory")
#define PG8_BAR __builtin_amdgcn_s_barrier()
#define PG8_SCHED __builtin_amdgcn_sched_barrier(0)
    Unit cur, nxt; int ui = 0;
    if (!S.next(0, cur)) return;
    f32x4 acc[2][2][4][2];
#pragma unroll
    for (int a = 0; a < 2; ++a)
#pragma unroll
        for (int b = 0; b < 2; ++b)
#pragma unroll
            for (int m = 0; m < 4; ++m)
#pragma unroll
                for (int n = 0; n < 2; ++n) acc[a][b][m][n] = (f32x4){0.f, 0.f, 0.f, 0.f};
    bf16x8 At[4][2], B0[2][2], B1[2][2];
    const char* cA = (const char*)g.A + (size_t)cur.pm * tstep; const char* cB = (const char*)g.Bt + (size_t)cur.pn * tstep;
    S.a_ready(cur);
    if constexpr (SP2) {
        PG8_STAGE(PG8_SB(0, 0), cB, voffB); PG8_STAGE(PG8_SB(0, 1), cB + hstep, voffB); PG8_STAGE(PG8_SA(0, 0), cA, voffA); PG8_STAGE(PG8_SA(0, 1), cA + hstep, voffA);
        if (wr == 1) PG8_BAR;
        PG8_WAIT_V(2); PG8_BAR;
        PG8_STAGE(PG8_SB(1, 0), cB + kstep, voffB); PG8_STAGE(PG8_SA(1, 0), cA + kstep, voffA); PG8_STAGE(PG8_SB(1, 1), cB + hstep + kstep, voffB);
        PG8_WAIT_V(6); PG8_BAR;
    } else {
        PG8_STAGE(PG8_SB(0, 0), cB, voffB); PG8_STAGE(PG8_SA(0, 0), cA, voffA); PG8_STAGE(PG8_SB(0, 1), cB + hstep, voffB); PG8_STAGE(PG8_SA(0, 1), cA + hstep, voffA);
        if (wr == 1) PG8_BAR;
        PG8_WAIT_V(4); PG8_BAR;
        PG8_STAGE(PG8_SB(1, 0), cB + kstep, voffB); PG8_STAGE(PG8_SA(1, 0), cA + kstep, voffA); PG8_STAGE(PG8_SB(1, 1), cB + hstep + kstep, voffB);
        PG8_WAIT_V(6); PG8_BAR;
    }
    for (;;) {
        const bool has_next = S.next(ui + 1, nxt);
        const char* nA = has_next ? (const char*)g.A + (size_t)nxt.pm * tstep : cA; const char* nB = has_next ? (const char*)g.Bt + (size_t)nxt.pn * tstep : cB;
        for (int t = 0; t < nt; t += 2) {
            const bool last = (t == nt - 2);
            const char* a1 = cA + (size_t)(t + 1) * kstep;
            const char* a2 = last ? nA : cA + (size_t)(t + 2) * kstep; const char* b2 = last ? nB : cB + (size_t)(t + 2) * kstep;
            const char* a3 = a2 + kstep; const char* b3 = b2 + kstep;
            if (last && has_next) S.a_ready(nxt);
            if constexpr (SP2) {
            PG8_LDB(B0, 0, 0); PG8_LDB(B1, 0, 1); PG8_SCHED; PG8_LDA(At, 0, 0); PG8_STAGE(PG8_SA(1, 1), a1 + hstep, voffA);
            PG8_WAIT_V(8); PG8_WAIT_L(0); PG8_BAR; PG8_MMA(0, 0, At, B0); PG8_MMA(0, 1, At, B1); PG8_BAR; PG8_SCHED;
            PG8_LDA(At, 0, 1); PG8_STAGE(PG8_SB(0, 0), b2, voffB); PG8_STAGE(PG8_SB(0, 1), b2 + hstep, voffB); PG8_STAGE(PG8_SA(0, 0), a2, voffA);
            PG8_WAIT_V(8); PG8_WAIT_L(0); PG8_BAR; PG8_MMA(1, 0, At, B0); PG8_MMA(1, 1, At, B1); PG8_BAR; PG8_SCHED;
            PG8_LDB(B0, 1, 0); PG8_LDB(B1, 1, 1); PG8_SCHED; PG8_LDA(At, 1, 0); PG8_STAGE(PG8_SA(0, 1), a2 + hstep, voffA);
            PG8_WAIT_V(8); PG8_WAIT_L(0); PG8_BAR; PG8_MMA(0, 0, At, B0); PG8_MMA(0, 1, At, B1); PG8_BAR; PG8_SCHED;
            PG8_LDA(At, 1, 1); PG8_STAGE(PG8_SB(1, 0), b3, voffB); PG8_STAGE(PG8_SB(1, 1), b3 + hstep, voffB); PG8_STAGE(PG8_SA(1, 0), a3, voffA);
            PG8_WAIT_V(8); PG8_WAIT_L(0); PG8_BAR; PG8_MMA(1, 0, At, B0); PG8_MMA(1, 1, At, B1); PG8_BAR; PG8_SCHED;
            } else {
            PG8_LDB(B0, 0, 0); PG8_SCHED; PG8_LDA(At, 0, 0); PG8_STAGE(PG8_SA(1, 1), a1 + hstep, voffA);
            PG8_WAIT_L(8); PG8_BAR; PG8_WAIT_L(0); PG8_MMA(0, 0, At, B0); PG8_BAR; PG8_SCHED;
            PG8_LDB(B1, 0, 1); PG8_STAGE(PG8_SB(0, 0), b2, voffB);
            PG8_BAR; PG8_WAIT_L(0); PG8_MMA(0, 1, At, B1); PG8_BAR;
            PG8_LDA(At, 0, 1); PG8_STAGE(PG8_SA(0, 0), a2, voffA);
            PG8_BAR; PG8_WAIT_L(0); PG8_MMA(1, 0, At, B0); PG8_BAR; PG8_SCHED;
            PG8_STAGE(PG8_SB(0, 1), b2 + hstep, voffB);
            PG8_WAIT_V(6); PG8_BAR; PG8_MMA(1, 1, At, B1); PG8_BAR;
            PG8_LDB(B0, 1, 0); PG8_SCHED; PG8_LDA(At, 1, 0); PG8_STAGE(PG8_SA(0, 1), a2 + hstep, voffA);
            PG8_WAIT_L(8); PG8_BAR; PG8_WAIT_L(0); PG8_MMA(0, 0, At, B0); PG8_BAR; PG8_SCHED;
            PG8_LDB(B1, 1, 1); PG8_STAGE(PG8_SB(1, 0), b3, voffB);
            PG8_BAR; PG8_WAIT_L(0); PG8_MMA(0, 1, At, B1); PG8_BAR;
            PG8_LDA(At, 1, 1); PG8_STAGE(PG8_SA(1, 0), a3, voffA);
            PG8_BAR; PG8_WAIT_L(0); PG8_MMA(1, 0, At, B0); PG8_BAR; PG8_SCHED;
            PG8_STAGE(PG8_SB(1, 1), b3 + hstep, voffB);
            PG8_WAIT_V(6); PG8_BAR; PG8_MMA(1, 1, At, B1); PG8_BAR;
            }
        }
        if constexpr (ALIGN_EPI) { if (wr == 0) PG8_BAR; }
        if constexpr (!Epi::AFTER_DRAIN) { E(acc, cur, wr, wc, fr, fq); S.done(cur); }
        if (!has_next) break;
#pragma unroll
        for (int a = 0; a < 2; ++a)
#pragma unroll
            for (int b = 0; b < 2; ++b)
#pragma unroll
                for (int m = 0; m < 4; ++m)
#pragma unroll
                    for (int n = 0; n < 2; ++n) acc[a][b][m][n] = (f32x4){0.f, 0.f, 0.f, 0.f};
        cur = nxt; cA = nA; cB = nB; ++ui;
        if constexpr (ALIGN_EPI) { if (wr == 1) PG8_BAR; }
    }
    PG8_WAIT_V(0);
    if constexpr (!ALIGN_EPI) { if (wr == 0) PG8_BAR; }
    PG8_BAR;
    if constexpr (Epi::AFTER_DRAIN) { E.fused(acc, cur, wr, wc, fr, fq, lds, wid, lane); S.done(cur); }
#undef PG8_SA
#undef PG8_SB
#undef PG8_STAGE
#undef PG8_LDA
#undef PG8_LDB
#undef PG8_MMA
#undef PG8_WAIT_V
#undef PG8_WAIT_L
#undef PG8_BAR
#undef PG8_SCHED
}
}
namespace pg8 {
#define PG8_LOG2E 1.4426950408889634f
__device__ __forceinline__ float fast_sigmoid(float x) { return __builtin_amdgcn_rcpf(1.0f + __builtin_amdgcn_exp2f(-x * PG8_LOG2E)); }
__device__ __forceinline__ float fast_silu(float x) { return x * fast_sigmoid(x); }
struct EpiU {
    static constexpr bool PERM = true, AFTER_DRAIN = false;
    bf16_t* O; int ldc; const float* lb; float qscale; int probe;
    long tab_off;
    template <int CTRL> static __device__ __forceinline__ float dmax(float v) { return fmaxf(v, __builtin_bit_cast(float, __builtin_amdgcn_update_dpp(0, __builtin_bit_cast(int, v), CTRL, 0xf, 0xf, true))); }
    __device__ __forceinline__ void operator()(const f32x4 (&acc)[2][2][4][2], const Unit& u, int wr, int wc, int fr, int fq) const {
        const int row0 = u.pm * BM + wr * 64 + fr; const int colt = u.pn * BM; const int col0 = colt + wc * 32 + 8 * fq;
        const int kind = (probe == 2) ? 2 : (u.pn >> 1);
        f32x4 lbv[2][2];
        if (kind == 1) {
#pragma unroll
            for (int bj = 0; bj < 2; ++bj)
#pragma unroll
                for (int n = 0; n < 2; ++n) lbv[bj][n] = *(const f32x4*)(lb + (col0 - 512) + bj * HALF + 4 * n);
        }
#pragma unroll
        for (int ai = 0; ai < 2; ++ai) { float rs[2][4];
#pragma unroll
            for (int m = 0; m < 4; ++m) { bf16_t* rowp = O + (size_t)(row0 + ai * HALF + m * 16) * ldc + col0;
#pragma unroll
                for (int bj = 0; bj < 2; ++bj) { f32x4 v0 = acc[ai][bj][m][0], v1 = acc[ai][bj][m][1];
                    if (kind == 0 || kind == 3) {
#pragma unroll
                        for (int c = 0; c < 4; ++c) { v0[c] = fast_silu(v0[c]); v1[c] = fast_silu(v1[c]); }
                    } else if (kind == 1) {
#pragma unroll
                        for (int c = 0; c < 4; ++c) { const float l0 = lbv[bj][0][c], l1 = lbv[bj][1][c];
                            v0[c] = __builtin_amdgcn_logf(l0 + (1.f - l0) * fast_sigmoid(v0[c]));
                            v1[c] = __builtin_amdgcn_logf(l1 + (1.f - l1) * fast_sigmoid(v1[c])); }
                    } else if (kind == 4) { v0 = v0 * qscale; v1 = v1 * qscale; }
                    u32x4 w; w.x = cvt_pk_bf16(v0[0], v0[1]); w.y = cvt_pk_bf16(v0[2], v0[3]); w.z = cvt_pk_bf16(v1[0], v1[1]); w.w = cvt_pk_bf16(v1[2], v1[3]);
                    if (probe != 1) *(u32x4*)(rowp + bj * HALF) = w; else asm volatile("" :: "v"(w));
                    if (kind == 4 || kind == 5) { float ss = 0.f;
#pragma unroll
                        for (int e = 0; e < 4; ++e) { const unsigned ww = e == 0 ? w.x : (e == 1 ? w.y : (e == 2 ? w.z : w.w)); const float a0 = __builtin_bit_cast(float, ww << 16), a1 = __builtin_bit_cast(float, ww & 0xffff0000u); ss += a0 * a0 + a1 * a1; }
                        rs[bj][m] = ss; } } }
            if (kind == 4 || kind == 5) {
                float t_[2][4];
#pragma unroll
                for (int bj = 0; bj < 2; ++bj)
#pragma unroll
                    for (int m = 0; m < 4; ++m) t_[bj][m] = __builtin_bit_cast(float, __builtin_amdgcn_ds_bpermute(((fq * 16 + fr) ^ 16) << 2, __builtin_bit_cast(int, rs[bj][m])));
#pragma unroll
                for (int bj = 0; bj < 2; ++bj)
#pragma unroll
                    for (int m = 0; m < 4; ++m) rs[bj][m] += t_[bj][m];
#pragma unroll
                for (int bj = 0; bj < 2; ++bj)
#pragma unroll
                    for (int m = 0; m < 4; ++m) t_[bj][m] = __builtin_bit_cast(float, __builtin_amdgcn_ds_bpermute(((fq * 16 + fr) ^ 32) << 2, __builtin_bit_cast(int, rs[bj][m])));
#pragma unroll
                for (int bj = 0; bj < 2; ++bj) { float mx = 0.f;
#pragma unroll
                    for (int m = 0; m < 4; ++m) mx = fmaxf(mx, rs[bj][m] + t_[bj][m]);
                    mx = dmax<0xB1>(mx); mx = dmax<0x4E>(mx); mx = dmax<0x141>(mx); mx = dmax<0x140>(mx);
                    if ((fr | fq) == 0) { unsigned* ktab = (unsigned*)((char*)O + tab_off); unsigned* qtab = ktab + 256 * 2 * 32; const int bh = (u.pm >> 3) * 8 + (u.pn & 1) * 4 + 2 * bj + (wc >> 1), hf = wc & 1;
                        if (kind == 5) __hip_atomic_fetch_max(ktab + (bh * 2 + hf) * 32 + (u.pm & 7) * 4 + ai * 2 + wr, __builtin_bit_cast(unsigned, mx), __ATOMIC_RELAXED, __HIP_MEMORY_SCOPE_AGENT);
                        else __hip_atomic_fetch_max(qtab + (bh * 2 + hf) * 8 + (u.pm & 7), __builtin_bit_cast(unsigned, mx), __ATOMIC_RELAXED, __HIP_MEMORY_SCOPE_AGENT); } } } }
    }
};
struct EpiD {
    static constexpr bool PERM = true, AFTER_DRAIN = false;
    bf16_t* O; int ldc;
    __device__ __forceinline__ void operator()(const f32x4 (&acc)[2][2][4][2], const Unit& u, int wr, int wc, int fr, int fq) const {
        const int row0 = u.pm * BM + wr * 64 + fr; const int col0 = u.pn * BM + wc * 32 + 8 * fq;
#pragma unroll
        for (int ai = 0; ai < 2; ++ai)
#pragma unroll
            for (int m = 0; m < 4; ++m) { bf16_t* rowp = O + (size_t)(row0 + ai * HALF + m * 16) * ldc + col0;
#pragma unroll
                for (int bj = 0; bj < 2; ++bj) { const f32x4 v0 = acc[ai][bj][m][0], v1 = acc[ai][bj][m][1];
                    u32x4 w; w.x = cvt_pk_bf16(v0[0], v0[1]); w.y = cvt_pk_bf16(v0[2], v0[3]); w.z = cvt_pk_bf16(v1[0], v1[1]); w.w = cvt_pk_bf16(v1[2], v1[3]);
                    *(u32x4*)(rowp + bj * HALF) = w; } }
    }
};
struct EpiH1 {
    static constexpr bool PERM = true, AFTER_DRAIN = false;
    const float* gain0; bf16_t* O; int ldc; long xn_off, rms_off;
    __device__ __forceinline__ void operator()(const f32x4 (&acc)[2][2][4][2], const Unit& u, int wr, int wc, int fr, int fq) const {
        const int row0 = u.pm * BM + wr * 64 + fr; const int col0 = u.pn * BM + wc * 32 + 8 * fq;
        const bf16_t* XNp = (const bf16_t*)((const char*)O + xn_off); const float* rms0 = (const float*)((const char*)O + rms_off);
        f32x4 ig[2][2];
#pragma unroll
        for (int bj = 0; bj < 2; ++bj)
#pragma unroll
            for (int n = 0; n < 2; ++n) { const f32x4 gq = *(const f32x4*)(gain0 + col0 + bj * HALF + 4 * n);
#pragma unroll
                for (int c = 0; c < 4; ++c) ig[bj][n][c] = __builtin_amdgcn_rcpf(gq[c]); }
#pragma unroll
        for (int ai = 0; ai < 2; ++ai) { u32x4 xv[4][2]; float rm[4];
#pragma unroll
            for (int m = 0; m < 4; ++m) { const int row = row0 + ai * HALF + m * 16; rm[m] = rms0[row];
#pragma unroll
                for (int bj = 0; bj < 2; ++bj) xv[m][bj] = *(const u32x4*)(XNp + (size_t)row * ldc + col0 + bj * HALF); }
#pragma unroll
            for (int m = 0; m < 4; ++m) { bf16_t* rowp = O + (size_t)(row0 + ai * HALF + m * 16) * ldc + col0;
#pragma unroll
                for (int bj = 0; bj < 2; ++bj) { const u32x4 xw = xv[m][bj];
                    const f32x4 x0 = {__builtin_bit_cast(float, xw.x << 16), __builtin_bit_cast(float, xw.x & 0xffff0000u), __builtin_bit_cast(float, xw.y << 16), __builtin_bit_cast(float, xw.y & 0xffff0000u)};
                    const f32x4 x1 = {__builtin_bit_cast(float, xw.z << 16), __builtin_bit_cast(float, xw.z & 0xffff0000u), __builtin_bit_cast(float, xw.w << 16), __builtin_bit_cast(float, xw.w & 0xffff0000u)};
                    const f32x4 v0 = acc[ai][bj][m][0] + x0 * (ig[bj][0] * rm[m]), v1 = acc[ai][bj][m][1] + x1 * (ig[bj][1] * rm[m]);
                    u32x4 w; w.x = cvt_pk_bf16(v0[0], v0[1]); w.y = cvt_pk_bf16(v0[2], v0[3]); w.z = cvt_pk_bf16(v1[0], v1[1]); w.w = cvt_pk_bf16(v1[2], v1[3]);
                    *(u32x4*)(rowp + bj * HALF) = w; } }
            asm volatile("" ::: "memory"); }
    }
};
struct EpiRes {
    static constexpr bool PERM = false, AFTER_DRAIN = false;
    const float* base; float* out; int ldc;
    __device__ __forceinline__ void operator()(const f32x4 (&acc)[2][2][4][2], const Unit& u, int wr, int wc, int fr, int fq) const {
        const int col0 = u.pn * BM + wc * 32 + 4 * fq;
#pragma unroll
        for (int ai = 0; ai < 2; ++ai)
#pragma unroll
            for (int m = 0; m < 4; ++m) { const size_t off = (size_t)(u.pm * BM + ai * HALF + wr * 64 + m * 16 + fr) * ldc + col0;
#pragma unroll
                for (int bj = 0; bj < 2; ++bj)
#pragma unroll
                    for (int n = 0; n < 2; ++n) { const f32x4 bs = *(const f32x4*)(base + off + bj * HALF + n * 16); *(f32x4*)(out + off + bj * HALF + n * 16) = bs + acc[ai][bj][m][n]; }
                if (m & 1) asm volatile("" ::: "memory"); }
    }
};
struct MUnit { int pm, pn, e, e2, hc, slot, half; };
__host__ __device__ __forceinline__ bool moe_deal(int i, int c, int G, int NU, int& g, int& half, bool quarter = false) {
    const int full = NU / G, rem = NU - full * G;
    if (i < full) { g = i * G + c; half = -1; return true; }
    if (i > full || rem == 0) return false;
    if (quarter && 4 * rem <= G) { if (c >= 4 * rem) return false; g = full * G + (c >> 2); half = 4 + (c & 3); return true; }
    if (2 * rem <= G) { if (c >= 2 * rem) return false; g = full * G + (c >> 1); half = c & 1; return true; }
    if (c >= rem) return false; g = full * G + c; half = -1; return true;
}
struct MGemm { const bf16_t* A; const bf16_t* Bt; int K; int KB; int brows; };
template <int SHIFT> struct MoeOrderP {
    PG8_LAS const int* tb;
    int G, c;
    __device__ __forceinline__ bool next(int i, MUnit& u) const {
        const int NT = __builtin_amdgcn_readfirstlane(tb[24]); int g, half; if (!moe_deal(i, c, G, NT << SHIFT, g, half, SHIFT == 2)) return false;
        const int rt = g >> SHIFT; int bk = 0;
#pragma unroll
        for (int j = 1; j < 24; ++j) { const int b = __builtin_amdgcn_readfirstlane(tb[j]); bk = (rt >= b) ? j : bk; }
        const int grp = bk / 6, p = bk - grp * 6; const int a = p < 3 ? 0 : (p < 5 ? 1 : 2), b2 = p < 3 ? p + 1 : (p < 5 ? p - 1 : 3);
        const int elo = grp * 4 + a, ehi = grp * 4 + b2;
        if (SHIFT == 3) { const int pn8 = g & 7; u.e = (pn8 < 4) ? elo : ehi; u.e2 = u.e; u.pn = pn8 & 3; u.hc = (pn8 >> 2) * 512; }
        else { u.e = elo; u.e2 = ehi; u.pn = g & 3; u.hc = 0; }
        u.pm = rt; u.slot = i; u.half = half; return true;
    }
    __device__ __forceinline__ void a_ready(const MUnit&) const {}
    __device__ __forceinline__ void done(const MUnit&) const {}
};
struct EpiSwiglu {
    static constexpr bool PERM = true, AFTER_DRAIN = false;
    bf16_t* H; PG8_LAS const int* tab;
    __device__ __forceinline__ void operator()(const f32x4 (&acc)[2][2][4][2], const MUnit& u, int wr, int wc, int fr, int fq) const {
        const int row0 = u.pm * BM + wr * 64 + fr; const int col0 = u.hc + u.pn * HALF + wc * 32 + 8 * fq;
#pragma unroll
        for (int ai = 0; ai < 2; ++ai) { if (u.half >= 0 && u.half != ai) continue;
#pragma unroll
            for (int m = 0; m < 4; ++m) { bf16_t* rowp = H + (size_t)(row0 + ai * HALF + m * 16) * 1024 + col0; const int rl = ai * HALF + wr * 64 + m * 16 + fr;
                const float rs = __builtin_bit_cast(float, tab[u.slot * 512 + 256 + rl]); const float w = __builtin_bit_cast(float, (unsigned)tab[u.slot * 512 + rl] & 0xffff0000u);
                f32x4 g0 = acc[ai][0][m][0] * rs, g1 = acc[ai][0][m][1] * rs; const f32x4 u0 = acc[ai][1][m][0] * (rs * w), u1 = acc[ai][1][m][1] * (rs * w);
#pragma unroll
                for (int c = 0; c < 4; ++c) { g0[c] = fast_silu(g0[c]) * u0[c]; g1[c] = fast_silu(g1[c]) * u1[c]; }
                u32x4 wv; wv.x = cvt_pk_bf16(g0[0], g0[1]); wv.y = cvt_pk_bf16(g0[2], g0[3]); wv.z = cvt_pk_bf16(g1[0], g1[1]); wv.w = cvt_pk_bf16(g1[2], g1[3]);
                *(u32x4*)rowp = wv; } }
    }
};
struct EpiDown {
    static constexpr bool PERM = true, AFTER_DRAIN = false;
    bf16_t* Y; PG8_LAS const int* tab;
    __device__ __forceinline__ void operator()(const f32x4 (&acc)[2][2][4][2], const MUnit& u, int wr, int wc, int fr, int fq) const {
        const int col0 = u.pn * BM + wc * 32 + 8 * fq;
#pragma unroll
        for (int ai = 0; ai < 2; ++ai) { if (u.half >= 0 && (u.half & 1) != ai) continue;
#pragma unroll
            for (int m = 0; m < 4; ++m) { const int rl = ai * HALF + wr * 64 + m * 16 + fr; const int t = tab[u.slot * 256 + rl];
                if (t >= 0) { bf16_t* rowp = Y + (size_t)t * 1024 + col0;
#pragma unroll
                    for (int bj = 0; bj < 2; ++bj) { if (u.half >= 4 && ((u.half >> 1) & 1) != bj) continue; const f32x4 v0 = acc[ai][bj][m][0], v1 = acc[ai][bj][m][1];
                        u32x4 o; o.x = cvt_pk_bf16(v0[0], v0[1]); o.y = cvt_pk_bf16(v0[2], v0[3]); o.z = cvt_pk_bf16(v1[0], v1[1]); o.w = cvt_pk_bf16(v1[2], v1[3]);
                        *(u32x4*)(rowp + bj * HALF) = o; } } } }
    }
};
template <class Epi, class Sched, bool GATHER, bool ALIGN_EPI, bool DUALB, int TSTRIDE = 512>
__device__ __forceinline__ void gemm_phase_moe(PG8_LAS unsigned char* lds, PG8_LAS const int* tok, const MGemm g, const Sched& S, const Epi& E) {
    const int tid = threadIdx.x, wid = __builtin_amdgcn_readfirstlane(tid >> 6), lane = tid & 63, wr = wid >> 2, wc = wid & 3, fr = lane & 15, fq = lane >> 4;
    const int K = g.K, KB = g.KB, nt = K / BK, nsw = KB / BK;
    unsigned voffB[2]; int RA[2]; unsigned colA[2];
#pragma unroll
    for (int i = 0; i < 2; ++i) { int R, C; stage_rc(tid * 16 + i * 8192, R, C); const int Rb = Epi::PERM ? ((R & ~31) + perm32(R & 31)) : R;
        RA[i] = R; colA[i] = (unsigned)C * 2u; voffB[i] = (unsigned)(Rb * KB + C) * 2u; }
    const size_t kstep = (size_t)(BK * 2);
    const size_t hstep = (size_t)HALF * KB * 2;
    const size_t tstep = (size_t)2 * HALF * K * 2;
    const unsigned ldsw = (unsigned)wid * 1024u;
    const int aoff = lds_byte(wr * 64 + fr, fq * 8), boff = lds_byte(wc * 32 + fr, fq * 8);
#define PG8_SA(b, h) (((b) * 2 + (h)) * HTB)
#define PG8_SB(b, h) ((4 + (b) * 2 + (h)) * HTB)
#define PG8_STAGE(bufoff, gbase, voff) do { _Pragma("unroll") for (int _i = 0; _i < 2; ++_i) \
        __builtin_amdgcn_global_load_lds((const unsigned*)((const char*)(gbase) + (voff)[_i]), (PG8_LAS unsigned*)(lds + (bufoff) + ldsw + _i * 8192), 16, 0, 0); } while (0)
#define PG8_LDA(dst, b, h) do { _Pragma("unroll") for (int m = 0; m < 4; ++m) _Pragma("unroll") for (int k = 0; k < 2; ++k) dst[m][k] = *(const PG8_LAS bf16x8*)(lds + PG8_SA(b, h) + aoff + m * 2048 + k * 1024); } while (0)
#define PG8_LDB(dst, b, h) do { _Pragma("unroll") for (int n = 0; n < 2; ++n) _Pragma("unroll") for (int k = 0; k < 2; ++k) dst[n][k] = *(const PG8_LAS bf16x8*)(lds + PG8_SB(b, h) + boff + n * 2048 + k * 1024); } while (0)
#define PG8_MMA(ai, bj, At, Bt) do { __builtin_amdgcn_s_setprio(1); _Pragma("unroll") for (int m = 0; m < 4; ++m) _Pragma("unroll") for (int n = 0; n < 2; ++n) _Pragma("unroll") for (int k = 0; k < 2; ++k) \
        acc[ai][bj][m][n] = __builtin_amdgcn_mfma_f32_16x16x32_bf16(Bt[n][k], At[m][k], acc[ai][bj][m][n], 0, 0, 0); __builtin_amdgcn_s_setprio(0); } while (0)
#define PG8_WAIT_V(n) asm volatile("s_waitcnt vmcnt(" #n ")" ::: "memory")
#define PG8_WAIT_L(n) asm volatile("s_waitcnt lgkmcnt(" #n ")" ::: "memory")
#define PG8_BAR __builtin_amdgcn_s_barrier()
#define PG8_SCHED __builtin_amdgcn_sched_barrier(0)
#define PG8_AOFFS(dst, U) do { _Pragma("unroll") for (int _h = 0; _h < 2; ++_h) _Pragma("unroll") for (int _i = 0; _i < 2; ++_i) { \
        if constexpr (GATHER) dst[_h][_i] = ((unsigned)tok[(U).slot * TSTRIDE + _h * HALF + RA[_i]] & 0xffffu) * (unsigned)(K * 2) + colA[_i]; \
        else dst[_h][_i] = (unsigned)((_h * HALF + RA[_i]) * K) * 2u + colA[_i]; } } while (0)
    MUnit cur, nxt; int ui = 0;
    if (!S.next(0, cur)) return;
    f32x4 acc[2][2][4][2];
#pragma unroll
    for (int a = 0; a < 2; ++a)
#pragma unroll
        for (int b = 0; b < 2; ++b)
#pragma unroll
            for (int m = 0; m < 4; ++m)
#pragma unroll
                for (int n = 0; n < 2; ++n) acc[a][b][m][n] = (f32x4){0.f, 0.f, 0.f, 0.f};
    bf16x8 At[4][2], B0[2][2], B1[2][2];
    unsigned cv[2][2], nv[2][2];
    PG8_AOFFS(cv, cur);
    const char* cA = GATHER ? (const char*)g.A : (const char*)g.A + (size_t)cur.pm * tstep;
    const char* cB = (const char*)g.Bt + ((size_t)cur.e * g.brows + (size_t)cur.pn * BM) * KB * 2;
    const char* cB2 = (const char*)g.Bt + ((size_t)cur.e2 * g.brows + (size_t)cur.pn * BM) * KB * 2 - (size_t)nsw * kstep;
    S.a_ready(cur);
    PG8_STAGE(PG8_SB(0, 0), cB, voffB); PG8_STAGE(PG8_SB(0, 1), cB + hstep, voffB); PG8_STAGE(PG8_SA(0, 0), cA, cv[0]); PG8_STAGE(PG8_SA(0, 1), cA, cv[1]);
    if (wr == 1) PG8_BAR;
    PG8_WAIT_V(2); PG8_BAR;
    PG8_STAGE(PG8_SB(1, 0), cB + kstep, voffB); PG8_STAGE(PG8_SA(1, 0), cA + kstep, cv[0]); PG8_STAGE(PG8_SB(1, 1), cB + hstep + kstep, voffB);
    PG8_WAIT_V(6); PG8_BAR;
    for (;;) {
        const bool has_next = S.next(ui + 1, nxt);
        const bool do0 = cur.half < 0 || (cur.half & 1) == 0, do1 = cur.half < 0 || (cur.half & 1) == 1;
        const bool db0 = cur.half < 4 || ((cur.half >> 1) & 1) == 0, db1 = cur.half < 4 || ((cur.half >> 1) & 1) == 1;
        const char* nA = cA; const char* nB = cB; const char* nB2 = cB2;
        if (has_next) { PG8_AOFFS(nv, nxt); nA = GATHER ? (const char*)g.A : (const char*)g.A + (size_t)nxt.pm * tstep; nB = (const char*)g.Bt + ((size_t)nxt.e * g.brows + (size_t)nxt.pn * BM) * KB * 2; nB2 = (const char*)g.Bt + ((size_t)nxt.e2 * g.brows + (size_t)nxt.pn * BM) * KB * 2 - (size_t)nsw * kstep; }
        else {
#pragma unroll
            for (int h = 0; h < 2; ++h)
#pragma unroll
                for (int i = 0; i < 2; ++i) nv[h][i] = cv[h][i]; }
        for (int t = 0; t < nt; t += 2) {
            const bool last = (t == nt - 2);
            const char* a1 = cA + (size_t)(t + 1) * kstep;
            const char* a2 = last ? nA : cA + (size_t)(t + 2) * kstep; const char* b2 = last ? nB : ((DUALB && t + 2 >= nsw) ? cB2 : cB) + (size_t)(t + 2) * kstep;
            const char* a3 = a2 + kstep; const char* b3 = b2 + kstep;
            unsigned v2[2][2];
#pragma unroll
            for (int h = 0; h < 2; ++h)
#pragma unroll
                for (int i = 0; i < 2; ++i) v2[h][i] = last ? nv[h][i] : cv[h][i];
            if (last && has_next) S.a_ready(nxt);
            PG8_LDB(B0, 0, 0); PG8_LDB(B1, 0, 1); PG8_SCHED; PG8_LDA(At, 0, 0); PG8_STAGE(PG8_SA(1, 1), a1, cv[1]);
            PG8_WAIT_V(8); PG8_WAIT_L(0); PG8_BAR; if (do0) { if (db0) PG8_MMA(0, 0, At, B0); if (db1) PG8_MMA(0, 1, At, B1); } PG8_BAR; PG8_SCHED;
            PG8_LDA(At, 0, 1); PG8_STAGE(PG8_SB(0, 0), b2, voffB); PG8_STAGE(PG8_SB(0, 1), b2 + hstep, voffB); PG8_STAGE(PG8_SA(0, 0), a2, v2[0]);
            PG8_WAIT_V(8); PG8_WAIT_L(0); PG8_BAR; if (do1) { if (db0) PG8_MMA(1, 0, At, B0); if (db1) PG8_MMA(1, 1, At, B1); } PG8_BAR; PG8_SCHED;
            PG8_LDB(B0, 1, 0); PG8_LDB(B1, 1, 1); PG8_SCHED; PG8_LDA(At, 1, 0); PG8_STAGE(PG8_SA(0, 1), a2, v2[1]);
            PG8_WAIT_V(8); PG8_WAIT_L(0); PG8_BAR; if (do0) { if (db0) PG8_MMA(0, 0, At, B0); if (db1) PG8_MMA(0, 1, At, B1); } PG8_BAR; PG8_SCHED;
            PG8_LDA(At, 1, 1); PG8_STAGE(PG8_SB(1, 0), b3, voffB); PG8_STAGE(PG8_SB(1, 1), b3 + hstep, voffB); PG8_STAGE(PG8_SA(1, 0), a3, v2[0]);
            PG8_WAIT_V(8); PG8_WAIT_L(0); PG8_BAR; if (do1) { if (db0) PG8_MMA(1, 0, At, B0); if (db1) PG8_MMA(1, 1, At, B1); } PG8_BAR; PG8_SCHED;
        }
        if constexpr (ALIGN_EPI) { if (wr == 0) PG8_BAR; }
        E(acc, cur, wr, wc, fr, fq); S.done(cur);
        if (!has_next) break;
#pragma unroll
        for (int a = 0; a < 2; ++a)
#pragma unroll
            for (int b = 0; b < 2; ++b)
#pragma unroll
                for (int m = 0; m < 4; ++m)
#pragma unroll
                    for (int n = 0; n < 2; ++n) acc[a][b][m][n] = (f32x4){0.f, 0.f, 0.f, 0.f};
        cur = nxt; cA = nA; cB = nB; cB2 = nB2; ++ui;
#pragma unroll
        for (int h = 0; h < 2; ++h)
#pragma unroll
            for (int i = 0; i < 2; ++i) cv[h][i] = nv[h][i];
        if constexpr (ALIGN_EPI) { if (wr == 1) PG8_BAR; }
    }
    PG8_WAIT_V(0);
    if constexpr (!ALIGN_EPI) { if (wr == 0) PG8_BAR; }
    PG8_BAR;
#undef PG8_AOFFS
#undef PG8_SA
#undef PG8_SB
#undef PG8_STAGE
#undef PG8_LDA
#undef PG8_LDB
#undef PG8_MMA
#undef PG8_WAIT_V
#undef PG8_WAIT_L
#undef PG8_BAR
#undef PG8_SCHED
}
}
constexpr int NWAVES = 8;
constexpr int T_ = 65536, DM_ = 1024, NB_ = 32, SEQ_ = 2048, INC_ = 3592, UC_ = 3584;
constexpr int NE_ = 16, EH_ = 512;
constexpr int RMAX_ = 2 * T_ + NE_ * 256;
constexpr int NBK_ = 24, RMAXP_ = T_ + NBK_ * 256;
constexpr float EPS_ = 1e-6f;
constexpr float QSCALE_ = 0.125f * 1.4426950408889634f;
constexpr size_t MiB = 1u << 20;
constexpr size_t WS_CTL = 0, CTL_ZERO_BYTES = 1 * MiB;
constexpr size_t WS_LB = 1 * MiB, WS_WI = 2 * MiB, WS_WO = 9 * MiB, WS_WGU = 11 * MiB, WS_WD = 43 * MiB, WS_FLG = 59 * MiB;
constexpr size_t WS_RE = 61 * MiB, WS_RW = 62 * MiB, WS_ENTRY = 63 * MiB, WS_SROW = 67 * MiB, WS_SW = 68 * MiB, WS_STOK = 69 * MiB, WS_TILEE = 70 * MiB, WS_CUM = 71 * MiB  ;
constexpr size_t WS_RSTD = 73 * MiB;
constexpr size_t WS_XN = 74 * MiB;
constexpr size_t WS_U = 202 * MiB;
constexpr size_t WS_HB = 202 * MiB;
constexpr size_t WS_Y = 346 * MiB;
constexpr size_t WS_D = 650 * MiB;
constexpr size_t WS_ORAW = 650 * MiB;
constexpr size_t WS_MIX = 778 * MiB;
constexpr size_t WS_RMS0 = WS_RE;
constexpr size_t WS_END = 906 * MiB;
constexpr int CW_TMO = 0, CW_CODE = 1;
constexpr int CW_CNT = 64;
constexpr int CW_CLAIM = 256;
constexpr int CW_KT = 65536, CW_QT = CW_KT + 256 * 2 * 32;
constexpr int CW_PLAN = 128;
constexpr int CW_BAR = 4096;
constexpr int RING_OFF = 0, RING_BYTES = 131072;
constexpr int TAB_OFF = RING_BYTES, TAB_BYTES = 24576;
constexpr int LDSCTL_OFF = TAB_OFF + TAB_BYTES, MISC_OFF = LDSCTL_OFF + 320;
constexpr int LDS_BYTES = LDSCTL_OFF + 1024;

#define GAS __attribute__((address_space(1)))
#define LAS __attribute__((address_space(3)))
typedef unsigned short bf16;
typedef unsigned v4u __attribute__((ext_vector_type(4)));
typedef unsigned v2u __attribute__((ext_vector_type(2)));
typedef float f32x4 __attribute__((ext_vector_type(4)));
typedef short bf16x8 __attribute__((ext_vector_type(8)));
typedef GAS unsigned gu32;
#define RLX_AGENT __ATOMIC_RELAXED, __HIP_MEMORY_SCOPE_AGENT
#define LDS_WAIT() asm volatile("s_waitcnt lgkmcnt(0)" ::: "memory")
#define VM_WAIT() asm volatile("s_waitcnt vmcnt(0)" ::: "memory")
__device__ __forceinline__ unsigned f2bf(float f) { unsigned u = __builtin_bit_cast(unsigned, f); return (u + 0x7fffu + ((u >> 16) & 1u)) >> 16; }
__device__ __forceinline__ unsigned pk2(float lo, float hi) { return f2bf(lo) | (f2bf(hi) << 16); }
__device__ __forceinline__ float bf2f(unsigned short b) { return __builtin_bit_cast(float, (unsigned)b << 16); }
__device__ __forceinline__ float bflo(unsigned w) { return __builtin_bit_cast(float, w << 16); }
__device__ __forceinline__ float bfhi(unsigned w) { return __builtin_bit_cast(float, w & 0xffff0000u); }

#define XB_TMO      128
#define XB_XCNT(j)  (256  + 64 * (j))
#define XB_XSUB(j)  (1280 + 64 * (j))
#define XB_XGEN(j)  (2304 + 64 * (j))
#define XB_TOP      3328
#define XB_TOPGEN   3392
#define XCD_BAR_WORDS 3456
#define XB_SPIN_CAP (1u << 18)

__device__ __forceinline__ unsigned xb_ld(unsigned* p)              { return __hip_atomic_load(p, __ATOMIC_RELAXED, __HIP_MEMORY_SCOPE_AGENT); }
__device__ __forceinline__ unsigned xb_add(unsigned* p, unsigned v) { return __hip_atomic_fetch_add(p, v, __ATOMIC_RELAXED, __HIP_MEMORY_SCOPE_AGENT); }
__device__ __forceinline__ unsigned xb_xcc_id() { return (unsigned)__builtin_amdgcn_s_getreg((3 << 11) | 20) & 0xFu; }
#define XB_SPIN(cond, bar) do { unsigned _sp = 0; while (cond) { __builtin_amdgcn_s_sleep(1); \
    if ((++_sp & 255u) == 0u) { if (xb_ld(&(bar)[XB_TMO])) break; if (_sp > XB_SPIN_CAP) { atomicAdd(&(bar)[XB_TMO], 1u); break; } } } } while (0)

struct XcdBarrier {
    unsigned* bar; unsigned x;
    volatile LAS unsigned* st;
};

__device__ __forceinline__ XcdBarrier xcd_barrier_post(unsigned* bar, volatile LAS unsigned* st) {
    XcdBarrier b; b.bar = bar; b.x = xb_xcc_id(); b.st = st;
    if (threadIdx.x == 0) (void)xb_add(&bar[XB_XCNT(b.x)], 1u);
    return b;
}
__device__ __forceinline__ void xcd_barrier_complete(unsigned* bar, unsigned x, unsigned& nloc, unsigned& nx) {
    const unsigned G = gridDim.x * gridDim.y * gridDim.z;
    unsigned sum, cnt, mine, sp = 0u;
    for (;;) {
        sum = 0u; cnt = 0u; mine = 0u;
#pragma unroll
        for (unsigned j = 0; j < 16; ++j) { const unsigned c = xb_ld(&bar[XB_XCNT(j)]); sum += c; cnt += (c > 0u) ? 1u : 0u; mine = (j == x) ? c : mine; }
        if (sum == G) break;
        __builtin_amdgcn_s_sleep(1);
        if ((++sp & 255u) == 0u) { if (xb_ld(&bar[XB_TMO])) break; if (sp > XB_SPIN_CAP) { atomicAdd(&bar[XB_TMO], 1u); break; } }
    }
    nloc = mine > 0u ? mine : 1u; nx = cnt > 0u ? cnt : 1u;
}

__device__ __forceinline__ void xcd_barrier(const XcdBarrier& b) {
    asm volatile("s_waitcnt vmcnt(0)" ::: "memory");
    __syncthreads();
    if (threadIdx.x == 0) {
        unsigned* bar = b.bar;
        __builtin_amdgcn_s_waitcnt(0);
        unsigned nloc = b.st[0], nx = b.st[1];
        if (nloc == 0u) { xcd_barrier_complete(bar, b.x, nloc, nx); b.st[0] = nloc; b.st[1] = nx; }
        const unsigned old = xb_add(&bar[XB_XSUB(b.x)], 1u);
        const unsigned gen = old / nloc;
        if (old + 1u == (gen + 1u) * nloc) {
            __builtin_amdgcn_fence(__ATOMIC_RELEASE, "agent");
            asm volatile("s_waitcnt vmcnt(0)" ::: "memory");
            const unsigned og = xb_add(&bar[XB_TOP], 1u);
            const unsigned tg = og / nx;
            if (og + 1u == (tg + 1u) * nx) xb_add(&bar[XB_TOPGEN], 1u);
            else XB_SPIN(xb_ld(&bar[XB_TOPGEN]) == tg, bar);
            __builtin_amdgcn_fence(__ATOMIC_ACQUIRE, "agent");
            xb_add(&bar[XB_XGEN(b.x)], 1u);
            asm volatile("s_waitcnt vmcnt(0)" ::: "memory");
        } else {
            XB_SPIN(xb_ld(&bar[XB_XGEN(b.x)]) == gen, bar);
            __builtin_amdgcn_fence(__ATOMIC_ACQUIRE, "agent");
            asm volatile("s_waitcnt vmcnt(0)" ::: "memory");
        }
    }
    __syncthreads();
}


struct Frame {
    LAS unsigned char* lds;
    volatile LAS unsigned* MISC;
    gu32* ctl;
    int tid, lane, wave;
    int vcu, G;
    const float* in[17]; float* out; unsigned char* ws;
};
template <int CTRL, int RM> __device__ __forceinline__ float dpp_add(float v) { return v + __builtin_bit_cast(float, __builtin_amdgcn_update_dpp(0, __builtin_bit_cast(int, v), CTRL, RM, 0xf, RM == 0xf)); }
__device__ __forceinline__ float wave_sum(float v) {
    v = dpp_add<0xB1, 0xf>(v); v = dpp_add<0x4E, 0xf>(v); v = dpp_add<0x141, 0xf>(v); v = dpp_add<0x140, 0xf>(v);
    v = dpp_add<0x142, 0xa>(v);
    v = dpp_add<0x143, 0xc>(v);
    return __builtin_bit_cast(float, __builtin_amdgcn_readlane(__builtin_bit_cast(int, v), 63));
}
template <bool SC = false> __device__ __forceinline__ void p0_transpose_block(const float* src, int pitch, bf16* dst, int Kdst, LAS float* scr, int lane, const float* ksc = nullptr) {
#pragma unroll 8
    for (int i = 0; i < 32; ++i) { const int kk = 2 * i + (lane >> 5); float v_ = src[(size_t)kk * pitch + (lane & 31)]; if constexpr (SC) v_ *= ksc[kk]; scr[kk * 33 + (lane & 31)] = v_; }
    LDS_WAIT(); asm volatile("" ::: "memory");
    const int c = lane & 7;
#pragma unroll
    for (int j = 0; j < 4; ++j) { const int n = (lane >> 3) + 8 * j; const LAS float* s = scr + (8 * c) * 33 + n;
        v4u o; o.x = pk2(s[0 * 33], s[1 * 33]); o.y = pk2(s[2 * 33], s[3 * 33]); o.z = pk2(s[4 * 33], s[5 * 33]); o.w = pk2(s[6 * 33], s[7 * 33]);
        *(GAS v4u*)(dst + (size_t)n * Kdst + 8 * c) = o; }
    LDS_WAIT(); asm volatile("" ::: "memory");
}
__device__ __forceinline__ void convert_items(Frame& F, int first, int count, int gw, int NGW) {
    LAS float* scr = (LAS float*)(F.lds + RING_OFF + F.wave * 16384);
    const float* w_in = F.in[2]; const float* w_out = F.in[7]; const float* w_gate = F.in[13]; const float* w_up = F.in[14]; const float* w_down = F.in[15];
    bf16* WI = (bf16*)(F.ws + WS_WI); bf16* WO = (bf16*)(F.ws + WS_WO); bf16* WGU = (bf16*)(F.ws + WS_WGU); bf16* WD = (bf16*)(F.ws + WS_WD);
    constexpr int I_WI = 16 * 112, I_WO = 16 * 32, I_WG = 16 * 256;
    for (int it = first + gw; it < first + count; it += NGW) {
        int r = it;
        if (r < I_WI) { const int kb = r / 112, nb = r % 112; p0_transpose_block(w_in + (size_t)(64 * kb) * INC_ + 32 * nb, INC_, WI + (size_t)(32 * nb) * 1024 + 64 * kb, 1024, scr, F.lane); continue; } r -= I_WI;
        if (r < I_WO) { const int kb = r / 32, nb = r % 32; p0_transpose_block(w_out + (size_t)(64 * kb) * 1024 + 32 * nb, 1024, WO + (size_t)(32 * nb) * 1024 + 64 * kb, 1024, scr, F.lane); continue; } r -= I_WO;
        if (r < 2 * I_WG) { const int up = r >= I_WG; if (up) r -= I_WG; const int e = r / 256, q = r % 256, kb = q / 16, nb = q % 16, n0 = 32 * nb;
            const int drow = (n0 >> 7) * 256 + (n0 & 127) + (up ? 128 : 0);
            p0_transpose_block<true>((up ? w_up : w_gate) + (size_t)e * 1024 * 512 + (size_t)(64 * kb) * 512 + n0, 512, WGU + ((size_t)e * 1024 + drow) * 1024 + 64 * kb, 1024, scr, F.lane, F.in[8] + 64 * kb); continue; }   r -= 2 * I_WG;
        { const int e = r / 256, q = r % 256, kb = q / 32, nb = q % 32;
            p0_transpose_block(w_down + (size_t)e * 512 * 1024 + (size_t)(64 * kb) * 1024 + 32 * nb, 1024, WD + ((size_t)e * 1024 + 32 * nb) * 512 + 64 * kb, 512, scr, F.lane); }
    }
}
constexpr int CONV_I_WI = 16 * 112, CONV_I_REST = 16 * 32 + 2 * 16 * 256 + 16 * 256;
__device__ __forceinline__ void p0_prologue(Frame& F) {
    const int gw = F.vcu * NWAVES + F.wave, NGW = F.G * NWAVES;
    const float* w_in = F.in[2];
    convert_items(F, 0, (F.G == 256 && (MK_OPT_MASK & 4)) ? CONV_I_WI : CONV_I_WI + CONV_I_REST, gw, NGW);
    { float* LB = (float*)(F.ws + WS_LB); const float* lg = F.in[3];
      for (int i = gw * 64 + F.lane; i < 512; i += NGW * 64) { const float a = lg[i], b = lg[512 + i]; LB[i] = 1.f / (1.f + expf(b - a)); } }
    const float* x = F.in[0]; const float* gain = F.in[1]; const float* fb = F.in[5];
    bf16* XN = (bf16*)(F.ws + WS_XN); float* FLG = (float*)(F.ws + WS_FLG);
    f32x4 gv[4]; f32x4 wfa[4][4], wfb[4][4];
#pragma unroll
    for (int j = 0; j < 4; ++j) { gv[j] = *(const GAS f32x4*)(gain + 256 * j + 4 * F.lane);
#pragma unroll
        for (int c = 0; c < 4; ++c) { const float* wp = w_in + (size_t)(256 * j + 4 * F.lane + c) * INC_ + 3584; wfa[j][c] = *(const GAS f32x4*)wp; wfb[j][c] = *(const GAS f32x4*)(wp + 4); } }
    const float fbv = fb[F.lane & 7];
    f32x4 nx[4];
#define P0_LOAD(mm) do { const GAS f32x4* xr_ = (const GAS f32x4*)(x + (size_t)(mm) * DM_) + F.lane; _Pragma("unroll") for (int j = 0; j < 4; ++j) nx[j] = xr_[64 * j]; } while (0)
    if (gw < T_) P0_LOAD(gw);
    for (int m = gw; m < T_; m += NGW) {
        f32x4 v[4]; float s = 0.f;
#pragma unroll
        for (int j = 0; j < 4; ++j) v[j] = nx[j];
        if (m + NGW < T_) P0_LOAD(m + NGW);
#pragma unroll
        for (int j = 0; j < 4; ++j) s += (v[j].x * v[j].x + v[j].y * v[j].y) + (v[j].z * v[j].z + v[j].w * v[j].w);
        const float rms_ = sqrtf(wave_sum(s) * (1.f / DM_) + EPS_); const float rstd = 1.f / rms_;
        if (F.lane == 0) ((float*)(F.ws + WS_RMS0))[m] = rms_;
        f32x4 pa = {0.f, 0.f, 0.f, 0.f}, pb = {0.f, 0.f, 0.f, 0.f};
        GAS unsigned long long* o8 = (GAS unsigned long long*)(XN + (size_t)m * DM_) + F.lane;
#pragma unroll
        for (int j = 0; j < 4; ++j) { v[j] = v[j] * rstd * gv[j];
            o8[64 * j] = (unsigned long long)pk2(v[j].x, v[j].y) | ((unsigned long long)pk2(v[j].z, v[j].w) << 32);
#pragma unroll
            for (int c = 0; c < 4; ++c) { pa += wfa[j][c] * v[j][c]; pb += wfb[j][c] * v[j][c]; } }
        float zz;
        { const float z[8] = {pa.x, pa.y, pa.z, pa.w, pb.x, pb.y, pb.z, pb.w}; const bool b0 = F.lane & 1, b1 = F.lane & 2, b2 = F.lane & 4;
          float y[4], w2[2];
#pragma unroll
          for (int k = 0; k < 4; ++k) { const float keep = b0 ? z[2 * k + 1] : z[2 * k], send = b0 ? z[2 * k] : z[2 * k + 1];
              y[k] = keep + __builtin_bit_cast(float, __builtin_amdgcn_update_dpp(0, __builtin_bit_cast(int, send), 0xB1, 0xf, 0xf, true)); }
#pragma unroll
          for (int j = 0; j < 2; ++j) { const float keep = b1 ? y[2 * j + 1] : y[2 * j], send = b1 ? y[2 * j] : y[2 * j + 1];
              w2[j] = keep + __builtin_bit_cast(float, __builtin_amdgcn_update_dpp(0, __builtin_bit_cast(int, send), 0x4E, 0xf, 0xf, true)); }
          { const float keep = b2 ? w2[1] : w2[0], send = b2 ? w2[0] : w2[1];
            const int h_ = __builtin_amdgcn_update_dpp(0, __builtin_bit_cast(int, send), 0x141, 0xf, 0xf, true);
            zz = keep + __builtin_bit_cast(float, __builtin_amdgcn_update_dpp(0, h_, 0x1B, 0xf, 0xf, true)); }
          { const int m_ = __builtin_amdgcn_update_dpp(0, __builtin_bit_cast(int, zz), 0x140, 0xf, 0xf, true);
            zz += __builtin_bit_cast(float, __builtin_amdgcn_update_dpp(0, m_, 0x141, 0xf, 0xf, true)); }
          zz += __builtin_bit_cast(float, __builtin_amdgcn_ds_bpermute((F.lane ^ 16) << 2, __builtin_bit_cast(int, zz)));
          zz += __builtin_bit_cast(float, __builtin_amdgcn_ds_bpermute((F.lane ^ 32) << 2, __builtin_bit_cast(int, zz))); }
        zz += fbv;
        const float ls = fminf(zz, 0.f) - log1pf(expf(-fabsf(zz)));
        if (F.lane < 8) FLG[(size_t)m * 8 + F.lane] = ls;
    }
}
template <bool DRY  > __device__ __forceinline__ void p4_router(Frame& F) {
    const float* wg = F.in[9]; const float* bg = F.in[10]; const float* we = F.in[11]; const float* be = F.in[12]; const float* gain = F.in[8];
    LAS unsigned char* BIMG = F.lds + RING_OFF;
    LAS float* LGW = (LAS float*)(F.lds + TAB_OFF) + F.wave * 640;
    LAS int* cntL = (LAS int*)(F.lds + TAB_OFF + 8 * 640 * 4);
    LAS int* baseL = cntL + 32;
    LAS int* asg = cntL + 64;
    const int fr = F.lane & 15, g4 = F.lane >> 4;
#pragma unroll 4
    for (int f = F.tid; f < 32 * 2 * 64; f += NWAVES * 64) { const int ks = f >> 7, ct = (f >> 6) & 1, ln = f & 63; const int col = 16 * ct + (ln & 15), k0 = 32 * ks + 8 * (ln >> 4);
        v4u h, l;
#pragma unroll
        for (int jp = 0; jp < 4; ++jp) { float w2[2];
#pragma unroll
            for (int e = 0; e < 2; ++e) { const int k = k0 + 2 * jp + e; w2[e] = (col < 4) ? gain[k] * wg[(size_t)k * 4 + col] : ((col < 20) ? gain[k] * we[(size_t)k * 16 + (col - 4)] : 0.f); }
            const unsigned h0 = f2bf(w2[0]), h1 = f2bf(w2[1]); h[jp] = h0 | (h1 << 16);
            l[jp] = f2bf(w2[0] - bf2f((unsigned short)h0)) | (f2bf(w2[1] - bf2f((unsigned short)h1)) << 16); }
        *(LAS v4u*)(BIMG + (size_t)f * 16) = h; *(LAS v4u*)(BIMG + 65536 + (size_t)f * 16) = l; }
    if (F.tid < 32) cntL[F.tid] = 0;
    __syncthreads();
    const bf16* H1 = (const bf16*)(F.ws + WS_D); float* RSTD = (float*)(F.ws + WS_RSTD); float* RW = (float*)(F.ws + WS_RW);
    float bgv[4], bev[16];
#pragma unroll
    for (int i = 0; i < 4; ++i) bgv[i] = bg[i];
#pragma unroll
    for (int i = 0; i < 16; ++i) bev[i] = be[i];
    for (int blk = F.vcu; blk < T_ / 256; blk += F.G) {
        bf16x8 A0[16], A1[16];
#define P4_LDA(dst, tile, half) do { const GAS bf16x8* p_ = (const GAS bf16x8*)(H1 + (size_t)(blk * 256 + F.wave * 32 + (tile) * 16 + fr) * DM_ + (half) * 512 + 8 * g4); \
        _Pragma("unroll") for (int q_ = 0; q_ < 16; ++q_) dst[q_] = p_[4 * q_]; } while (0)
#define P4_MMA(src, half) do { _Pragma("unroll") for (int q_ = 0; q_ < 16; ++q_) { const int ks_ = (half) * 16 + q_; \
            const bf16x8 bh0 = *(const LAS bf16x8*)(BIMG + (ks_ * 2 + 0) * 1024 + F.lane * 16), bh1 = *(const LAS bf16x8*)(BIMG + (ks_ * 2 + 1) * 1024 + F.lane * 16); \
            const bf16x8 bl0 = *(const LAS bf16x8*)(BIMG + 65536 + (ks_ * 2 + 0) * 1024 + F.lane * 16), bl1 = *(const LAS bf16x8*)(BIMG + 65536 + (ks_ * 2 + 1) * 1024 + F.lane * 16); \
            acc0 = __builtin_amdgcn_mfma_f32_16x16x32_bf16(src[q_], bh0, acc0, 0, 0, 0); acc1 = __builtin_amdgcn_mfma_f32_16x16x32_bf16(src[q_], bh1, acc1, 0, 0, 0); \
            acc0 = __builtin_amdgcn_mfma_f32_16x16x32_bf16(src[q_], bl0, acc0, 0, 0, 0); acc1 = __builtin_amdgcn_mfma_f32_16x16x32_bf16(src[q_], bl1, acc1, 0, 0, 0); \
            accs = __builtin_amdgcn_mfma_f32_16x16x32_bf16(src[q_], src[q_], accs, 0, 0, 0); } } while (0)
        P4_LDA(A0, 0, 0); P4_LDA(A1, 0, 1);
#pragma unroll
        for (int tile = 0; tile < 2; ++tile) {
            f32x4 acc0 = {0.f, 0.f, 0.f, 0.f}, acc1 = {0.f, 0.f, 0.f, 0.f}, accs = {0.f, 0.f, 0.f, 0.f};
            P4_MMA(A0, 0); if (tile == 0) P4_LDA(A0, 1, 0);
            P4_MMA(A1, 1); if (tile == 0) P4_LDA(A1, 1, 1);
#pragma unroll
            for (int rg = 0; rg < 4; ++rg) { LGW[(4 * g4 + rg) * 33 + fr] = acc0[rg]; LGW[(4 * g4 + rg) * 33 + 16 + fr] = acc1[rg]; }
            { const float d = (fr & 3) == 0 ? accs[0] : ((fr & 3) == 1 ? accs[1] : ((fr & 3) == 2 ? accs[2] : accs[3])); if ((fr >> 2) == g4) LGW[528 + fr] = d; }
            asm volatile("s_waitcnt lgkmcnt(0)" ::: "memory");
            if (F.lane < 16) { const int rl = F.wave * 32 + tile * 16 + F.lane; const int tok = blk * 256 + rl;
                float lg[20];
#pragma unroll
                for (int q = 0; q < 20; ++q) lg[q] = LGW[F.lane * 33 + q];
                const float rq = 1.f / sqrtf(LGW[528 + F.lane] * (1.f / DM_) + EPS_);
                float g[4]; int gs = 0;
#pragma unroll
                for (int i = 0; i < 4; ++i) g[i] = lg[i] * rq + bgv[i];
                float gm = g[0];
#pragma unroll
                for (int i = 1; i < 4; ++i) if (g[i] > gm) { gm = g[i]; gs = i; }
                float den = 0.f;
#pragma unroll
                for (int i = 0; i < 4; ++i) den += expf(g[i] - gm);
                const float pg = 1.f / den;
                float e[4];
#pragma unroll
                for (int i = 0; i < 4; ++i) { float xx = 0.f;
#pragma unroll
                    for (int q = 0; q < 4; ++q) xx = (q == gs) ? (lg[4 + q * 4 + i] * rq + bev[q * 4 + i]) : xx;
                    e[i] = xx; }
                int i0 = 0; float e0v = e[0];
#pragma unroll
                for (int i = 1; i < 4; ++i) if (e[i] > e0v) { e0v = e[i]; i0 = i; }
                int i1 = -1; float e1v = -3.0e38f;
#pragma unroll
                for (int i = 0; i < 4; ++i) if (i != i0 && e[i] > e1v) { e1v = e[i]; i1 = i; }
                if (i1 < 0) i1 = (i0 + 1) & 3;
                const float p1r = expf(e1v - e0v); const float w0 = pg / (1.f + p1r), w1 = pg * p1r / (1.f + p1r);
                const int a = i0 < i1 ? i0 : i1, b2 = i0 < i1 ? i1 : i0; const int pidx = (a == 0) ? (b2 - 1) : ((a == 1) ? (b2 + 1) : 5); const int bk = gs * 6 + pidx;
                RW[tok * 2] = (i0 < i1) ? w0 : w1; RW[tok * 2 + 1] = (i0 < i1) ? w1 : w0; RSTD[tok] = rq;
                const int la = __hip_atomic_fetch_add(cntL + bk, 1, __ATOMIC_RELAXED, __HIP_MEMORY_SCOPE_WORKGROUP);
                asg[rl] = bk | (la << 8); }
            asm volatile("s_waitcnt lgkmcnt(0)" ::: "memory");
        }
#undef P4_LDA
#undef P4_MMA
    __syncthreads();
    if (!DRY && F.tid < NBK_) { const int c = cntL[F.tid]; baseL[F.tid] = (int)__hip_atomic_fetch_add((unsigned*)(F.ctl + CW_CNT + F.tid), (unsigned)c, RLX_AGENT); }
    __syncthreads();
    if (!DRY && F.tid < 256) { int* ENTRY = (int*)(F.ws + WS_ENTRY); const int a = asg[F.tid]; const int bk = a & 0xff, lp = a >> 8;
      ENTRY[(size_t)bk * T_ + baseL[bk] + lp] = blk * 256 + F.tid; }
    __syncthreads();
    if (F.tid < 32) cntL[F.tid] = 0;
    __syncthreads();
    }
}
constexpr int TB_OFF = TAB_OFF + 23 * 1024;
__device__ __forceinline__ void moe_tables(Frame& F, bool down) {
    LAS int* tb = (LAS int*)(F.lds + TB_OFF);
    if (F.tid < NBK_) tb[32 + F.tid] = (int)F.ctl[CW_CNT + F.tid];
    __syncthreads();
    if (F.tid == 0) { int base = 0;
        for (int b = 0; b < NBK_; ++b) { tb[b] = base; base += (tb[32 + b] + 255) >> 8; }
        tb[NBK_] = base; }
    __syncthreads();
    const int NT = tb[NBK_]; const int sh = down ? 2 : 3; const int* ENTRY = (const int*)(F.ws + WS_ENTRY); const float* RW = (const float*)(F.ws + WS_RW); const float* RSTD = (const float*)(F.ws + WS_RSTD);
    int tbr[NBK_];
#pragma unroll
    for (int j = 0; j < NBK_; ++j) tbr[j] = tb[j];
    int tkv[11];
#pragma unroll
    for (int i = 0; i < 11; ++i) { int g, half; tkv[i] = -1;
        if (pg8::moe_deal(i, F.vcu, F.G, NT << sh, g, half, down) && F.tid < 256) { const int rt = g >> sh; int bk = 0;
#pragma unroll
            for (int j = 1; j < NBK_; ++j) bk = (rt >= tbr[j]) ? j : bk;
            const int cnt = tb[32 + bk]; const int pos = (rt - tb[bk]) * 256 + F.tid;
            if (pos < cnt) tkv[i] = ENTRY[(size_t)bk * T_ + pos]; } }
#pragma unroll
    for (int i = 0; i < 11; ++i) { int g, half;
        if (pg8::moe_deal(i, F.vcu, F.G, NT << sh, g, half, down) && F.tid < 256) { const int t = tkv[i]; const bool valid = t >= 0;
            if (!down) { const float w = valid ? RW[t * 2 + ((g >> 2) & 1)] : 0.f;
                ((LAS unsigned*)(F.lds + TAB_OFF))[i * 512 + F.tid] = valid ? ((unsigned)t | (f2bf(w) << 16)) : 0u; ((LAS float*)(F.lds + TAB_OFF))[i * 512 + 256 + F.tid] = valid ? RSTD[t] : 0.f; }
            else ((LAS int*)(F.lds + TAB_OFF))[i * 256 + F.tid] = t; } }
    __syncthreads();
}
template <bool DRY  > __device__ __forceinline__ void p7_final(Frame& F) {
    const int gw = F.vcu * NWAVES + F.wave, NGW = F.G * NWAVES;
    const float* gain = F.in[16]; const bf16* Y = (const bf16*)(F.ws + WS_Y); const bf16* H1 = (const bf16*)(F.ws + WS_D);
    f32x4 gv[4];
#pragma unroll
    for (int j = 0; j < 4; ++j) gv[j] = *(const GAS f32x4*)(gain + 256 * j + 4 * F.lane);
    const bool poison = __hip_atomic_load(F.ctl + 2, RLX_AGENT) != 0u;
    v2u na[4], nd[4];
#define P7_LOAD(mm) do { const GAS v2u* d_ = (const GAS v2u*)(H1 + (size_t)(mm) * DM_) + F.lane; const GAS v2u* y0_ = (const GAS v2u*)(Y + (size_t)(mm) * DM_) + F.lane; \
        _Pragma("unroll") for (int j = 0; j < 4; ++j) { na[j] = y0_[64 * j]; nd[j] = d_[64 * j]; } } while (0)
    if (gw < T_) P7_LOAD(gw);
    for (int m = gw; m < T_; m += NGW) {
        GAS f32x4* xr = (GAS f32x4*)((DRY ? (float*)(F.ws + 778 * MiB) : F.out) + (size_t)(DRY ? (m & 32767) : m) * DM_) + F.lane;
        f32x4 v[4]; v2u ya[4]; float s = 0.f;
#pragma unroll
        for (int j = 0; j < 4; ++j) { const v2u d = nd[j]; v[j] = (f32x4){bflo(d.x), bfhi(d.x), bflo(d.y), bfhi(d.y)}; ya[j] = na[j]; }
        if (m + NGW < T_) P7_LOAD(m + NGW);
#pragma unroll
        for (int j = 0; j < 4; ++j) { const v2u a = ya[j];
            v[j].x += bflo(a.x); v[j].y += bfhi(a.x); v[j].z += bflo(a.y); v[j].w += bfhi(a.y);
            s += (v[j].x * v[j].x + v[j].y * v[j].y) + (v[j].z * v[j].z + v[j].w * v[j].w); }
        const float rstd = 1.f / sqrtf(wave_sum(s) * (1.f / DM_) + EPS_);
#pragma unroll
        for (int j = 0; j < 4; ++j) xr[64 * j] = v[j] * (poison ? 1.5f * rstd : rstd) * gv[j];
    }
#undef P7_LOAD
}
namespace attn_body {
using bf16=__hip_bfloat16;
using bf16x8=__attribute__((ext_vector_type(8)))short;
using s16x4=__attribute__((ext_vector_type(4)))short;
using f32x16=__attribute__((ext_vector_type(16)))float;
using u32x4=__attribute__((ext_vector_type(4)))unsigned;
constexpr int BATCH=32,NHEAD=8,SEQ=2048,D=64,DM=3584,DMO=1024;
constexpr int NW=8,QBLK=32,QB=QBLK*NW,KVBLK=64,NQB=SEQ/QB;
constexpr int ATTN_PITCH=DM, ATTN_UNIT_ROWS=QB;
__device__ __forceinline__ int crow(int r,int hi){return (r&3)+8*(r>>2)+4*hi;}
#define SBAR() __builtin_amdgcn_sched_barrier(0)
__device__ __forceinline__ void cmask(f32x16&p0,f32x16&p1,int jb,int qrel,int hi){
  const float NEG=-INFINITY; int kb=64*jb+4*hi;
  #pragma unroll
  for(int r=0;r<16;++r){int kv=kb+(r&3)+8*(r>>2); if(kv>qrel)p0[r]=NEG; if(kv+32>qrel)p1[r]=NEG;}
}

constexpr int NSLOT=3, SLOTB=8192;
constexpr int LDS_K=0, LDS_V=NSLOT*SLOTB, LDS_WS=2*NSLOT*SLOTB, LDS_OST=LDS_WS+NW*64*4, LDS_KB=LDS_OST+NW*4096, LDS_SCAN=LDS_KB+SEQ*16, LDS_NRM=LDS_SCAN+64, LDS_TIL=LDS_NRM+2*SEQ*4, LDS_BYTES=LDS_TIL+512;
typedef float f32x4_t __attribute__((ext_vector_type(4)));
constexpr float C2=0.125f*1.4426950408889634f;
__device__ __forceinline__ void glds16s(const void*sbase,unsigned voff,unsigned lds_dst){unsigned keep;
  asm volatile("s_mov_b32 %0, m0\n\ts_mov_b32 m0, %3\n\ts_nop 0\n\tglobal_load_lds_dwordx4 %1, %2\n\ts_mov_b32 m0, %0":"=&s"(keep):"v"(voff),"s"(sbase),"s"(lds_dst):"memory");}
__device__ __forceinline__ void glds16(const void*gsrc,unsigned lds_dst){unsigned keep;
  asm volatile("s_mov_b32 %0, m0\n\ts_mov_b32 m0, %2\n\ts_nop 0\n\tglobal_load_lds_dwordx4 %1, off\n\ts_mov_b32 m0, %0":"=&s"(keep):"v"(gsrc),"s"(lds_dst):"memory");}
__device__ __forceinline__ float max3f(float a,float b,float c){float r;asm("v_max3_f32 %0, %1, %2, %3":"=v"(r):"v"(a),"v"(b),"v"(c));return r;}
__device__ __forceinline__ float max2f(float a,float b){float r;asm("v_max_f32_e32 %0, %1, %2":"=v"(r):"v"(a),"v"(b));return r;}
__device__ __forceinline__ float fadd_s(float a,float b){float r;asm("v_add_f32_e32 %0, %1, %2":"=v"(r):"v"(a),"v"(b));return r;}
__device__ __forceinline__ float fsub_s(float a,float b){float r;asm("v_sub_f32_e32 %0, %1, %2":"=v"(r):"v"(a),"v"(b));return r;}
typedef float f32x2_t __attribute__((ext_vector_type(2))); typedef __bf16 bf16x2_t __attribute__((ext_vector_type(2)));
__device__ __forceinline__ unsigned cvtpk_s(float lo,float hi){f32x2_t v={lo,hi};bf16x2_t b=__builtin_convertvector(v,bf16x2_t);return __builtin_bit_cast(unsigned,b);}
#define WAIT_BAR(N) asm volatile("s_waitcnt vmcnt(" #N ") lgkmcnt(0)\n\ts_barrier":::"memory")

__device__ __forceinline__ void qkt(f32x16&p0,f32x16&p1,const char*Kslot,const bf16x8*qr,const f32x16&negm,int r32,int hi){
  const char*kb=Kslot+hi*1024+r32*16;
  #pragma unroll
  for(int d0=0;d0<4;++d0){
    const bf16x8 b0=*reinterpret_cast<const bf16x8*>(kb+d0*2048);
    const bf16x8 b1=*reinterpret_cast<const bf16x8*>(kb+d0*2048+512);
    if(d0==0){p0=__builtin_amdgcn_mfma_f32_32x32x16_bf16(b0,qr[0],negm,0,0,0);p1=__builtin_amdgcn_mfma_f32_32x32x16_bf16(b1,qr[0],negm,0,0,0);}
    else{p0=__builtin_amdgcn_mfma_f32_32x32x16_bf16(b0,qr[d0],p0,0,0,0);p1=__builtin_amdgcn_mfma_f32_32x32x16_bf16(b1,qr[d0],p1,0,0,0);}}
}
typedef __attribute__((address_space(3))) const char* lds_cptr;
typedef short v4i16_t __attribute__((ext_vector_type(4)));
__device__ __forceinline__ void kload8(bf16x8*kf,lds_cptr kp){
  kf[0]=*(const __attribute__((address_space(3))) bf16x8*)(kp);      kf[1]=*(const __attribute__((address_space(3))) bf16x8*)(kp+512);
  kf[2]=*(const __attribute__((address_space(3))) bf16x8*)(kp+2048); kf[3]=*(const __attribute__((address_space(3))) bf16x8*)(kp+2560);
  kf[4]=*(const __attribute__((address_space(3))) bf16x8*)(kp+4096); kf[5]=*(const __attribute__((address_space(3))) bf16x8*)(kp+4608);
  kf[6]=*(const __attribute__((address_space(3))) bf16x8*)(kp+6144); kf[7]=*(const __attribute__((address_space(3))) bf16x8*)(kp+6656);
}
__device__ __forceinline__ void kload2(bf16x8*kf,lds_cptr kp,int j){ kf[2*j]=*(const __attribute__((address_space(3))) bf16x8*)(kp+j*2048); kf[2*j+1]=*(const __attribute__((address_space(3))) bf16x8*)(kp+j*2048+512); }
__device__ __forceinline__ s16x4 vtr(lds_cptr p){ return __builtin_bit_cast(s16x4,__builtin_amdgcn_ds_read_tr16_b64_v4i16((__attribute__((address_space(3))) v4i16_t*)p)); }
__device__ __forceinline__ float rowmax(const f32x16&p0,const f32x16&p1){
  float a=max3f(p0[0],p0[1],p1[0]),b=max3f(p0[2],p0[3],p1[1]);a=max3f(a,p1[2],p1[3]);
  #pragma unroll
  for(int r=4;r<16;r+=4){a=max3f(a,p0[r],p0[r+1]);b=max3f(b,p0[r+2],p0[r+3]);a=max3f(a,p1[r],p1[r+1]);b=max3f(b,p1[r+2],p1[r+3]);}
  const float m=max2f(a,b);
  auto rr=__builtin_amdgcn_permlane32_swap(__float_as_uint(m),__float_as_uint(m),false,false);
  return max2f(__uint_as_float(rr[0]),__uint_as_float(rr[1]));
}
__device__ __forceinline__ void pv(f32x16*o,int vb,bf16x8 pa0,bf16x8 pa1,bf16x8 pa2,bf16x8 pa3){
  #pragma unroll
  for(int d0=0;d0<2;++d0){s16x4 lo[4],hi[4];
    #pragma unroll
    for(int ks=0;ks<4;++ks){
      asm volatile("ds_read_b64_tr_b16 %0,%1 offset:%c2":"=&v"(lo[ks]):"v"(vb),"i"(d0*4096+ks*1024):"memory");
      asm volatile("ds_read_b64_tr_b16 %0,%1 offset:%c2":"=&v"(hi[ks]):"v"(vb),"i"(d0*4096+ks*1024+512):"memory");}
    asm volatile("s_waitcnt lgkmcnt(0)":::"memory");SBAR();
    #define PK(k) (bf16x8){lo[k][0],lo[k][1],lo[k][2],lo[k][3],hi[k][0],hi[k][1],hi[k][2],hi[k][3]}
    o[d0]=__builtin_amdgcn_mfma_f32_32x32x16_bf16(pa0,PK(0),o[d0],0,0,0);
    o[d0]=__builtin_amdgcn_mfma_f32_32x32x16_bf16(pa1,PK(1),o[d0],0,0,0);
    o[d0]=__builtin_amdgcn_mfma_f32_32x32x16_bf16(pa2,PK(2),o[d0],0,0,0);
    o[d0]=__builtin_amdgcn_mfma_f32_32x32x16_bf16(pa3,PK(3),o[d0],0,0,0);
    #undef PK
  }
}

#ifndef ATTN_STORE16
#define ATTN_STORE16(p,v) (*(u32x4*)(p)=(v))
#endif
template<int CTRL> __device__ __forceinline__ float dpp_f(float v){ return __int_as_float(__builtin_amdgcn_update_dpp(0,__float_as_int(v),CTRL,0xf,0xf,true)); }
__device__ __forceinline__ void split3(float x,unsigned&h,unsigned&m,unsigned&l){
  h=cvtpk_s(x,0.f)&0xffffu; const float r1=x-__uint_as_float(h<<16); m=cvtpk_s(r1,0.f)&0xffffu; const float r2=r1-__uint_as_float(m<<16); l=cvtpk_s(r2,0.f)&0xffffu; }
__device__ __forceinline__ bf16x8 mkqp(float s,int hi){ unsigned h,m,l; split3(s,h,m,l); u32x4 w; w[0]=0x3f803f80u; w[1]=0x3f80u|(h<<16); w[2]=m|(l<<16); w[3]=0u; if(hi){w[0]=0u;w[1]=0u;w[2]=0u;} return __builtin_bit_cast(bf16x8,w); }
template<int THRL> __device__ __forceinline__ void attn_unit(int b,int h,int qb,const bf16*Q,const bf16*__restrict__ K,const bf16*__restrict__ V,bf16*O,const float*__restrict__ gain,char*shm,int t0,bf16x8(&qr)[4],const bool primed,int&qbn,const int t0n_,unsigned*claim){
  int t0n=t0n_; const bool dyn=claim!=nullptr;
  int tid_=threadIdx.x; asm volatile("":"+v"(tid_));
  const int tid=tid_,lane=tid&63,r32=lane&31,hi=lane>>5; const int wid=__builtin_amdgcn_readfirstlane(tid>>6);
  int claimv=0; if(dyn&&tid==0)claimv=(int)__hip_atomic_fetch_add(claim,1u,__ATOMIC_RELAXED,__HIP_MEMORY_SCOPE_AGENT);
  const long rowbase=(long)b*SEQ; const int q0=qb*QB;
  const bf16*Qw=Q+(rowbase+q0+wid*QBLK)*DM+h*D;
  const bf16*Kh=K+(rowbase+(long)t0*KVBLK)*DM+h*D,*Vh=V+(rowbase+(long)t0*KVBLK)*DM+h*D;
  const unsigned lds0=(unsigned)(uintptr_t)shm;
  float*wsf=(float*)(shm+LDS_WS)+wid*64;
  const unsigned koff=(unsigned)(lane*DM+wid*8)*2u;
  const unsigned voff=(unsigned)((16*(wid&3)+(lane>>2))*DM+(wid>>2)*32+(lane&3)*8)*2u;
  const unsigned kdst=lds0+LDS_K+wid*1024, vdst=lds0+LDS_V+wid*1024;
  #define DMA_KP(base,t,slot) glds16s((base)+(long)(t)*KVBLK*DM,koff,(unsigned)__builtin_amdgcn_readfirstlane(kdst+(slot)))
  #define DMA_VP(base,t,slot) glds16s((base)+(long)(t)*KVBLK*DM,voff,(unsigned)__builtin_amdgcn_readfirstlane(vdst+(slot)))
  #define DMA_K(t,slot) DMA_KP(Kh,t,slot)
  #define DMA_V(t,slot) DMA_VP(Vh,t,slot)
  #define PRIME(KB,VB,QW,QR) do{ DMA_KP(KB,0,0);DMA_VP(VB,0,0);DMA_KP(KB,1,SLOTB); \
    _Pragma("unroll") for(int d0=0;d0<4;++d0)QR[d0]=*reinterpret_cast<const bf16x8*>(&(QW)[(long)r32*DM+d0*16+hi*8]); DMA_KP(KB,2,2*SLOTB); }while(0)
  const int vb0=(int)(lds0+LDS_V)+((lane>>4)&1)*32+(lane&3)*8+(4*hi+((lane&15)>>2))*64;
  const char*Kbase=shm+LDS_K; bf16x8 kf[8];
  const lds_cptr shm3=(lds_cptr)shm; const lds_cptr kp0=shm3+LDS_K+hi*1024+r32*16; const lds_cptr vp0=shm3+LDS_V+((lane>>4)&1)*32+(lane&3)*8+(4*hi+((lane&15)>>2))*64;
  const int NT=(q0+QB)/KVBLK-t0;
  if(!primed){ PRIME(Kh,Vh,Qw,qr); }
  const int qrel=wid*QBLK+r32;
  const lds_cptr kb3=(lds_cptr)shm+LDS_KB+t0*1024+r32*16;
  float cq; { const u32x4 e=*(const __attribute__((address_space(3))) u32x4*)((lds_cptr)shm+LDS_KB+(q0+qrel)*16); cq=-((__uint_as_float(e[0]<<16)+__uint_as_float(e[0]&0xffff0000u))+__uint_as_float(e[1]<<16)); }
  float mhat=0.f,l_reg=0.f;f32x16 o[2];o[0]=f32x16{};o[1]=f32x16{}; const f32x16 negm=f32x16{};
  bf16x8 qp=mkqp(cq,hi);
  #define CMASK(P0,P1,t) do{int jb_=(t)-(NT-4); if(jb_>=0)cmask(P0,P1,jb_,qrel,hi);}while(0)
  bool resc=false;
  #define START(P0,P1) do{ const float rm=rowmax(P0,P1); resc=false; \
    { const float dl=__builtin_fmaxf(rm,0.f); mhat=fadd_s(mhat,dl); \
      _Pragma("unroll") for(int r=0;r<16;++r){P0[r]=fsub_s(P0[r],dl);P1[r]=fsub_s(P1[r],dl);} \
      qp=mkqp(cq-mhat,hi); } \
    _Pragma("unroll") for(int r=0;r<16;++r)P0[r]=__builtin_amdgcn_exp2f(P0[r]); }while(0)
  #define RESC() do{ if(resc){ asm volatile("s_waitcnt lgkmcnt(0)":::"memory"); \
      _Pragma("unroll") for(int d_=0;d_<2;++d_) _Pragma("unroll") for(int r=0;r<16;++r)o[d_][r]*=wsf[crow(r,hi)]; } }while(0)
  f32x16 pA0,pA1,pB0,pB1;
  int sl_prev=0,sl_cur=0,sl_next=SLOTB;
  #define ROT() do{sl_prev=sl_cur;sl_cur=sl_next;sl_next=(sl_next==(NSLOT-1)*SLOTB)?0:sl_next+SLOTB;}while(0)
  WAIT_BAR(3);
  if(dyn&&tid==0)((int*)(shm+LDS_TIL))[104]=claimv;
  qkt(pA0,pA1,Kbase,qr,negm,r32,hi);
  { const bf16x8 kb0_=*(const __attribute__((address_space(3))) bf16x8*)(kb3), kb1_=*(const __attribute__((address_space(3))) bf16x8*)(kb3+512);
    pA0=__builtin_amdgcn_mfma_f32_32x32x16_bf16(kb0_,qp,pA0,0,0,0); pA1=__builtin_amdgcn_mfma_f32_32x32x16_bf16(kb1_,qp,pA1,0,0,0); }
  asm volatile("s_nop 15\n\ts_nop 7":"+v"(pA0),"+v"(pA1));CMASK(pA0,pA1,0);
  START(pA0,pA1);
  _Pragma("unroll") for(int r=0;r<16;++r)pA1[r]=__builtin_amdgcn_exp2f(pA1[r]);
  WAIT_BAR(0);
  DMA_K(3,0);DMA_V(1,SLOTB);
  ROT();
  kload8(kf,kp0+sl_cur);
  WAIT_BAR(2);
  s16x4 vlo[8],vhi[8]; u32x4 pw0,pw1,pw2,pw3;
  #define PKW(P,B) cvtpk_s(P[B],P[B+1])
  #define PAF(k) __builtin_bit_cast(bf16x8,pw##k)
  #define VFR(i) (bf16x8){vlo[i][0],vlo[i][1],vlo[i][2],vlo[i][3],vhi[i][0],vhi[i][1],vhi[i][2],vhi[i][3]}
  #define PIN(x) asm volatile("":"+v"(x))
  #define MX3(a,b,c) __builtin_fmaxf(__builtin_fmaxf((a),(b)),(c))
  #define GAPA(MF,A0,A1,A2,A3,W0,W1,PW) do{ MF; sacc+=A0; sacc+=A1; sacc+=A2; sacc+=A3; PIN(sacc); W0; W1; PIN(PW); SBAR(); }while(0)
  #define EX(v) __builtin_amdgcn_exp2f(v)
  #define GAPB(MF,X,B) do{ MF; X[B]=EX(X[B]); X[B+1]=EX(X[B+1]); X[B+2]=EX(X[B+2]); X[B+3]=EX(X[B+3]); PIN(X); SBAR(); }while(0)
  #define VRD(i) do{ vlo[i]=vtr(vp_+(((i)>>2)*4096+((i)&3)*1024)); vhi[i]=vtr(vp_+(((i)>>2)*4096+((i)&3)*1024+512)); }while(0)
  #define KRD(G,j) do{ if(G){ kload2(kf,kp0+sl_next,j); SBAR(); } }while(0)
  #define STEP(C0,C1,P0,P1,t,GK,GV,GL) do{ SBAR(); \
    const lds_cptr vp_=vp0+sl_prev; \
    const bf16x8 kb0_=*(const __attribute__((address_space(3))) bf16x8*)(kb3+(t)*1024), kb1_=*(const __attribute__((address_space(3))) bf16x8*)(kb3+(t)*1024+512); \
    VRD(0); SBAR(); float sacc=(P0[0]+P0[1]); \
    GAPA(C0=__builtin_amdgcn_mfma_f32_32x32x16_bf16(kf[0],qr[0],negm,0,0,0), P0[2],P0[3],P0[4],P0[5],     pw0[0]=PKW(P0,0), pw0[1]=PKW(P0,2), pw0); \
    VRD(4); SBAR(); GAPA(C1=__builtin_amdgcn_mfma_f32_32x32x16_bf16(kf[1],qr[0],negm,0,0,0), P0[6],P0[7],P0[8],P0[9],     pw0[2]=PKW(P0,4), pw0[3]=PKW(P0,6), pw0); \
    VRD(1); SBAR(); GAPA(C0=__builtin_amdgcn_mfma_f32_32x32x16_bf16(kf[2],qr[1],C0,0,0,0),   P0[10],P0[11],P0[12],P0[13], pw1[0]=PKW(P0,8), pw1[1]=PKW(P0,10), pw1); \
    VRD(5); SBAR(); GAPA(C1=__builtin_amdgcn_mfma_f32_32x32x16_bf16(kf[3],qr[1],C1,0,0,0),   P0[14],P0[15],P1[0],P1[1],   pw1[2]=PKW(P0,12),pw1[3]=PKW(P0,14), pw1); \
    VRD(2); SBAR(); GAPA(C0=__builtin_amdgcn_mfma_f32_32x32x16_bf16(kf[4],qr[2],C0,0,0,0),   P1[2],P1[3],P1[4],P1[5],     pw2[0]=PKW(P1,0), pw2[1]=PKW(P1,2), pw2); \
    VRD(6); SBAR(); GAPA(C1=__builtin_amdgcn_mfma_f32_32x32x16_bf16(kf[5],qr[2],C1,0,0,0),   P1[6],P1[7],P1[8],P1[9],     pw2[2]=PKW(P1,4), pw2[3]=PKW(P1,6), pw2); \
    VRD(3); SBAR(); GAPA(C0=__builtin_amdgcn_mfma_f32_32x32x16_bf16(kf[6],qr[3],C0,0,0,0),   P1[10],P1[11],P1[12],P1[13], pw3[0]=PKW(P1,8), pw3[1]=PKW(P1,10), pw3); \
    VRD(7); SBAR(); GAPA(C1=__builtin_amdgcn_mfma_f32_32x32x16_bf16(kf[7],qr[3],C1,0,0,0),   P1[14],P1[15],0.f,0.f,       pw3[2]=PKW(P1,12),pw3[3]=PKW(P1,14), pw3); \
    C0=__builtin_amdgcn_mfma_f32_32x32x16_bf16(kb0_,qp,C0,0,0,0); C1=__builtin_amdgcn_mfma_f32_32x32x16_bf16(kb1_,qp,C1,0,0,0); \
    l_reg+=sacc; \
    if(GK){DMA_K((t)+3,sl_cur);} if(GV){DMA_V((t)+1,sl_next);} \
    CMASK(C0,C1,t); \
    { float a=MX3(C0[0],C0[1],C1[0]),b=MX3(C0[2],C0[3],C1[1]); a=MX3(a,C1[2],C1[3]); \
      _Pragma("unroll") for(int r=4;r<16;r+=4){a=MX3(a,C0[r],C0[r+1]);b=MX3(b,C0[r+2],C0[r+3]);a=MX3(a,C1[r],C1[r+1]);b=MX3(b,C1[r+2],C1[r+3]);} \
      float rm=__builtin_fmaxf(a,b); { auto rr=__builtin_amdgcn_permlane32_swap(__float_as_uint(rm),__float_as_uint(rm),false,false); rm=__builtin_fmaxf(__uint_as_float(rr[0]),__uint_as_float(rr[1])); } \
      resc=false; \
      if(__builtin_expect(__any(rm>(float)THRL),0)){ const float dl=__builtin_fmaxf(rm,0.f); mhat+=dl; \
        _Pragma("unroll") for(int r=0;r<16;++r){C0[r]-=dl;C1[r]-=dl;} \
        qp=mkqp(cq-mhat,hi); \
        const float f=__builtin_amdgcn_exp2f(-dl); l_reg*=f; if(hi==0)wsf[r32]=f; resc=true; } } \
    SBAR(); \
    GAPB(o[0]=__builtin_amdgcn_mfma_f32_32x32x16_bf16(PAF(0),VFR(0),o[0],0,0,0), C0,0); \
    GAPB(o[1]=__builtin_amdgcn_mfma_f32_32x32x16_bf16(PAF(0),VFR(4),o[1],0,0,0), C0,4); \
    KRD(GL,0); GAPB(o[0]=__builtin_amdgcn_mfma_f32_32x32x16_bf16(PAF(1),VFR(1),o[0],0,0,0), C0,8); \
    KRD(GL,1); GAPB(o[1]=__builtin_amdgcn_mfma_f32_32x32x16_bf16(PAF(1),VFR(5),o[1],0,0,0), C0,12); \
    KRD(GL,2); GAPB(o[0]=__builtin_amdgcn_mfma_f32_32x32x16_bf16(PAF(2),VFR(2),o[0],0,0,0), C1,0); \
    KRD(GL,3); GAPB(o[1]=__builtin_amdgcn_mfma_f32_32x32x16_bf16(PAF(2),VFR(6),o[1],0,0,0), C1,4); \
    GAPB(o[0]=__builtin_amdgcn_mfma_f32_32x32x16_bf16(PAF(3),VFR(3),o[0],0,0,0), C1,8); \
    GAPB(o[1]=__builtin_amdgcn_mfma_f32_32x32x16_bf16(PAF(3),VFR(7),o[1],0,0,0), C1,12); \
    }while(0)
  int t=1;
  #undef CMASK
  #define CMASK(P0,P1,t) do{}while(0)
  for(;t+5<NT;t+=2){
    STEP(pB0,pB1,pA0,pA1,t,true,true,true);     WAIT_BAR(2); RESC(); ROT();
    STEP(pA0,pA1,pB0,pB1,t+1,true,true,true);   WAIT_BAR(2); RESC(); ROT();
  }
  #undef CMASK
  #define CMASK(P0,P1,t) do{int jb_=(t)-(NT-4); if(jb_>=0)cmask(P0,P1,jb_,qrel,hi);}while(0)
  #define ENDW(tt) do{ if((tt)+3<NT){WAIT_BAR(2);} else if((tt)+2<NT){WAIT_BAR(1);} else {WAIT_BAR(0);} }while(0)
  for(;t+1<NT;t+=2){
    STEP(pB0,pB1,pA0,pA1,t,(t+3<NT),(t+1<NT),(t+1<NT));       ENDW(t);   RESC(); ROT();
    STEP(pA0,pA1,pB0,pB1,t+1,(t+4<NT),(t+2<NT),(t+2<NT));     ENDW(t+1); RESC(); ROT();
  }
  STEP(pB0,pB1,pA0,pA1,NT-1,false,false,false); RESC();
  { float sacc=pB0[0]+pB0[1]; _Pragma("unroll") for(int r=2;r<16;++r)sacc+=pB0[r]; _Pragma("unroll") for(int r=0;r<16;++r)sacc+=pB1[r]; l_reg+=sacc;
    pw0=(u32x4){PKW(pB0,0),PKW(pB0,2),PKW(pB0,4),PKW(pB0,6)};pw1=(u32x4){PKW(pB0,8),PKW(pB0,10),PKW(pB0,12),PKW(pB0,14)};pw2=(u32x4){PKW(pB1,0),PKW(pB1,2),PKW(pB1,4),PKW(pB1,6)};pw3=(u32x4){PKW(pB1,8),PKW(pB1,10),PKW(pB1,12),PKW(pB1,14)};
    SBAR(); pv(o,vb0+sl_cur,PAF(0),PAF(1),PAF(2),PAF(3)); }
  asm volatile("s_waitcnt lgkmcnt(0)\n\ts_barrier":::"memory");
  if(dyn){ const int n_=__builtin_amdgcn_readfirstlane(((const int*)(shm+LDS_TIL))[104]); qbn=(n_<NQB)?NQB-1-n_:-1; t0n=__builtin_amdgcn_readfirstlane(((const int*)(shm+LDS_TIL))[96+(qbn<0?0:qbn)]); }
  bf16x8 qn[4];
  if(qbn>=0){ const bf16*Khn=K+(rowbase+(long)t0n*KVBLK)*DM+h*D,*Vhn=V+(rowbase+(long)t0n*KVBLK)*DM+h*D; const bf16*Qwn=Q+(rowbase+qbn*QB+wid*QBLK)*DM+h*D; PRIME(Khn,Vhn,Qwn,qn); }
  #undef PKW
  #undef PAF
  #undef VFR
  #undef PIN
  #undef MX3
  #undef GAPA
  #undef GAPB
  #undef EX
  #undef VRD
  #undef KRD
  #undef STEP
  #undef ENDW
  {auto rr=__builtin_amdgcn_permlane32_swap(__float_as_uint(l_reg),__float_as_uint(l_reg),false,false);l_reg=__uint_as_float(rr[0])+__uint_as_float(rr[1]);}
  if(hi==0)wsf[32+r32]=l_reg;asm volatile("s_waitcnt lgkmcnt(0)":::"memory");
  float rli[16];
  #pragma unroll
  for(int r=0;r<16;++r)rli[r]=__builtin_amdgcn_rcpf(wsf[32+crow(r,hi)]);
  bf16*Ow=O+(rowbase+q0+wid*QBLK)*DMO+h*D;
  { bf16*stg=(bf16*)(shm+LDS_OST)+wid*2048;
    #pragma unroll
    for(int r=0;r<16;++r){const int orow=crow(r,hi);
      #pragma unroll
      for(int d0=0;d0<2;++d0)stg[orow*64+d0*32+r32]=__float2bfloat16(o[d0][r]*rli[r]);}
    asm volatile("s_waitcnt lgkmcnt(0)":::"memory");
    const int ch=lane&7; const f32x4_t g0=*(const f32x4_t*)(gain+ch*8), g1=*(const f32x4_t*)(gain+ch*8+4);
    #pragma unroll
    for(int i=0;i<4;++i){const int row=i*8+(lane>>3); const u32x4 v=*(const u32x4*)(stg+row*64+ch*8);
      float f[8];
      #pragma unroll
      for(int e=0;e<4;++e){ f[2*e]=__uint_as_float(v[e]<<16); f[2*e+1]=__uint_as_float(v[e]&0xffff0000u); }
      float ss=(f[0]*f[0]+f[1]*f[1])+(f[2]*f[2]+f[3]*f[3])+(f[4]*f[4]+f[5]*f[5])+(f[6]*f[6]+f[7]*f[7]);
      ss+=dpp_f<0xB1>(ss); ss+=dpp_f<0x4E>(ss); ss+=dpp_f<0x141>(ss);
      const float rs=__builtin_amdgcn_rsqf(ss*(1.f/64.f)+1e-6f);
      u32x4 w; w[0]=cvtpk_s(f[0]*rs*g0[0],f[1]*rs*g0[1]); w[1]=cvtpk_s(f[2]*rs*g0[2],f[3]*rs*g0[3]); w[2]=cvtpk_s(f[4]*rs*g1[0],f[5]*rs*g1[1]); w[3]=cvtpk_s(f[6]*rs*g1[2],f[7]*rs*g1[3]);
      ATTN_STORE16(Ow+(long)row*DMO+ch*8,w);} }
  if(qbn>=0){
    #pragma unroll
    for(int d0=0;d0<4;++d0)qr[d0]=qn[d0]; }
  #undef DMA_K
  #undef DMA_V
  #undef DMA_KP
  #undef DMA_VP
  #undef PRIME
  #undef CMASK
  #undef START
  #undef RESC
  #undef ROT
}
constexpr int ATTN_LDS_BYTES=LDS_BYTES;
template<int THRL=8> __device__ __forceinline__ void attn_bh(char*lds,const bf16*U,bf16*MIX,const float*__restrict__ FLG,const float*__restrict__ gain,int bh,int qlo,int qhi,unsigned*claim,const unsigned*ktab,const unsigned*qtab){
  const int tid=threadIdx.x,lane=tid&63,wid=tid>>6;
  { const int b=bh/NHEAD,h=bh%NHEAD;
    { float a[4];
      #pragma unroll
      for(int i=0;i<4;++i)a[i]=FLG[((size_t)b*SEQ+4*tid+i)*8+h];
      a[1]+=a[0];a[2]+=a[1];a[3]+=a[2];
      float sc=a[3];
      int lo_=lane; asm volatile("":"+v"(lo_));
      #pragma unroll
      for(int o=1;o<64;o<<=1){const float n=__int_as_float(__builtin_amdgcn_ds_bpermute(((lo_-o)&63)<<2,__float_as_int(sc))); if(lo_>=o)sc+=n;}
      float*ws=(float*)(lds+LDS_SCAN);
      if(lane==63)ws[wid]=sc;
      __syncthreads();
      float base=0.f;
      #pragma unroll
      for(int w=0;w<NW;++w)base+=(w<wid)?ws[w]:0.f;
      const float ex=base+sc-a[3];
      #pragma unroll
      for(int i=0;i<4;++i){ unsigned hh,mm,ll; split3(-(ex+a[i])*1.4426950408889634f,hh,mm,ll); u32x4 e; e[0]=hh|(mm<<16); e[1]=ll|0x3f800000u; e[2]=0x3f803f80u; e[3]=0u; *(u32x4*)(lds+LDS_KB+16*(4*tid+i))=e; }
      __syncthreads(); }
    { float* til=(float*)(lds+LDS_TIL); unsigned* tilu=(unsigned*)(lds+LDS_TIL);
      if(tid<128)tilu[tid]=0u;
      __syncthreads();
      if(tid<32)til[tid]=__uint_as_float(ktab[(bh*2+0)*32+tid])+__uint_as_float(ktab[(bh*2+1)*32+tid]);
      else if(tid>=64&&tid<72)til[tid]=__uint_as_float(qtab[(bh*2+0)*8+(tid-64)])+__uint_as_float(qtab[(bh*2+1)*8+(tid-64)]);
      if(tid<32){ const u32x4 e=*(const u32x4*)(lds+LDS_KB+16*(64*tid+63)); til[32+tid]=-((__uint_as_float(e[0]<<16)+__uint_as_float(e[0]&0xffff0000u))+__uint_as_float(e[1]<<16)); }
      else if(tid<40){ const int bq=tid-32; const u32x4 e=*(const u32x4*)(lds+LDS_KB+16*(256*bq)); til[72+bq]=-((__uint_as_float(e[0]<<16)+__uint_as_float(e[0]&0xffff0000u))+__uint_as_float(e[1]<<16)); }
      __syncthreads(); }
    if(tid<NQB){ const float* til=(const float*)(lds+LDS_TIL); const int qb=tid; const float qn2=til[64+qb]*1.0001f, cq0=til[72+qb]; int t0=4*qb;
      for(int j=0;j<4*qb;++j){ const float bound=sqrtf(qn2*til[j])*1.0001f+cq0-til[32+j]; if(!(bound<-150.f)){ t0=j; break; } }
      ((int*)(lds+LDS_TIL))[96+qb]=t0&~1; }
    __syncthreads();
    { bf16x8 qr[4]; bool primed=false; const bool dyn=claim!=nullptr; const int* t0t=(const int*)(lds+LDS_TIL)+96;
      int qb=qhi-1;
      if(dyn){ if(tid==0)((int*)(lds+LDS_TIL))[105]=(int)__hip_atomic_fetch_add(claim,1u,__ATOMIC_RELAXED,__HIP_MEMORY_SCOPE_AGENT); __syncthreads(); const int n_=__builtin_amdgcn_readfirstlane(((const int*)(lds+LDS_TIL))[105]); qb=(n_<NQB)?NQB-1-n_:-1; }
      while(qb>=qlo){ const int t0=__builtin_amdgcn_readfirstlane(t0t[qb]);
        int qbn=(!dyn&&qb>qlo)?qb-1:-1; const int t0n=__builtin_amdgcn_readfirstlane(t0t[qbn<0?0:qbn]);
        attn_unit<THRL>(b,h,qb,U+2048,U+2560,U+3072,MIX+512,gain,lds,t0,qr,primed,qbn,t0n,claim); primed=(qbn>=0); qb=qbn; } }
    __syncthreads();
  }
}
template<int THRL=8,class Pre> __device__ __forceinline__ void attn_phase(char*lds,const bf16*U,bf16*MIX,const float*__restrict__ FLG,const float*__restrict__ gain,int vcu,int G,unsigned*claims,const unsigned*ktab,const unsigned*qtab,const Pre&pre){
  for(int it=0;;++it){ int bh,qlo=0,qhi=NQB; unsigned*claim=nullptr;
    if(G==256){ if(vcu<128){ if(it>0)break; bh=vcu; claim=claims+vcu; } else { if(it>1)break; bh=it?vcu-128:vcu; if(it)claim=claims+(vcu-128); } }
    else { bh=vcu+it*G; if(bh>=BATCH*NHEAD)break; }
    pre(it);
    attn_bh<THRL>(lds,U,MIX,FLG,gain,bh,qlo,qhi,claim,ktab,qtab); }
  pre(-1);
}
#undef SBAR
#undef WAIT_BAR
}
namespace hgrn_body {
typedef unsigned short bf16;
typedef short bf16x8 __attribute__((ext_vector_type(8)));
typedef short s16x4 __attribute__((ext_vector_type(4)));
typedef float f32x4 __attribute__((ext_vector_type(4)));
typedef float f32x2 __attribute__((ext_vector_type(2)));
typedef unsigned u32x4 __attribute__((ext_vector_type(4)));
typedef unsigned u32x2 __attribute__((ext_vector_type(2)));
#define HL __attribute__((address_space(3)))
constexpr int SEQ = 2048, NCH = SEQ / 64, UP = 3584, MP = 1024, NUNITS = 32 * 4;
constexpr int QS = 272, PS = 144, OS = 132;
constexpr int QSET = 64 * QS;
constexpr int L_Q = 0, L_K = L_Q + 2 * QSET, L_P = L_K + 2 * QSET, L_V = L_P + 64 * PS, L_O = L_V + 2 * 16384, L_SEG = L_O + 64 * OS * 4, L_ER = L_SEG + 8 * 128 * 4, L_END = L_ER + 2 * 1024;
static_assert(L_END <= 155648, "HGRN LDS map");
__device__ __forceinline__ unsigned pk(float lo, float hi) { typedef __bf16 b2 __attribute__((ext_vector_type(2))); const f32x2 v = {lo, hi}; const b2 b = __builtin_convertvector(v, b2); return __builtin_bit_cast(unsigned, b); }
__device__ __forceinline__ float blo(unsigned w) { return __builtin_bit_cast(float, w << 16); }
__device__ __forceinline__ float bhi(unsigned w) { return __builtin_bit_cast(float, w & 0xffff0000u); }
__device__ __forceinline__ float ex2(float x) { return __builtin_amdgcn_exp2f(x); }
template <int CTRL> __device__ __forceinline__ float dppf(float v) { return __builtin_bit_cast(float, __builtin_amdgcn_update_dpp(0, __builtin_bit_cast(int, v), CTRL, 0xf, 0xf, true)); }
__device__ __forceinline__ s16x4 trd(HL char* p) { return __builtin_bit_cast(s16x4, __builtin_amdgcn_ds_read_tr16_b64_v4i16((HL s16x4*)p)); }
#define HBAR() do { asm volatile("s_waitcnt lgkmcnt(0)" ::: "memory"); __builtin_amdgcn_s_barrier(); asm volatile("" ::: "memory"); } while (0)
#define HMF(a, b, c) __builtin_amdgcn_mfma_f32_16x16x32_bf16((a), (b), (c), 0, 0, 0)

template <int VAR  >
__device__ __forceinline__ void hgrn_unit(char* lds_, const bf16* __restrict__ U, bf16* MIX, const float* __restrict__ gain, int b, int h) {
    HL char* lds = (HL char*)lds_;
    int tid_ = threadIdx.x; asm volatile("" : "+v"(tid_));
    const int tid = tid_, lane = tid & 63, w = __builtin_amdgcn_readfirstlane(tid >> 6), fr = lane & 15, g = lane >> 4;
    const size_t row0 = (size_t)b * SEQ;
    const bf16* Uq = U + row0 * UP + h * 128;
    const int ot = tid >> 3, oj = tid & 7;
    f32x4 gn[4];
#pragma unroll
    for (int i = 0; i < 4; ++i) gn[i] = *(const f32x4*)(gain + 16 * oj + 4 * i);
    unsigned rq[8], rl[8]; u32x4 sgc0, sgc1;
    float cx[8], cy[8];
    f32x4 S[8];
#pragma unroll
    for (int i = 0; i < 8; ++i) S[i] = (f32x4){0.f, 0.f, 0.f, 0.f};
#define H_LOAD_RAW(c) do { _Pragma("unroll") for (int i_ = 0; i_ < 8; ++i_) { const bf16* p_ = Uq + (size_t)((c) * 64 + 8 * w + i_) * UP + 2 * lane; rq[i_] = *(const unsigned*)p_; rl[i_] = *(const unsigned*)(p_ + 512); } } while (0)
#define H_DMA_V(c, slot) do { _Pragma("unroll") for (int i_ = 0; i_ < 2; ++i_) \
        __builtin_amdgcn_global_load_lds((const unsigned*)(Uq + 1024 + (size_t)((c) * 64 + 8 * w + 4 * i_ + (lane >> 4)) * UP + (lane & 15) * 8), (HL unsigned*)(lds + L_V + (slot) * 16384 + (8 * w + 4 * i_) * 256), 16, 0, 0); } while (0)
#define H_LOAD_SG(c, d0, d1) do { const bf16* p_ = Uq + 1536 + (size_t)((c) * 64 + ot) * UP + 16 * oj; d0 = *(const u32x4*)p_; d1 = *(const u32x4*)(p_ + 8); } while (0)
#define H_PREP1() do { float ax_ = 0.f, ay_ = 0.f; \
        _Pragma("unroll") for (int i = 0; i < 8; ++i) { ax_ += blo(rl[i]); ay_ += bhi(rl[i]); cx[i] = ax_; cy[i] = ay_; } \
        *(HL f32x2*)(lds + L_SEG + (w * 128 + 2 * lane) * 4) = (f32x2){ax_, ay_}; } while (0)
#define H_PREP2(set) do { float px = 0.f, py = 0.f, rx = 0.f, ry = 0.f, tx = 0.f, ty = 0.f; \
        _Pragma("unroll") for (int ww = 0; ww < 8; ++ww) { const f32x2 s = *(HL f32x2*)(lds + L_SEG + (ww * 128 + 2 * lane) * 4); \
            px += (ww < w) ? s.x : 0.f; py += (ww < w) ? s.y : 0.f; if (ww < 4) { rx += s.x; ry += s.y; } tx += s.x; ty += s.y; } \
        _Pragma("unroll") for (int i = 0; i < 8; ++i) { const float bx = px + cx[i], by = py + cy[i]; \
            const float qx = blo(rq[i]) * ex2(bx - rx), qy = bhi(rq[i]) * ex2(by - ry); \
            const float kx = (1.f - ex2(blo(rl[i]))) * ex2(rx - bx), ky = (1.f - ex2(bhi(rl[i]))) * ex2(ry - by); \
            const int t = 8 * w + i; \
            *(HL unsigned*)(lds + L_Q + (set) * QSET + t * QS + 4 * lane) = pk(qx, qy); \
            *(HL unsigned*)(lds + L_K + (set) * QSET + t * QS + 4 * lane) = pk(kx, ky); } \
        if (w == 0) { *(HL f32x2*)(lds + L_ER + (set) * 1024 + (2 * lane) * 4) = (f32x2){ex2(rx), ex2(ry)}; *(HL f32x2*)(lds + L_ER + (set) * 1024 + 512 + (2 * lane) * 4) = (f32x2){ex2(tx - rx), ex2(ty - ry)}; } } while (0)
#define H_OUTPUT(cc) do { f32x4 o[4]; float ss = 0.f; \
        _Pragma("unroll") for (int i = 0; i < 4; ++i) { o[i] = *(HL f32x4*)(lds + L_O + (ot * OS + 16 * oj + 4 * i) * 4); ss += (o[i][0] * o[i][0] + o[i][1] * o[i][1]) + (o[i][2] * o[i][2] + o[i][3] * o[i][3]); } \
        ss += dppf<0xB1>(ss); ss += dppf<0x4E>(ss); ss += dppf<0x141>(ss); \
        const float rs = __builtin_amdgcn_rsqf(ss * (1.f / 128.f) + 1e-6f); \
        const unsigned sgw[8] = {sgc0[0], sgc0[1], sgc0[2], sgc0[3], sgc1[0], sgc1[1], sgc1[2], sgc1[3]}; \
        u32x4 y0, y1; \
        _Pragma("unroll") for (int i = 0; i < 4; ++i) { const float a0 = o[i][0] * rs * gn[i][0] * blo(sgw[2 * i]), a1 = o[i][1] * rs * gn[i][1] * bhi(sgw[2 * i]); \
            const float a2 = o[i][2] * rs * gn[i][2] * blo(sgw[2 * i + 1]), a3 = o[i][3] * rs * gn[i][3] * bhi(sgw[2 * i + 1]); \
            if (i < 2) { y0[2 * i] = pk(a0, a1); y0[2 * i + 1] = pk(a2, a3); } else { y1[2 * (i - 2)] = pk(a0, a1); y1[2 * (i - 2) + 1] = pk(a2, a3); } } \
        bf16* op = MIX + (row0 + (size_t)(cc) * 64 + ot) * MP + h * 128 + 16 * oj; \
        *(u32x4*)op = y0; *(u32x4*)(op + 8) = y1; } while (0)
    H_LOAD_RAW(0); H_DMA_V(0, 0); sgc0 = (u32x4){0u, 0u, 0u, 0u}; sgc1 = sgc0;
    H_PREP1(); HBAR(); H_PREP2(0); H_LOAD_RAW(1); HBAR();
    for (int c = 0; c < NCH; ++c) {
        const int set = c & 1;
        asm volatile("s_waitcnt vmcnt(0)" ::: "memory");
        if (VAR != 1 && c + 1 < NCH) H_DMA_V(c + 1, (c + 1) & 1);
        if (c > 0) H_OUTPUT(c - 1);
        if (VAR != 1) H_LOAD_SG(c, sgc0, sgc1);
        if (VAR != 2 && c + 1 < NCH) H_PREP1();
#pragma unroll
        for (int q = 0; q < 2; ++q) { const int ti = 2 * w + q, tt = ti >> 2, st = ti & 3;
            f32x4 acc = {0.f, 0.f, 0.f, 0.f};
            if (st <= tt) {
                bf16x8 pa[4], pb[4];
#pragma unroll
                for (int ks = 0; ks < 4; ++ks) { pa[ks] = *(HL bf16x8*)(lds + L_K + set * QSET + (16 * st + fr) * QS + (32 * ks + 8 * g) * 2); pb[ks] = *(HL bf16x8*)(lds + L_Q + set * QSET + (16 * tt + fr) * QS + (32 * ks + 8 * g) * 2); }
#pragma unroll
                for (int ks = 0; ks < 4; ++ks) if (VAR != 3) acc = HMF(pa[ks], pb[ks], acc);
                const int dlt = 16 * (tt - st) + fr - 4 * g;
#pragma unroll
                for (int r = 0; r < 4; ++r) acc[r] = (r > dlt) ? 0.f : acc[r];
                asm volatile("" : "+v"(acc));
            }
            *(HL u32x2*)(lds + L_P + (16 * tt + fr) * PS + (16 * st + 4 * g) * 2) = (u32x2){pk(acc[0], acc[1]), pk(acc[2], acc[3])}; }
        f32x4 O[4];
#pragma unroll
        for (int i = 0; i < 4; ++i) O[i] = (f32x4){0.f, 0.f, 0.f, 0.f};
#pragma unroll
        for (int kt = 0; kt < 8; ++kt) S[kt] = S[kt] * *(HL f32x4*)(lds + L_ER + set * 1024 + (16 * kt + 4 * g) * 4);
        bf16x8 sf[4];
#pragma unroll
        for (int ks = 0; ks < 4; ++ks) { u32x4 p; p[0] = pk(S[2 * ks][0], S[2 * ks][1]); p[1] = pk(S[2 * ks][2], S[2 * ks][3]); p[2] = pk(S[2 * ks + 1][0], S[2 * ks + 1][1]); p[3] = pk(S[2 * ks + 1][2], S[2 * ks + 1][3]); sf[ks] = __builtin_bit_cast(bf16x8, p); }
#pragma unroll
        for (int th = 0; th < 2; ++th) {
            u32x2 flo[2][4], fhi[2][4];
#pragma unroll
            for (int t2 = 0; t2 < 2; ++t2)
#pragma unroll
                for (int ks = 0; ks < 4; ++ks) { const int tt = 2 * th + t2; flo[t2][ks] = *(HL u32x2*)(lds + L_Q + set * QSET + (16 * tt + fr) * QS + (32 * ks + 4 * g) * 2); fhi[t2][ks] = *(HL u32x2*)(lds + L_Q + set * QSET + (16 * tt + fr) * QS + (32 * ks + 16 + 4 * g) * 2); }
#pragma unroll
            for (int ks = 0; ks < 4; ++ks)
#pragma unroll
                for (int t2 = 0; t2 < 2; ++t2) { const u32x4 a4 = {flo[t2][ks][0], flo[t2][ks][1], fhi[t2][ks][0], fhi[t2][ks][1]}; if (VAR != 3) O[2 * th + t2] = HMF(__builtin_bit_cast(bf16x8, a4), sf[ks], O[2 * th + t2]); } }
        HBAR();
        if (c + 1 < NCH) { if (VAR != 2) H_PREP2(set ^ 1); if (VAR != 1 && c + 2 < NCH) H_LOAD_RAW(c + 2); }
        bf16x8 vf[2];
        { HL char* vb = lds + L_V + set * 16384 + (8 * g + (fr >> 2)) * 256 + (16 * w + 4 * (fr & 3)) * 2;
#pragma unroll
          for (int st = 0; st < 2; ++st) { const s16x4 lo = trd(vb + st * 32 * 256), hi = trd(vb + st * 32 * 256 + 4 * 256); vf[st] = (bf16x8){lo[0], lo[1], lo[2], lo[3], hi[0], hi[1], hi[2], hi[3]}; } }
        { bf16x8 pf[4][2];
#pragma unroll
          for (int tt = 0; tt < 4; ++tt)
#pragma unroll
            for (int st = 0; st < 2; ++st) { if (st == 1 && tt < 2) continue; pf[tt][st] = *(HL bf16x8*)(lds + L_P + (16 * tt + fr) * PS + (32 * st + 8 * g) * 2); }
#pragma unroll
          for (int st = 0; st < 2; ++st)
#pragma unroll
            for (int tt = 0; tt < 4; ++tt) { if (st == 1 && tt < 2) continue; if (VAR != 3) O[tt] = HMF(pf[tt][st], vf[st], O[tt]); } }
        { HL char* kb = lds + L_K + set * QSET + (8 * g + (fr >> 2)) * QS + (4 * (fr & 3)) * 2;
#pragma unroll
          for (int kh = 0; kh < 2; ++kh) {
            s16x4 tlo[4][2], thi[4][2];
#pragma unroll
            for (int k4 = 0; k4 < 4; ++k4)
#pragma unroll
                for (int st = 0; st < 2; ++st) { const int kt = 4 * kh + k4; tlo[k4][st] = trd(kb + st * 32 * QS + kt * 32); thi[k4][st] = trd(kb + st * 32 * QS + 4 * QS + kt * 32); }
#pragma unroll
            for (int st = 0; st < 2; ++st)
#pragma unroll
                for (int k4 = 0; k4 < 4; ++k4) { const bf16x8 a = (bf16x8){tlo[k4][st][0], tlo[k4][st][1], tlo[k4][st][2], tlo[k4][st][3], thi[k4][st][0], thi[k4][st][1], thi[k4][st][2], thi[k4][st][3]};
                    if (VAR != 3) S[4 * kh + k4] = HMF(a, vf[st], S[4 * kh + k4]); else asm volatile("" :: "v"(a)); } } }
#pragma unroll
        for (int kt = 0; kt < 8; ++kt) S[kt] = S[kt] * *(HL f32x4*)(lds + L_ER + set * 1024 + 512 + (16 * kt + 4 * g) * 4);
#pragma unroll
        for (int tt = 0; tt < 4; ++tt)
#pragma unroll
            for (int r = 0; r < 4; ++r) *(HL float*)(lds + L_O + ((16 * tt + 4 * g + r) * OS + 16 * w + fr) * 4) = O[tt][r];
        HBAR();
    }
    H_OUTPUT(NCH - 1);
#undef H_OUTPUT
#undef H_PREP1
#undef H_PREP2
#undef H_LOAD_RAW
#undef H_DMA_V
#undef H_LOAD_SG
}
template <int VAR = 0> __device__ __forceinline__ void hgrn_phase(char* lds, const bf16* U, bf16* MIX, const float* gain, int vcu, int G) {
    for (int u = vcu; u < NUNITS; u += G) { hgrn_unit<VAR>(lds, U, MIX, gain, u >> 2, u & 3); __syncthreads(); }
    __syncthreads();
}
#undef HL
#undef HBAR
#undef HMF
}
#if MK_OPT_MASK != 0xFF || defined(MK_NAIVE_HGRN) || defined(MK_NAIVE_ATTN) || defined(MK_OVERWRITE)
namespace nb {
__device__ __forceinline__ float wsum(float v) {
#pragma unroll
    for (int o = 1; o < 64; o <<= 1) v += __shfl_xor(v, o);
    return v;
}
__device__ __forceinline__ float siluf(float x) { return x / (1.f + expf(-x)); }
__device__ __forceinline__ float sigm(float x) { return 1.f / (1.f + expf(-x)); }
__device__ __forceinline__ unsigned short tobf(float f) { return (unsigned short)f2bf(f); }
struct NG { const bf16* A; int lda; const int* a_rows; const bf16* Bt; int ldb; const int* tile_e; size_t strideB; int M, N, K, mode; const int* Mdev;
            void* C; const float* R; const float* lb; const int* c_rows; const float* roww; };
__global__ void __launch_bounds__(256) k_ngemm(NG a) {
    __shared__ float As[32][68], Bs[32][68], Bs2[32][68];
    const int M = a.Mdev ? *a.Mdev : a.M;
    const int m0 = blockIdx.y * 64, n0 = blockIdx.x * 64;
    if (m0 >= M) return;
    const bf16* Bp = a.Bt; if (a.tile_e) Bp += (size_t)a.tile_e[m0 >> 8] * a.strideB;
    const int tid = threadIdx.x, tx = tid & 15, ty = tid >> 4;
    const int lr = tid >> 2, lk = (tid & 3) * 8;
    int arow = m0 + lr; bool aval = arow < M;
    if (aval && a.a_rows) { const int g = a.a_rows[arow]; aval = g >= 0; arow = g; }
    const bf16* Ap = a.A + (size_t)(aval ? arow : 0) * a.lda;
    const int j = n0 + lr; const bool dual = a.mode == 2;
    const int brow = dual ? ((j >> 7) * 256 + (j & 127)) : j;
    const bf16* Bq = Bp + (size_t)brow * a.ldb; const bf16* Bq2 = Bq + (size_t)128 * a.ldb;
    float acc[4][4] = {}, acc2[4][4] = {};
    for (int k0 = 0; k0 < a.K; k0 += 32) {
        uint4 av = aval ? *(const uint4*)(Ap + k0 + lk) : make_uint4(0, 0, 0, 0);
        uint4 bv = *(const uint4*)(Bq + k0 + lk); uint4 bv2 = make_uint4(0, 0, 0, 0); if (dual) bv2 = *(const uint4*)(Bq2 + k0 + lk);
        __syncthreads();
        { const unsigned w[4] = {av.x, av.y, av.z, av.w}; const unsigned x[4] = {bv.x, bv.y, bv.z, bv.w}; const unsigned y[4] = {bv2.x, bv2.y, bv2.z, bv2.w};
#pragma unroll
          for (int q = 0; q < 4; ++q) { As[lk + 2 * q][lr] = bflo(w[q]); As[lk + 2 * q + 1][lr] = bfhi(w[q]); Bs[lk + 2 * q][lr] = bflo(x[q]); Bs[lk + 2 * q + 1][lr] = bfhi(x[q]);
              if (dual) { Bs2[lk + 2 * q][lr] = bflo(y[q]); Bs2[lk + 2 * q + 1][lr] = bfhi(y[q]); } } }
        __syncthreads();
#pragma unroll
        for (int kk = 0; kk < 32; ++kk) {
            const float4 a4 = *(const float4*)&As[kk][ty * 4]; const float4 b4 = *(const float4*)&Bs[kk][tx * 4];
            const float aa[4] = {a4.x, a4.y, a4.z, a4.w}, bb[4] = {b4.x, b4.y, b4.z, b4.w};
#pragma unroll
            for (int i = 0; i < 4; ++i)
#pragma unroll
                for (int jj = 0; jj < 4; ++jj) acc[i][jj] = fmaf(aa[i], bb[jj], acc[i][jj]);
            if (dual) { const float4 c4 = *(const float4*)&Bs2[kk][tx * 4]; const float cc[4] = {c4.x, c4.y, c4.z, c4.w};
#pragma unroll
                for (int i = 0; i < 4; ++i)
#pragma unroll
                    for (int jj = 0; jj < 4; ++jj) acc2[i][jj] = fmaf(aa[i], cc[jj], acc2[i][jj]); }
        }
    }
#pragma unroll
    for (int i = 0; i < 4; ++i) {
        const int r = m0 + ty * 4 + i; if (r >= M) continue;
        const int c = n0 + tx * 4;
        float o[4] = {acc[i][0], acc[i][1], acc[i][2], acc[i][3]};
        if (a.mode == 0) { const int kind = c >> 9;
#pragma unroll
            for (int q = 0; q < 4; ++q) { float v = o[q];
                if (kind == 0 || kind == 3) v = siluf(v); else if (kind == 1) { const float l = a.lb[c + q - 512]; v = log2f(l + (1.f - l) * sigm(v)); } else if (kind == 4) v *= QSCALE_;
                ((bf16*)a.C)[(size_t)r * UC_ + c + q] = tobf(v); }
        } else if (a.mode == 1) {
#pragma unroll
            for (int q = 0; q < 4; ++q) ((bf16*)a.C)[(size_t)r * DM_ + c + q] = tobf(o[q]);
        } else if (a.mode == 2) {
#pragma unroll
            for (int q = 0; q < 4; ++q) ((bf16*)a.C)[(size_t)r * 512 + c + q] = tobf(siluf(o[q]) * acc2[i][q]);
        } else { const int cr = a.c_rows[r]; if (cr < 0) continue; const float w = a.roww[r];
            bf16* dst = (bf16*)a.C + (size_t)(cr & 1) * T_ * DM_ + (size_t)(cr >> 1) * DM_ + c;
#pragma unroll
            for (int q = 0; q < 4; ++q) dst[q] = tobf(w * o[q]); }
    }
}
__global__ void k_cum(const float* __restrict__ flg, float* __restrict__ cum) {
    const int i = blockIdx.x * blockDim.x + threadIdx.x; if (i >= NB_ * 8) return;
    const int b = i / 8, h = i % 8; double acc = 0.0;
    for (int s = 0; s < SEQ_; ++s) { acc += (double)flg[(size_t)(b * SEQ_ + s) * 8 + h]; cum[(size_t)(b * SEQ_ + s) * 8 + h] = (float)acc; }
}
__global__ void __launch_bounds__(128) k_hgrn(const bf16* __restrict__ u, float* __restrict__ oraw) {
    __shared__ float qs[16][128], fs[16][128], ks[16][128];
    const int b = blockIdx.x / 4, h = blockIdx.x % 4, v = threadIdx.x;
    float Sr[128];
#pragma unroll
    for (int k = 0; k < 128; ++k) Sr[k] = 0.f;
    for (int t0 = 0; t0 < SEQ_; t0 += 16) {
        __syncthreads();
        for (int i = 0; i < 16; ++i) { const bf16* ur = u + (size_t)(b * SEQ_ + t0 + i) * UC_ + h * 128 + v;
            const float f = exp2f(bf2f(ur[512])); qs[i][v] = bf2f(ur[0]); fs[i][v] = f; ks[i][v] = 1.f - f; }
        __syncthreads();
        for (int i = 0; i < 16; ++i) { const float iv = bf2f(u[(size_t)(b * SEQ_ + t0 + i) * UC_ + 1024 + h * 128 + v]); float o = 0.f;
#pragma unroll
            for (int k = 0; k < 128; ++k) { Sr[k] = fmaf(fs[i][k], Sr[k], ks[i][k] * iv); o = fmaf(qs[i][k], Sr[k], o); }
            oraw[(size_t)(b * SEQ_ + t0 + i) * 512 + h * 128 + v] = o; }
    }
}
__global__ void k_hnorm(const float* __restrict__ oraw, const bf16* __restrict__ u, const float* __restrict__ gain, bf16* __restrict__ mix) {
    const int w = (int)((blockIdx.x * (size_t)blockDim.x + threadIdx.x) >> 6), lane = threadIdx.x & 63;
    if (w >= T_ * 4) return;
    const int t = w / 4, h = w % 4;
    const float* orow = oraw + (size_t)t * 512 + h * 128; const float a = orow[lane], c = orow[lane + 64];
    const float r = rsqrtf(wsum(a * a + c * c) * (1.f / 128) + EPS_);
    const bf16* gr = u + (size_t)t * UC_ + 1536 + h * 128;
    mix[(size_t)t * DM_ + h * 128 + lane] = tobf(a * r * gain[lane] * bf2f(gr[lane]));
    mix[(size_t)t * DM_ + h * 128 + lane + 64] = tobf(c * r * gain[lane + 64] * bf2f(gr[lane + 64]));
}
__global__ void __launch_bounds__(64) k_attn(const bf16* __restrict__ u, const float* __restrict__ cum, const float* __restrict__ gain, bf16* __restrict__ mix) {
    __shared__ float Ks[64][64], Vs[64][64], Cs[64];
    const int qt = blockIdx.x % (SEQ_ / 64), bh = blockIdx.x / (SEQ_ / 64), h = bh % 8, b = bh / 8, lane = threadIdx.x;
    const int t = qt * 64 + lane;
    float q[64], o[64];
    const bf16* qrow = u + (size_t)(b * SEQ_ + t) * UC_ + 2048 + h * 64;
#pragma unroll
    for (int d = 0; d < 64; ++d) { q[d] = bf2f(qrow[d]); o[d] = 0.f; }
    const float ct = cum[(size_t)(b * SEQ_ + t) * 8 + h] * 1.4426950408889634f;
    float m = -1e30f, l = 0.f;
    for (int kt = 0; kt <= qt; ++kt) {
        __syncthreads();
        for (int i = 0; i < 64; ++i) { const bf16* kr = u + (size_t)(b * SEQ_ + kt * 64 + i) * UC_ + 2560 + h * 64; Ks[i][lane] = bf2f(kr[lane]); Vs[i][lane] = bf2f(kr[512 + lane]); }
        Cs[lane] = cum[(size_t)(b * SEQ_ + kt * 64 + lane) * 8 + h] * 1.4426950408889634f;
        __syncthreads();
        for (int s = 0; s < 64; ++s) {
            float x = 0.f;
#pragma unroll
            for (int d = 0; d < 64; ++d) x = fmaf(q[d], Ks[s][d], x);
            x += ct - Cs[s];
            const bool ok = (kt * 64 + s) <= t; if (!ok) x = -1e30f;
            const float mn = fmaxf(m, x); const float al = exp2f(m - mn); const float p = ok ? exp2f(x - mn) : 0.f;
            l = l * al + p; m = mn;
#pragma unroll
            for (int d = 0; d < 64; ++d) o[d] = fmaf(o[d], al, p * Vs[s][d]);
        }
    }
    float ss = 0.f; const float il = 1.f / l;
#pragma unroll
    for (int d = 0; d < 64; ++d) { o[d] *= il; ss += o[d] * o[d]; }
    const float r = rsqrtf(ss * (1.f / 64) + EPS_);
    bf16* orow = mix + (size_t)(b * SEQ_ + t) * DM_ + 512 + h * 64;
#pragma unroll
    for (int d = 0; d < 64; ++d) orow[d] = tobf(o[d] * r * gain[d]);
}
__global__ void k_route(const float* __restrict__ x0, const bf16* __restrict__ dd, const float* __restrict__ gain, const float* __restrict__ wg, const float* __restrict__ bg,
                        const float* __restrict__ we, const float* __restrict__ be, bf16* __restrict__ xn2, int* __restrict__ re, float* __restrict__ rw) {
    const int w = (int)((blockIdx.x * (size_t)blockDim.x + threadIdx.x) >> 6), lane = threadIdx.x & 63;
    if (w >= T_) return;
    const float4* xr = (const float4*)(x0 + (size_t)w * DM_); const float4* gr = (const float4*)gain;
    float4 v[4]; float s = 0.f;
#pragma unroll
    for (int j = 0; j < 4; ++j) { v[j] = xr[lane + 64 * j]; const bf16* dp = dd + (size_t)w * DM_ + (lane + 64 * j) * 4; v[j].x += bf2f(dp[0]); v[j].y += bf2f(dp[1]); v[j].z += bf2f(dp[2]); v[j].w += bf2f(dp[3]); s += v[j].x * v[j].x + v[j].y * v[j].y + v[j].z * v[j].z + v[j].w * v[j].w; }
    s = wsum(s); const float r = rsqrtf(s * (1.f / DM_) + EPS_);
    float lg[20];
#pragma unroll
    for (int i = 0; i < 20; ++i) lg[i] = 0.f;
#pragma unroll
    for (int j = 0; j < 4; ++j) { const float4 gg = gr[lane + 64 * j]; const float tv[4] = {v[j].x * r * gg.x, v[j].y * r * gg.y, v[j].z * r * gg.z, v[j].w * r * gg.w};
        bf16* xo = xn2 + (size_t)w * DM_ + (lane + 64 * j) * 4;
#pragma unroll
        for (int c = 0; c < 4; ++c) { xo[c] = tobf(tv[c]); const int d = (lane + 64 * j) * 4 + c; const float4 g4 = *(const float4*)(wg + (size_t)d * 4);
            lg[0] = fmaf(tv[c], g4.x, lg[0]); lg[1] = fmaf(tv[c], g4.y, lg[1]); lg[2] = fmaf(tv[c], g4.z, lg[2]); lg[3] = fmaf(tv[c], g4.w, lg[3]);
#pragma unroll
            for (int q = 0; q < 4; ++q) { const float4 e4 = *(const float4*)(we + (size_t)d * 16 + q * 4);
                lg[4 + q * 4 + 0] = fmaf(tv[c], e4.x, lg[4 + q * 4 + 0]); lg[4 + q * 4 + 1] = fmaf(tv[c], e4.y, lg[4 + q * 4 + 1]);
                lg[4 + q * 4 + 2] = fmaf(tv[c], e4.z, lg[4 + q * 4 + 2]); lg[4 + q * 4 + 3] = fmaf(tv[c], e4.w, lg[4 + q * 4 + 3]); } } }
#pragma unroll
    for (int i = 0; i < 20; ++i) lg[i] = wsum(lg[i]);
    if (lane == 0) {
        float g[4]; int gs = 0;
#pragma unroll
        for (int i = 0; i < 4; ++i) g[i] = lg[i] + bg[i];
        float gm = g[0];
#pragma unroll
        for (int i = 1; i < 4; ++i) if (g[i] > gm) { gm = g[i]; gs = i; }
        float den = 0.f;
#pragma unroll
        for (int i = 0; i < 4; ++i) den += expf(g[i] - gm);
        const float pg = 1.f / den;
        float e[4];
#pragma unroll
        for (int i = 0; i < 4; ++i) { float x = 0.f;
#pragma unroll
            for (int q = 0; q < 4; ++q) if (q == gs) x = lg[4 + q * 4 + i] + be[q * 4 + i];
            e[i] = x; }
        int i0 = 0; float e0v = e[0];
#pragma unroll
        for (int i = 1; i < 4; ++i) if (e[i] > e0v) { e0v = e[i]; i0 = i; }
        int i1 = -1; float e1v = -3.0e38f;
#pragma unroll
        for (int i = 0; i < 4; ++i) if (i != i0 && e[i] > e1v) { e1v = e[i]; i1 = i; }
        const float p1r = expf(e1v - e0v);
        re[w] = (gs * 4 + i0) | ((gs * 4 + i1) << 8);
        rw[w * 2 + 0] = pg / (1.f + p1r); rw[w * 2 + 1] = pg * p1r / (1.f + p1r);
    }
}
__global__ void k_assign(const int* __restrict__ re, int* __restrict__ cnt, int* __restrict__ entry) {
    const int t = blockIdx.x * blockDim.x + threadIdx.x; if (t >= T_) return;
    const int r = re[t];
#pragma unroll
    for (int k = 0; k < 2; ++k) { const int e = (r >> (8 * k)) & 0xff; const int pos = atomicAdd(&cnt[e], 1); entry[(size_t)e * T_ + pos] = t * 2 + k; }
}
__global__ void k_plan(const int* __restrict__ cnt, int* __restrict__ plan, int* __restrict__ tile_e) {
    if (threadIdx.x == 0 && blockIdx.x == 0) { int base = 0;
        for (int e = 0; e < NE_; ++e) { plan[e] = base; const int nt = (cnt[e] + 255) >> 8; for (int i = 0; i < nt; ++i) tile_e[(base >> 8) + i] = e; base += nt * 256; }
        plan[16] = base; plan[32] = base; }
}
__global__ void k_fill(const int* __restrict__ cnt, const int* __restrict__ plan, const int* __restrict__ entry, const float* __restrict__ rw, int* __restrict__ srow, float* __restrict__ sw, int* __restrict__ stok) {
    const int r = blockIdx.x * blockDim.x + threadIdx.x; if (r >= RMAX_) return;
    int tk = -1; float w = 0.f;
    if (r < plan[16]) { int e = 0;
#pragma unroll
        for (int i = 1; i < NE_; ++i) if (r >= plan[i]) e = i;
        const int pos = r - plan[e];
        if (pos < cnt[e]) { tk = entry[(size_t)e * T_ + pos]; w = rw[tk]; } }
    srow[r] = tk; sw[r] = w; stok[r] = tk < 0 ? -1 : (tk >> 1);
}
__global__ void k_final(const float* x0, const bf16* __restrict__ dd, const bf16* __restrict__ y, const float* __restrict__ g, float* out) {
    const int w = (int)((blockIdx.x * (size_t)blockDim.x + threadIdx.x) >> 6), lane = threadIdx.x & 63;
    if (w >= T_) return;
    const float4* xr = (const float4*)(x0 + (size_t)w * DM_); const float4* gr = (const float4*)g; float4* yr = (float4*)(out + (size_t)w * DM_);
    float4 v[4]; float s = 0.f;
#pragma unroll
    for (int j = 0; j < 4; ++j) { v[j] = xr[lane + 64 * j]; { const bf16* dp = dd + (size_t)w * DM_ + (lane + 64 * j) * 4; v[j].x += bf2f(dp[0]); v[j].y += bf2f(dp[1]); v[j].z += bf2f(dp[2]); v[j].w += bf2f(dp[3]); } const bf16* y0 = y + (size_t)w * DM_ + (lane + 64 * j) * 4; const bf16* y1 = y0 + (size_t)T_ * DM_;
        v[j].x += bf2f(y0[0]) + bf2f(y1[0]); v[j].y += bf2f(y0[1]) + bf2f(y1[1]); v[j].z += bf2f(y0[2]) + bf2f(y1[2]); v[j].w += bf2f(y0[3]) + bf2f(y1[3]);
        s += v[j].x * v[j].x + v[j].y * v[j].y + v[j].z * v[j].z + v[j].w * v[j].w; }
    s = wsum(s); const float r = rsqrtf(s * (1.f / DM_) + EPS_);
#pragma unroll
    for (int j = 0; j < 4; ++j) { const float4 gg = gr[lane + 64 * j]; float4 o; o.x = v[j].x * r * gg.x; o.y = v[j].y * r * gg.y; o.z = v[j].z * r * gg.z; o.w = v[j].w * r * gg.w; yr[lane + 64 * j] = o; }
}
}
#endif
constexpr int N_PHASES = 8;
struct Args { const float* in[17]; float* out; unsigned char* ws; int ph_lo, ph_hi, li, pad; };
__global__ void __launch_bounds__(NWAVES * 64, 2) mk_fwd(Args args) {
    extern __shared__ __attribute__((aligned(16))) unsigned char lds[];
    Frame F;
    F.lds = (LAS unsigned char*)lds;
    F.MISC = (volatile LAS unsigned*)(F.lds + MISC_OFF);
    F.tid = threadIdx.x; F.lane = F.tid & 63; F.wave = __builtin_amdgcn_readfirstlane(F.tid >> 6);
    F.G = gridDim.x; { const int bx = blockIdx.x; F.vcu = (F.G % 8 == 0) ? (bx % 8) * (F.G / 8) + bx / 8 : bx; }
    F.ws = args.ws; F.out = args.out;
#pragma unroll
    for (int i = 0; i < 17; ++i) F.in[i] = args.in[i];
    F.ctl = (gu32*)(args.ws + WS_CTL);
#if defined(MK_ZERO_LDS)
    for (int u = F.tid; u < LDSCTL_OFF / 4; u += NWAVES * 64) ((LAS unsigned*)(F.lds))[u] = 0u;
#endif
    for (int u = F.tid; u < (LDS_BYTES - LDSCTL_OFF) / 4; u += NWAVES * 64) ((LAS unsigned*)(F.lds + LDSCTL_OFF))[u] = 0u;
    __syncthreads();
    const int lo = args.ph_lo, hi = args.ph_hi;
    XcdBarrier bar; bar.bar = (unsigned*)(F.ctl + CW_BAR) + args.li * XCD_BAR_WORDS; bar.x = 0; bar.st = nullptr;
    if (hi - lo > 1) bar = xcd_barrier_post((unsigned*)(F.ctl + CW_BAR) + args.li * XCD_BAR_WORDS, F.MISC + 8);
#ifndef MK_PH_EN
#define MK_PH_EN 0xFF
#endif
#define IN(k) (((MK_PH_EN >> (k)) & 1) && lo <= (k) && (k) < hi)
#define BOTH(k) (IN(k) && IN((k) + 1))
#define GRID_BAR() xcd_barrier(bar)
#define P1_PROBE 0
#ifndef MK_REP_PHASE
#define MK_REP_PHASE -1
#endif
#ifndef MK_REP_SUB
#define MK_REP_SUB 0
#endif
#define NREP(k) ((MK_REP_PHASE == (k)) ? 2 : 1)
    bf16* XN = (bf16*)(F.ws + WS_XN); bf16* U = (bf16*)(F.ws + WS_U);

    if (IN(0)) { p0_prologue(F); if (BOTH(0)) GRID_BAR(); }

    if (IN(1)) {
        pg8::Gemm g{XN, (const bf16*)(F.ws + WS_WI), T_, UC_, DM_}; pg8::StaticOrder S; S.init(T_, UC_, F.G, (int)blockIdx.x);
        pg8::EpiU E{U, UC_, (const float*)(F.ws + WS_LB), QSCALE_, P1_PROBE, (long)(WS_CTL + (size_t)CW_KT * 4) - (long)WS_U};
        pg8::gemm_phase<pg8::EpiU, pg8::StaticOrder, true, true>(F.lds + RING_OFF, g, S, E);
        if (BOTH(1)) GRID_BAR();
    }

    if (IN(2)) {
#if !defined(MK_NAIVE_HGRN)
#if MK_REP_SUB == 1
#ifndef MK_HG_VAR
#define MK_HG_VAR 0
#endif
        hgrn_body::hgrn_phase<MK_HG_VAR>((char*)lds + RING_OFF, (const bf16*)U, (bf16*)(F.ws + WS_MIX), F.in[4], F.vcu, F.G);
#endif
        hgrn_body::hgrn_phase((char*)lds + RING_OFF, (const bf16*)U, (bf16*)(F.ws + WS_MIX), F.in[4], F.vcu, F.G);
#endif
#if defined(MK_SELFCHECK_HGRN)
#if defined(MK_SCRAMBLE_LDS)
        __syncthreads(); for (int u = F.tid; u < LDSCTL_OFF / 4; u += NWAVES * 64) ((LAS unsigned*)(F.lds))[u] = 0xFFFFFFFFu; __syncthreads();
#endif
        hgrn_body::hgrn_phase((char*)lds + RING_OFF, (const bf16*)U, (bf16*)(F.ws + WS_ORAW), F.in[4], F.vcu, F.G);
        asm volatile("s_waitcnt vmcnt(0)" ::: "memory"); __syncthreads();
        if (F.vcu < 128) { const int ub = F.vcu >> 2, uh = F.vcu & 3; unsigned bad = 0u;
            for (int i = F.tid; i < 2048 * 16; i += NWAVES * 64) { const size_t off = ((size_t)ub * 2048 + (i >> 4)) * 1024 + uh * 128 + (i & 15) * 8;
                const unsigned long long a0 = __hip_atomic_load((const unsigned long long*)(XN + off), RLX_AGENT), a1 = __hip_atomic_load((const unsigned long long*)(XN + off) + 1, RLX_AGENT);
                const unsigned long long b0 = __hip_atomic_load((const unsigned long long*)((const bf16*)(F.ws + WS_ORAW) + off), RLX_AGENT), b1 = __hip_atomic_load((const unsigned long long*)((const bf16*)(F.ws + WS_ORAW) + off) + 1, RLX_AGENT);
                bad |= (a0 != b0 || a1 != b1) ? 1u : 0u; }
            if (bad) __hip_atomic_store(F.ctl + 2, 1u, RLX_AGENT); }
        __syncthreads();
#endif
#if !defined(MK_NAIVE_ATTN)
        attn_body::attn_phase<8>((char*)lds + RING_OFF, (const attn_body::bf16*)U, (attn_body::bf16*)(F.ws + WS_MIX), (const float*)(F.ws + WS_FLG), F.in[6], F.vcu, F.G, (unsigned*)(F.ctl + CW_CLAIM), (const unsigned*)(F.ctl + CW_KT), (const unsigned*)(F.ctl + CW_QT),
            [&](int it) { if (F.G == 256 && it < 0) { __syncthreads(); Frame F2 = F; { int l_ = F.lane; asm volatile("" : "+v"(l_)); F2.lane = l_; }
                convert_items(F2, CONV_I_WI, CONV_I_REST, F.vcu * NWAVES + F.wave, F.G * NWAVES); __syncthreads(); } });
#endif
#if MK_REP_SUB == 2
        attn_body::attn_phase<8>((char*)lds + RING_OFF, (const attn_body::bf16*)U, (attn_body::bf16*)(F.ws + WS_MIX), (const float*)(F.ws + WS_FLG), F.in[6], F.vcu, F.G, (unsigned*)(F.ctl + CW_CLAIM), (const unsigned*)(F.ctl + CW_KT), (const unsigned*)(F.ctl + CW_QT),
            [&](int it) { if (F.G == 256 && it < 0) { __syncthreads(); Frame F2 = F; { int l_ = F.lane; asm volatile("" : "+v"(l_)); F2.lane = l_; }
                convert_items(F2, CONV_I_WI, CONV_I_REST, F.vcu * NWAVES + F.wave, F.G * NWAVES); __syncthreads(); } });
#endif

        if (BOTH(2)) GRID_BAR();
    }

    if (IN(3)) {
        pg8::Gemm g{(const bf16*)(F.ws + WS_MIX), (const bf16*)(F.ws + WS_WO), T_, DM_, DM_}; pg8::StaticOrder S; S.init(T_, DM_, F.G, (int)blockIdx.x);
        pg8::EpiH1 E{F.in[1], (bf16*)(F.ws + WS_D), DM_, (long)WS_XN - (long)WS_D, (long)WS_RMS0 - (long)WS_D};
        pg8::gemm_phase<pg8::EpiH1, pg8::StaticOrder, true, true>(F.lds + RING_OFF, g, S, E);
        if (BOTH(3)) GRID_BAR();
    }

#if defined(MK_TIME_P4)
    if (IN(4)) { p4_router<true>(F); GRID_BAR(); }
#endif
    if (IN(4)) { p4_router<false>(F); if (BOTH(4)) GRID_BAR(); }

    if (IN(5)) {
        moe_tables(F, false);
        pg8::MGemm g{(const bf16*)(F.ws + WS_D), (const bf16*)(F.ws + WS_WGU), DM_, DM_, 1024}; pg8::MoeOrderP<3> S{(LAS const int*)(F.lds + TB_OFF), F.G, F.vcu};
        pg8::EpiSwiglu E{(bf16*)(F.ws + WS_HB), (LAS const int*)(F.lds + TAB_OFF)};
        pg8::gemm_phase_moe<pg8::EpiSwiglu, pg8::MoeOrderP<3>, true, true, false>(F.lds + RING_OFF, (LAS const int*)(F.lds + TAB_OFF), g, S, E);
        if (BOTH(5)) GRID_BAR();
    }

    if (IN(6)) {
        moe_tables(F, true);
        pg8::MGemm g{(const bf16*)(F.ws + WS_HB), (const bf16*)(F.ws + WS_WD), 2 * EH_, EH_, 1024}; pg8::MoeOrderP<2> S{(LAS const int*)(F.lds + TB_OFF), F.G, F.vcu};
        pg8::EpiDown E{(bf16*)(F.ws + WS_Y), (LAS const int*)(F.lds + TAB_OFF)};
        pg8::gemm_phase_moe<pg8::EpiDown, pg8::MoeOrderP<2>, false, true, true>(F.lds + RING_OFF, (LAS const int*)(F.lds + TAB_OFF), g, S, E);
        if (BOTH(6)) GRID_BAR();
    }

#if defined(MK_TIME_P7)
    if (IN(7)) { p7_final<true>(F); GRID_BAR(); }
#endif
    if (IN(7)) { p7_final<false>(F); }
#undef IN
#undef BOTH
#undef GRID_BAR
}
extern "C" void kernel_launch(void* const* d_in, const int* in_sizes, int n_in, void* d_out, int out_size, void* d_ws, size_t ws_size, hipStream_t stream) {
    static int grid = 0;
    if (grid == 0) {
        if (n_in != 17 || in_sizes[0] != T_ * DM_ || out_size != T_ * DM_ || ws_size < WS_END) { fprintf(stderr, "kernel_launch: unexpected shapes (n_in %d, in0 %d, out %d, ws %zu); nothing launched\n", n_in, n_in > 0 ? in_sizes[0] : -1, out_size, ws_size); grid = -1; return; }
        int dev = 0, cus = 0, per_cu = 0;
        if (hipGetDevice(&dev) != hipSuccess || hipDeviceGetAttribute(&cus, hipDeviceAttributeMultiprocessorCount, dev) != hipSuccess) { grid = -1; return; }
        if (hipFuncSetAttribute((const void*)mk_fwd, hipFuncAttributeMaxDynamicSharedMemorySize, LDS_BYTES) != hipSuccess) { fprintf(stderr, "kernel_launch: hipFuncSetAttribute failed\n"); grid = -1; return; }
        if (hipOccupancyMaxActiveBlocksPerMultiprocessor(&per_cu, (const void*)mk_fwd, NWAVES * 64, LDS_BYTES) != hipSuccess || per_cu < 1)
            fprintf(stderr, "kernel_launch: note: occupancy query reports %d workgroups per CU\n", per_cu);
        (void)hipGetLastError();
        grid = cus;
    }
    if (grid < 0) return;
    unsigned char* ws = (unsigned char*)d_ws;
    if (hipMemsetAsync(ws + WS_CTL, 0, CTL_ZERO_BYTES, stream) != hipSuccess) return;
    Args a{};
    for (int i = 0; i < 17; ++i) a.in[i] = (const float*)d_in[i];
    a.out = (float*)d_out; a.ws = ws;
    int li = 0;
    for (int p = 0; p < N_PHASES;) {
        if ((MK_OPT_MASK >> p) & 1) { int q = p; while (q < N_PHASES && ((MK_OPT_MASK >> q) & 1)) ++q;
#if defined(MK_NAIVE_HGRN) || defined(MK_NAIVE_ATTN)
            if (p < 2 && q > 2) q = 2;
#endif
#if defined(MK_NAIVE_HGRN)
            if (p == 2) { nb::k_hgrn<<<NB_ * 4, 128, 0, stream>>>((const bf16*)(ws + WS_U), (float*)(ws + WS_ORAW)); nb::k_hnorm<<<T_ * 4 / 4, 256, 0, stream>>>((const float*)(ws + WS_ORAW), (const bf16*)(ws + WS_U), (const float*)d_in[4], (bf16*)(ws + WS_XN)); }
#endif
#if defined(MK_NAIVE_ATTN)
            if (p == 2) { nb::k_cum<<<1, 256, 0, stream>>>((const float*)(ws + WS_FLG), (float*)(ws + WS_CUM)); nb::k_attn<<<NB_ * 8 * (SEQ_ / 64), 64, 0, stream>>>((const bf16*)(ws + WS_U), (const float*)(ws + WS_CUM), (const float*)d_in[6], (bf16*)(ws + WS_XN)); }
#endif
#if defined(MK_OVERWRITE)
            { int c = p; while (c < q && !((MK_OVERWRITE >> c) & 1) && !(c == 2 && (MK_OVERWRITE & 0x300))) ++c; if (c < q) q = c + 1; }
#endif
            a.ph_lo = p; a.ph_hi = q; a.li = li++;
            hipLaunchKernelGGL(mk_fwd, dim3(grid), dim3(NWAVES * 64), LDS_BYTES, stream, a);
#if defined(MK_OVERWRITE)
            { const int k = q - 1; bf16* XNb = (bf16*)(ws + WS_XN); bf16* Ub = (bf16*)(ws + WS_U); float* outf = (float*)d_out;
              int* CNT = (int*)(ws + WS_CTL) + CW_CNT; int* PLAN = (int*)(ws + WS_CTL) + CW_PLAN;
              if (k == 1 && ((MK_OVERWRITE >> 1) & 1)) { nb::NG g{}; g.A = XNb; g.lda = DM_; g.Bt = (const bf16*)(ws + WS_WI); g.ldb = DM_; g.M = T_; g.N = UC_; g.K = DM_; g.mode = 0; g.C = Ub; g.lb = (const float*)(ws + WS_LB);
                  nb::k_ngemm<<<dim3(UC_ / 64, T_ / 64), 256, 0, stream>>>(g); }
              if (k == 2 && (MK_OVERWRITE & 0x100)) { nb::k_hgrn<<<NB_ * 4, 128, 0, stream>>>(Ub, (float*)(ws + WS_ORAW)); nb::k_hnorm<<<T_ * 4 / 4, 256, 0, stream>>>((const float*)(ws + WS_ORAW), Ub, (const float*)d_in[4], XNb); }
              if (k == 2 && (MK_OVERWRITE & 0x200)) { nb::k_cum<<<1, 256, 0, stream>>>((const float*)(ws + WS_FLG), (float*)(ws + WS_CUM)); nb::k_attn<<<NB_ * 8 * (SEQ_ / 64), 64, 0, stream>>>(Ub, (const float*)(ws + WS_CUM), (const float*)d_in[6], XNb); }
              if (k == 3 && ((MK_OVERWRITE >> 3) & 1)) { nb::NG g{}; g.A = XNb; g.lda = DM_; g.Bt = (const bf16*)(ws + WS_WO); g.ldb = DM_; g.M = T_; g.N = DM_; g.K = DM_; g.mode = 1; g.C = (bf16*)(ws + WS_D);
                  nb::k_ngemm<<<dim3(DM_ / 64, T_ / 64), 256, 0, stream>>>(g); }
              if ((k == 5 && ((MK_OVERWRITE >> 5) & 1)) || (k == 6 && ((MK_OVERWRITE >> 6) & 1))) {
                  nb::k_plan<<<1, 64, 0, stream>>>(CNT, PLAN, (int*)(ws + WS_TILEE)); nb::k_fill<<<(RMAX_ + 255) / 256, 256, 0, stream>>>(CNT, PLAN, (const int*)(ws + WS_ENTRY), (const float*)(ws + WS_RW), (int*)(ws + WS_SROW), (float*)(ws + WS_SW), (int*)(ws + WS_STOK));
                  nb::NG g{}; g.tile_e = (const int*)(ws + WS_TILEE); g.Mdev = PLAN + 16; g.M = RMAX_;
                  if (k == 5) { g.A = XNb; g.lda = DM_; g.a_rows = (const int*)(ws + WS_STOK); g.Bt = (const bf16*)(ws + WS_WGU); g.ldb = DM_; g.strideB = (size_t)1024 * 1024; g.N = 512; g.K = DM_; g.mode = 2; g.C = (bf16*)(ws + WS_HB);
                      nb::k_ngemm<<<dim3(512 / 64, RMAX_ / 64), 256, 0, stream>>>(g); }
                  else { g.A = (const bf16*)(ws + WS_HB); g.lda = 512; g.Bt = (const bf16*)(ws + WS_WD); g.ldb = 512; g.strideB = (size_t)1024 * 512; g.N = DM_; g.K = 512; g.mode = 3; g.C = (bf16*)(ws + WS_Y); g.c_rows = (const int*)(ws + WS_SROW); g.roww = (const float*)(ws + WS_SW);
                      nb::k_ngemm<<<dim3(DM_ / 64, RMAX_ / 64), 256, 0, stream>>>(g); } } }
#endif
            p = q; continue; }
#if MK_OPT_MASK != 0xFF
        bf16* XN = (bf16*)(ws + WS_XN); bf16* U = (bf16*)(ws + WS_U); float* out = (float*)d_out;
        int* CNT = (int*)(ws + WS_CTL) + CW_CNT; int* PLAN = (int*)(ws + WS_CTL) + CW_PLAN;
        int* RE = (int*)(ws + WS_RE); float* RW = (float*)(ws + WS_RW); int* ENTRY = (int*)(ws + WS_ENTRY); int* SROW = (int*)(ws + WS_SROW); float* SW = (float*)(ws + WS_SW);
        int* STOK = (int*)(ws + WS_STOK); int* TILEE = (int*)(ws + WS_TILEE); float* CUM = (float*)(ws + WS_CUM); float* ORAW = (float*)(ws + WS_ORAW);
        bf16* HB = (bf16*)(ws + WS_HB); bf16* Y = (bf16*)(ws + WS_Y);
        if (p == 1) { nb::NG g{}; g.A = XN; g.lda = DM_; g.Bt = (const bf16*)(ws + WS_WI); g.ldb = DM_; g.M = T_; g.N = UC_; g.K = DM_; g.mode = 0; g.C = U; g.lb = (const float*)(ws + WS_LB);
            nb::k_ngemm<<<dim3(UC_ / 64, T_ / 64), 256, 0, stream>>>(g); }
        else if (p == 2) { nb::k_cum<<<1, 256, 0, stream>>>((const float*)(ws + WS_FLG), CUM);
            nb::k_hgrn<<<NB_ * 4, 128, 0, stream>>>(U, ORAW); nb::k_hnorm<<<T_ * 4 / 4, 256, 0, stream>>>(ORAW, U, (const float*)d_in[4], XN);
            nb::k_attn<<<NB_ * 8 * (SEQ_ / 64), 64, 0, stream>>>(U, CUM, (const float*)d_in[6], XN); }
        else if (p == 3) { nb::NG g{}; g.A = XN; g.lda = DM_; g.Bt = (const bf16*)(ws + WS_WO); g.ldb = DM_; g.M = T_; g.N = DM_; g.K = DM_; g.mode = 1; g.C = (bf16*)(ws + WS_D);
            nb::k_ngemm<<<dim3(DM_ / 64, T_ / 64), 256, 0, stream>>>(g); }
        else if (p == 4) { nb::k_route<<<T_ / 4, 256, 0, stream>>>((const float*)d_in[0], (const bf16*)(ws + WS_D), (const float*)d_in[8], (const float*)d_in[9], (const float*)d_in[10], (const float*)d_in[11], (const float*)d_in[12], XN, RE, RW);
            nb::k_assign<<<T_ / 256, 256, 0, stream>>>(RE, CNT, ENTRY); }
        else if (p == 5 || p == 6) { nb::k_plan<<<1, 64, 0, stream>>>(CNT, PLAN, TILEE); nb::k_fill<<<(RMAX_ + 255) / 256, 256, 0, stream>>>(CNT, PLAN, ENTRY, RW, SROW, SW, STOK);
            nb::NG g{}; g.tile_e = TILEE; g.Mdev = PLAN + 16; g.M = RMAX_;
            if (p == 5) { g.A = XN; g.lda = DM_; g.a_rows = STOK; g.Bt = (const bf16*)(ws + WS_WGU); g.ldb = DM_; g.strideB = (size_t)1024 * 1024; g.N = 512; g.K = DM_; g.mode = 2; g.C = HB;
                nb::k_ngemm<<<dim3(512 / 64, RMAX_ / 64), 256, 0, stream>>>(g); }
            else { g.A = HB; g.lda = 512; g.Bt = (const bf16*)(ws + WS_WD); g.ldb = 512; g.strideB = (size_t)1024 * 512; g.N = DM_; g.K = 512; g.mode = 3; g.C = Y; g.c_rows = SROW; g.roww = SW;
                nb::k_ngemm<<<dim3(DM_ / 64, RMAX_ / 64), 256, 0, stream>>>(g); } }
        else if (p == 7) { nb::k_final<<<T_ / 4, 256, 0, stream>>>((const float*)d_in[0], (const bf16*)(ws + WS_D), Y, (const float*)d_in[16], out); }
#endif
        ++p;
    }
}
```

```cpp
#include <hip/hip_runtime.h>
#include <hip/hip_bf16.h>
#include <cstdio>
#include <cstdint>
#include <cmath>
#ifndef MK_OPT_MASK
#define MK_OPT_MASK 0xFF
#endif
namespace pg8 {
#define PG8_LAS __attribute__((address_space(3)))
typedef unsigned short bf16_t;
typedef short bf16x8 __attribute__((ext_vector_type(8)));
typedef float f32x4 __attribute__((ext_vector_type(4)));
typedef unsigned u32x4 __attribute__((ext_vector_type(4)));
constexpr int BM = 256, BK = 64, HALF = 128, HTB = HALF * BK * 2  , STAGE_BYTES = 8 * HTB, NXCD = 8, WGM = 8;

__host__ __device__ __forceinline__ int lds_byte(int r, int c) { const int st = (r >> 4) * 2 + (c >> 5), rr = r & 15, cc = c & 31, ob = rr * 64 + cc * 2; return st * 1024 + (ob ^ (((ob >> 9) & 1) << 5)); }
__host__ __device__ __forceinline__ void stage_rc(int b, int& R, int& C) { const int st = b / 1024, sb = b % 1024, swz = sb ^ (((sb >> 9) & 1) << 5); R = (st >> 1) * 16 + swz / 64; C = (st & 1) * 32 + (swz % 64) / 2; }
__host__ __device__ __forceinline__ int perm32(int rho) { const int n = rho >> 4, i = rho & 15; return 8 * (i >> 2) + 4 * n + (i & 3); }

struct Unit { int pm, pn; };
struct Gemm { const bf16_t* A; const bf16_t* Bt; int M, N, K; };

struct StaticOrder {
    int nM, nN, nwg, G, c;
    __host__ __device__ void init(int M, int N, int G_, int c_) { nM = M / BM; nN = N / BM; nwg = nM * nN; G = G_; c = c_; }
    __host__ __device__ bool next(int i, Unit& u) const {
        const long L = (long)i * G + c; if (L >= nwg) return false;
        int wgid = (int)L; { const int q = nwg / NXCD, r = nwg % NXCD, xcd = wgid % NXCD, off = wgid / NXCD; wgid = (xcd < r ? xcd * (q + 1) : r * (q + 1) + (xcd - r) * q) + off; }
        const int nig = WGM * nN, gid = wgid / nig, fm = gid * WGM, gsz = (nM - fm) < WGM ? (nM - fm) : WGM;
        u.pm = fm + ((wgid % nig) % gsz); u.pn = (wgid % nig) / gsz; return true;
    }
    __device__ __forceinline__ void a_ready(const Unit&) const {}
    __device__ __forceinline__ void done(const Unit&) const {}
};

__device__ __forceinline__ unsigned cvt_pk_bf16(float lo, float hi) { unsigned r; asm volatile("v_cvt_pk_bf16_f32 %0, %1, %2" : "=v"(r) : "v"(lo), "v"(hi)); return r; }
typedef float f32x2 __attribute__((ext_vector_type(2)));
__device__ __forceinline__ f32x2 gelu_pk(f32x2 v) {
    const f32x2 av = __builtin_elementwise_abs(v), d = av * 0.2316418882f + 1.0f;
    f32x2 t; t.x = __builtin_amdgcn_rcpf(d.x); t.y = __builtin_amdgcn_rcpf(d.y);
    f32x2 q = t * 0.5307027145f + (-0.7265760135f); q = q * t + 0.7107068705f; q = q * t + (-0.142248368f); q = q * t + 0.127414796f; q = q * t;
    const f32x2 s = (v * v) * (-0.72134752044f);
    f32x2 e; e.x = __builtin_amdgcn_exp2f(s.x); e.y = __builtin_amdgcn_exp2f(s.y);
    const f32x2 m = v * (q * e), r = v - m;
    f32x2 o; o.x = v.x < 0.f ? m.x : r.x; o.y = v.y < 0.f ? m.y : r.y; return o;
}

template <int ACT  > struct EpiBf16 {
    static constexpr bool PERM = true, AFTER_DRAIN = false; static_assert(ACT == 0 || ACT == 1, "EpiBf16: ACT is 0 (none) or 1 (gelu_pk)");
    bf16_t* O; int ldc; const float* bias; int split_cols; size_t split_stride; float scale0;
    __device__ __forceinline__ void operator()(const f32x4 (&acc)[2][2][4][2], const Unit& u, int wr, int wc, int fr, int fq) const {
        const int row0 = u.pm * BM + wr * 64 + fr; int colt = u.pn * BM; bf16_t* base = O;
        float sc = 1.f; if (split_cols) { const int t = colt / split_cols; base += (size_t)t * split_stride; colt -= t * split_cols; if (t == 0) sc = scale0; }
        const int col0 = colt + wc * 32 + 8 * fq, bcol0 = u.pn * BM + wc * 32 + 8 * fq;
        f32x4 bv[2][2];
#pragma unroll
        for (int bj = 0; bj < 2; ++bj)
#pragma unroll
            for (int n = 0; n < 2; ++n) bv[bj][n] = bias ? *(const f32x4*)(bias + bcol0 + bj * HALF + 4 * n) : (f32x4){0.f, 0.f, 0.f, 0.f};
#pragma unroll
        for (int ai = 0; ai < 2; ++ai)
#pragma unroll
            for (int m = 0; m < 4; ++m) { bf16_t* rowp = base + (size_t)(row0 + ai * HALF + m * 16) * ldc + col0;
#pragma unroll
                for (int bj = 0; bj < 2; ++bj) { f32x4 v0 = acc[ai][bj][m][0] + bv[bj][0], v1 = acc[ai][bj][m][1] + bv[bj][1];
                    if (ACT == 1) { f32x2 a = gelu_pk((f32x2){v0[0], v0[1]}), b = gelu_pk((f32x2){v0[2], v0[3]}), c = gelu_pk((f32x2){v1[0], v1[1]}), d = gelu_pk((f32x2){v1[2], v1[3]});
                        v0 = (f32x4){a.x, a.y, b.x, b.y}; v1 = (f32x4){c.x, c.y, d.x, d.y}; }
                    v0 = v0 * sc; v1 = v1 * sc; u32x4 w; w.x = cvt_pk_bf16(v0[0], v0[1]); w.y = cvt_pk_bf16(v0[2], v0[3]); w.z = cvt_pk_bf16(v1[0], v1[1]); w.w = cvt_pk_bf16(v1[2], v1[3]);
                    *(u32x4*)(rowp + bj * HALF) = w; } }
    }
};

struct PanelStats {
    unsigned* xbuf;
    unsigned* cnt;
    unsigned* tmo;
    int ntn; float eps;
    unsigned code;
    __device__ __forceinline__ bool run(const f32x4 (&v)[2][2][4][2], const Unit& u, int wr, int wc, int fr, int fq, PG8_LAS unsigned char* lds, int wid, int lane) const {
        typedef float f32x2v __attribute__((ext_vector_type(2)));
        PG8_LAS f32x2v* P = (PG8_LAS f32x2v*)lds;
        PG8_LAS f32x2v* S = (PG8_LAS f32x2v*)(lds + 8192);
        PG8_LAS unsigned* flag = (PG8_LAS unsigned*)(lds + 8192 + 2048);
#pragma unroll
        for (int ai = 0; ai < 2; ++ai)
#pragma unroll
            for (int m = 0; m < 4; ++m) {
                float s = 0.f;
#pragma unroll
                for (int bj = 0; bj < 2; ++bj)
#pragma unroll
                    for (int n = 0; n < 2; ++n) { const f32x4 x = v[ai][bj][m][n]; s += (x[0] + x[1]) + (x[2] + x[3]); }
                s += __shfl_xor(s, 16); s += __shfl_xor(s, 32);
                const float mw = s * (1.0f / 64.0f); float q = 0.f;
#pragma unroll
                for (int bj = 0; bj < 2; ++bj)
#pragma unroll
                    for (int n = 0; n < 2; ++n) { const f32x4 d = v[ai][bj][m][n] - mw; q += (d[0] * d[0] + d[1] * d[1]) + (d[2] * d[2] + d[3] * d[3]); }
                q += __shfl_xor(q, 16); q += __shfl_xor(q, 32);
                if (fq == 0) P[(ai * HALF + wr * 64 + m * 16 + fr) * 4 + wc] = (f32x2v){mw, q};
            }
        asm volatile("s_waitcnt lgkmcnt(0)" ::: "memory"); __builtin_amdgcn_s_barrier(); asm volatile("" ::: "memory");
#if defined(BROKEN_EXCHANGE_NO_WAIT)
#warning BROKEN CONTROL BUILD: the row-statistics exchange does not wait; results are wrong by design
        if (blockIdx.x >= 64) { const long long t0_ = clock64(); while (clock64() - t0_ < 60000) __builtin_amdgcn_s_sleep(8); }
#endif
        const int row = wid * 32 + (lane & 31);
        if (lane < 32) {
            const f32x2v a = P[row * 4 + 0], b = P[row * 4 + 1], c = P[row * 4 + 2], d = P[row * 4 + 3];
            const float mt = (a.x + b.x + c.x + d.x) * 0.25f;
            const float da = a.x - mt, db = b.x - mt, dc = c.x - mt, dd = d.x - mt;
            const float m2 = (a.y + b.y) + (c.y + d.y) + 64.0f * ((da * da + db * db) + (dc * dc + dd * dd));
            unsigned long long* slot = (unsigned long long*)xbuf + ((size_t)(u.pm * BM + row) * 4 + u.pn);
            __hip_atomic_store(slot, ((unsigned long long)__float_as_uint(m2) << 32) | __float_as_uint(mt), __ATOMIC_RELAXED, __HIP_MEMORY_SCOPE_AGENT);
        }
        asm volatile("s_waitcnt vmcnt(0)" ::: "memory");
        if (lane == 0) __hip_atomic_fetch_add(cnt + 64 * u.pm, 1u, __ATOMIC_RELAXED, __HIP_MEMORY_SCOPE_AGENT);
        if (wid == 0) {
            bool dead = false; const unsigned long long t0 = __builtin_amdgcn_s_memrealtime(); const unsigned want = 8u * (unsigned)ntn;
            for (;;) {
#if defined(BROKEN_EXCHANGE_NO_WAIT)
                break;
#endif
                if ((unsigned)__builtin_amdgcn_readfirstlane(__hip_atomic_load(cnt + 64 * u.pm, __ATOMIC_RELAXED, __HIP_MEMORY_SCOPE_AGENT)) >= want) break;
                if (__builtin_amdgcn_s_memrealtime() - t0 > 2000000ull) {
                    if (lane == 0) { unsigned expect = 0u; __hip_atomic_compare_exchange_strong(tmo + 1, &expect, code | (unsigned)(u.pm & 0xff), __ATOMIC_RELAXED, __ATOMIC_RELAXED, __HIP_MEMORY_SCOPE_AGENT);
                                     __hip_atomic_store(tmo, 1u, __ATOMIC_RELAXED, __HIP_MEMORY_SCOPE_AGENT); }
                    dead = true; break; }
                __builtin_amdgcn_s_sleep(2);
            }
            __builtin_amdgcn_fence(__ATOMIC_ACQUIRE, "agent");
            if (lane == 0) flag[0] = dead ? 1u : 0u;
        }
        asm volatile("s_waitcnt vmcnt(0) lgkmcnt(0)" ::: "memory"); __builtin_amdgcn_s_barrier(); asm volatile("" ::: "memory");
        const bool bad = flag[0] != 0u;
        if (lane < 32) {
            const unsigned long long* slot = (const unsigned long long*)xbuf + (size_t)(u.pm * BM + row) * 4; float mt[4], m2[4]; float ms = 0.f;
#pragma unroll
            for (int t = 0; t < 4; ++t) { if (t < ntn) { const unsigned long long w = __hip_atomic_load(slot + t, __ATOMIC_RELAXED, __HIP_MEMORY_SCOPE_AGENT); mt[t] = __uint_as_float((unsigned)w); m2[t] = __uint_as_float((unsigned)(w >> 32)); } else { mt[t] = 0.f; m2[t] = 0.f; } ms += mt[t]; }
            const float mean = ms / (float)ntn; float q = 0.f;
#pragma unroll
            for (int t = 0; t < 4; ++t) if (t < ntn) { const float dm = mt[t] - mean; q += m2[t] + 256.0f * dm * dm; }
            S[row] = (f32x2v){mean, 1.0f / sqrtf(q / (256.0f * (float)ntn) + eps)};
        }
        asm volatile("s_waitcnt lgkmcnt(0)" ::: "memory"); __builtin_amdgcn_s_barrier(); asm volatile("" ::: "memory");
        return bad;
    }
};
struct EpiLnRes {
    static constexpr bool PERM = false, AFTER_DRAIN = true;
    const float* base; float* out; int ldc; const float* bias; PanelStats st; unsigned poison;
    __device__ __forceinline__ void fused(f32x4 (&acc)[2][2][4][2], const Unit& u, int wr, int wc, int fr, int fq, PG8_LAS unsigned char* lds, int wid, int lane) const {
        typedef float f32x2v __attribute__((ext_vector_type(2)));
        const PG8_LAS f32x2v* S = (const PG8_LAS f32x2v*)(lds + 8192);
        const int col0 = u.pn * BM + wc * 32 + 4 * fq;
#pragma unroll
        for (int bj = 0; bj < 2; ++bj)
#pragma unroll
            for (int n = 0; n < 2; ++n) { const f32x4 bv = bias ? *(const f32x4*)(bias + col0 + bj * HALF + n * 16) : (f32x4){0.f, 0.f, 0.f, 0.f};
#pragma unroll
                for (int ai = 0; ai < 2; ++ai)
#pragma unroll
                    for (int m = 0; m < 4; ++m) acc[ai][bj][m][n] += bv; }
        f32x4 pre[4][2][2];
#pragma unroll
        for (int m = 0; m < 4; ++m) { const size_t off = (size_t)(u.pm * BM + wr * 64 + m * 16 + fr) * ldc + col0;
#pragma unroll
            for (int bj = 0; bj < 2; ++bj)
#pragma unroll
                for (int n = 0; n < 2; ++n) pre[m][bj][n] = *(const f32x4*)(base + off + bj * HALF + n * 16); }
        const bool bad = st.run(acc, u, wr, wc, fr, fq, lds, wid, lane) || poison != 0u;
        const float qnan = __builtin_nanf("");
#pragma unroll
        for (int ai = 0; ai < 2; ++ai)
#pragma unroll
            for (int m = 0; m < 4; ++m) { const int r = ai * HALF + wr * 64 + m * 16 + fr; const f32x2v sr = S[r]; const size_t off = (size_t)(u.pm * BM + r) * ldc + col0;
#pragma unroll
                for (int bj = 0; bj < 2; ++bj)
#pragma unroll
                    for (int n = 0; n < 2; ++n) { const f32x4 bs = ai == 0 ? pre[m][bj][n] : *(const f32x4*)(base + off + bj * HALF + n * 16); f32x4 o = bs + (acc[ai][bj][m][n] - sr.x) * sr.y;
                        if (bad) o = (f32x4){qnan, qnan, qnan, qnan}; *(f32x4*)(out + off + bj * HALF + n * 16) = o; }
                if (m & 1) asm volatile("" ::: "memory"); }
    }
};
struct EpiLnResLn {
    static constexpr bool PERM = false, AFTER_DRAIN = true;
    const float* base; float* out; bf16_t* xn; int ldc; const float* bias; PanelStats st1, st2; unsigned poison;
    __device__ __forceinline__ void fused(f32x4 (&acc)[2][2][4][2], const Unit& u, int wr, int wc, int fr, int fq, PG8_LAS unsigned char* lds, int wid, int lane) const {
        typedef float f32x2v __attribute__((ext_vector_type(2))); typedef unsigned u32x2v __attribute__((ext_vector_type(2)));
        const PG8_LAS f32x2v* S = (const PG8_LAS f32x2v*)(lds + 8192);
        const int col0 = u.pn * BM + wc * 32 + 4 * fq;
#pragma unroll
        for (int bj = 0; bj < 2; ++bj)
#pragma unroll
            for (int n = 0; n < 2; ++n) { const f32x4 bv = bias ? *(const f32x4*)(bias + col0 + bj * HALF + n * 16) : (f32x4){0.f, 0.f, 0.f, 0.f};
#pragma unroll
                for (int ai = 0; ai < 2; ++ai)
#pragma unroll
                    for (int m = 0; m < 4; ++m) acc[ai][bj][m][n] += bv; }
        bool bad = st1.run(acc, u, wr, wc, fr, fq, lds, wid, lane) || poison != 0u;
        const float qnan = __builtin_nanf("");
#pragma unroll
        for (int ai = 0; ai < 2; ++ai)
#pragma unroll
            for (int m = 0; m < 4; ++m) { const int r = ai * HALF + wr * 64 + m * 16 + fr; const f32x2v sr = S[r]; const size_t off = (size_t)(u.pm * BM + r) * ldc + col0;
#pragma unroll
                for (int bj = 0; bj < 2; ++bj)
#pragma unroll
                    for (int n = 0; n < 2; ++n) { const f32x4 bs = *(const f32x4*)(base + off + bj * HALF + n * 16); acc[ai][bj][m][n] = bs + (acc[ai][bj][m][n] - sr.x) * sr.y; }
                asm volatile("" : "+v"(acc[ai][0][m][0]), "+v"(acc[ai][0][m][1]), "+v"(acc[ai][1][m][0]), "+v"(acc[ai][1][m][1]));
                if (m & 1) asm volatile("" ::: "memory"); }
        const bool bad1 = bad;
        bad = st2.run(acc, u, wr, wc, fr, fq, lds, wid, lane) || bad;
#pragma unroll
        for (int ai = 0; ai < 2; ++ai)
#pragma unroll
            for (int m = 0; m < 4; ++m) { const int r = ai * HALF + wr * 64 + m * 16 + fr; const f32x2v sr = S[r]; const size_t off = (size_t)(u.pm * BM + r) * ldc + col0;
#pragma unroll
                for (int bj = 0; bj < 2; ++bj)
#pragma unroll
                    for (int n = 0; n < 2; ++n) { const f32x4 x1 = acc[ai][bj][m][n]; *(f32x4*)(out + off + bj * HALF + n * 16) = bad1 ? (f32x4){qnan, qnan, qnan, qnan} : x1;
                        const f32x4 o = (x1 - sr.x) * sr.y; u32x2v w; w.x = cvt_pk_bf16(o[0], o[1]); w.y = cvt_pk_bf16(o[2], o[3]);
                        if (bad) { w.x = 0x7fc07fc0u; w.y = 0x7fc07fc0u; } *(u32x2v*)(xn + off + bj * HALF + n * 16) = w; }
                asm volatile("" ::: "memory"); }
    }
};

template <class Epi, class Sched, bool ALIGN_EPI = false, bool SP2 = false>
__device__ __forceinline__ void gemm_phase(PG8_LAS unsigned char* lds, const Gemm g, const Sched& S, const Epi& E) {
    const int tid = threadIdx.x, wid = __builtin_amdgcn_readfirstlane(tid >> 6), lane = tid & 63, wr = wid >> 2, wc = wid & 3, fr = lane & 15, fq = lane >> 4;
    const int K = g.K, nt = K / BK;
    unsigned voffA[2], voffB[2];
#pragma unroll
    for (int i = 0; i < 2; ++i) { int R, C; stage_rc(tid * 16 + i * 8192, R, C); const int Rb = Epi::PERM ? ((R & ~31) + perm32(R & 31)) : R;
        voffA[i] = (unsigned)(R * K + C) * 2u; voffB[i] = (unsigned)(Rb * K + C) * 2u; }
    const size_t kstep = (size_t)(BK * 2);
    const size_t hstep = (size_t)HALF * K * 2;
    const size_t tstep = 2 * hstep;
    const unsigned ldsw = (unsigned)wid * 1024u;
    const int aoff = lds_byte(wr * 64 + fr, fq * 8), boff = lds_byte(wc * 32 + fr, fq * 8);
#define PG8_SA(b, h) (((b) * 2 + (h)) * HTB)
#define PG8_SB(b, h) ((4 + (b) * 2 + (h)) * HTB)
#define PG8_STAGE(bufoff, gbase, voff) do { _Pragma("unroll") for (int _i = 0; _i < 2; ++_i) \
        __builtin_amdgcn_global_load_lds((const unsigned*)((const char*)(gbase) + (voff)[_i]), (PG8_LAS unsigned*)(lds + (bufoff) + ldsw + _i * 8192), 16, 0, 0); } while (0)
#define PG8_LDA(dst, b, h) do { _Pragma("unroll") for (int m = 0; m < 4; ++m) _Pragma("unroll") for (int k = 0; k < 2; ++k) dst[m][k] = *(const PG8_LAS bf16x8*)(lds + PG8_SA(b, h) + aoff + m * 2048 + k * 1024); } while (0)
#define PG8_LDB(dst, b, h) do { _Pragma("unroll") for (int n = 0; n < 2; ++n) _Pragma("unroll") for (int k = 0; k < 2; ++k) dst[n][k] = *(const PG8_LAS bf16x8*)(lds + PG8_SB(b, h) + boff + n * 2048 + k * 1024); } while (0)
#define PG8_MMA(ai, bj, At, Bt) do { __builtin_amdgcn_s_setprio(1); _Pragma("unroll") for (int m = 0; m < 4; ++m) _Pragma("unroll") for (int n = 0; n < 2; ++n) _Pragma("unroll") for (int k = 0; k < 2; ++k) \
        acc[ai][bj][m][n] = __builtin_amdgcn_mfma_f32_16x16x32_bf16(Bt[n][k], At[m][k], acc[ai][bj][m][n], 0, 0, 0); __builtin_amdgcn_s_setprio(0); } while (0)
#define PG8_WAIT_V(n) asm volatile("s_waitcnt vmcnt(" #n ")" ::: "memory")
#define PG8_WAIT_L(n) asm volatile("s_waitcnt lgkmcnt(" #n ")" ::: "memory")
#define PG8_BAR __builtin_amdgcn_s_barrier()
#define PG8_SCHED __builtin_amdgcn_sched_barrier(0)
    Unit cur, nxt; int ui = 0;
    if (!S.next(0, cur)) return;
    f32x4 acc[2][2][4][2];
#pragma unroll
    for (int a = 0; a < 2; ++a)
#pragma unroll
        for (int b = 0; b < 2; ++b)
#pragma unroll
            for (int m = 0; m < 4; ++m)
#pragma unroll
                for (int n = 0; n < 2; ++n) acc[a][b][m][n] = (f32x4){0.f, 0.f, 0.f, 0.f};
    bf16x8 At[4][2], B0[2][2], B1[2][2];
    const char* cA = (const char*)g.A + (size_t)cur.pm * tstep; const char* cB = (const char*)g.Bt + (size_t)cur.pn * tstep;
    S.a_ready(cur);
    if constexpr (SP2) {
        PG8_STAGE(PG8_SB(0, 0), cB, voffB); PG8_STAGE(PG8_SB(0, 1), cB + hstep, voffB); PG8_STAGE(PG8_SA(0, 0), cA, voffA); PG8_STAGE(PG8_SA(0, 1), cA + hstep, voffA);
        if (wr == 1) PG8_BAR;
        PG8_WAIT_V(2); PG8_BAR;
        PG8_STAGE(PG8_SB(1, 0), cB + kstep, voffB); PG8_STAGE(PG8_SA(1, 0), cA + kstep, voffA); PG8_STAGE(PG8_SB(1, 1), cB + hstep + kstep, voffB);
        PG8_WAIT_V(6); PG8_BAR;
    } else {
        PG8_STAGE(PG8_SB(0, 0), cB, voffB); PG8_STAGE(PG8_SA(0, 0), cA, voffA); PG8_STAGE(PG8_SB(0, 1), cB + hstep, voffB); PG8_STAGE(PG8_SA(0, 1), cA + hstep, voffA);
        if (wr == 1) PG8_BAR;
        PG8_WAIT_V(4); PG8_BAR;
        PG8_STAGE(PG8_SB(1, 0), cB + kstep, voffB); PG8_STAGE(PG8_SA(1, 0), cA + kstep, voffA); PG8_STAGE(PG8_SB(1, 1), cB + hstep + kstep, voffB);
        PG8_WAIT_V(6); PG8_BAR;
    }
    for (;;) {
        const bool has_next = S.next(ui + 1, nxt);
        const char* nA = has_next ? (const char*)g.A + (size_t)nxt.pm * tstep : cA; const char* nB = has_next ? (const char*)g.Bt + (size_t)nxt.pn * tstep : cB;
        for (int t = 0; t < nt; t += 2) {
            const bool last = (t == nt - 2);
            const char* a1 = cA + (size_t)(t + 1) * kstep;
            const char* a2 = last ? nA : cA + (size_t)(t + 2) * kstep; const char* b2 = last ? nB : cB + (size_t)(t + 2) * kstep;
            const char* a3 = a2 + kstep; const char* b3 = b2 + kstep;
            if (last && has_next) S.a_ready(nxt);
            if constexpr (SP2) {
            PG8_LDB(B0, 0, 0); PG8_LDB(B1, 0, 1); PG8_SCHED; PG8_LDA(At, 0, 0); PG8_STAGE(PG8_SA(1, 1), a1 + hstep, voffA);
            PG8_WAIT_V(8); PG8_WAIT_L(0); PG8_BAR; PG8_MMA(0, 0, At, B0); PG8_MMA(0, 1, At, B1); PG8_BAR; PG8_SCHED;
            PG8_LDA(At, 0, 1); PG8_STAGE(PG8_SB(0, 0), b2, voffB); PG8_STAGE(PG8_SB(0, 1), b2 + hstep, voffB); PG8_STAGE(PG8_SA(0, 0), a2, voffA);
            PG8_WAIT_V(8); PG8_WAIT_L(0); PG8_BAR; PG8_MMA(1, 0, At, B0); PG8_MMA(1, 1, At, B1); PG8_BAR; PG8_SCHED;
            PG8_LDB(B0, 1, 0); PG8_LDB(B1, 1, 1); PG8_SCHED; PG8_LDA(At, 1, 0); PG8_STAGE(PG8_SA(0, 1), a2 + hstep, voffA);
            PG8_WAIT_V(8); PG8_WAIT_L(0); PG8_BAR; PG8_MMA(0, 0, At, B0); PG8_MMA(0, 1, At, B1); PG8_BAR; PG8_SCHED;
            PG8_LDA(At, 1, 1); PG8_STAGE(PG8_SB(1, 0), b3, voffB); PG8_STAGE(PG8_SB(1, 1), b3 + hstep, voffB); PG8_STAGE(PG8_SA(1, 0), a3, voffA);
            PG8_WAIT_V(8); PG8_WAIT_L(0); PG8_BAR; PG8_MMA(1, 0, At, B0); PG8_MMA(1, 1, At, B1); PG8_BAR; PG8_SCHED;
            } else {
            PG8_LDB(B0, 0, 0); PG8_SCHED; PG8_LDA(At, 0, 0); PG8_STAGE(PG8_SA(1, 1), a1 + hstep, voffA);
            PG8_WAIT_L(8); PG8_BAR; PG8_WAIT_L(0); PG8_MMA(0, 0, At, B0); PG8_BAR; PG8_SCHED;
            PG8_LDB(B1, 0, 1); PG8_STAGE(PG8_SB(0, 0), b2, voffB);
            PG8_BAR; PG8_WAIT_L(0); PG8_MMA(0, 1, At, B1); PG8_BAR;
            PG8_LDA(At, 0, 1); PG8_STAGE(PG8_SA(0, 0), a2, voffA);
            PG8_BAR; PG8_WAIT_L(0); PG8_MMA(1, 0, At, B0); PG8_BAR; PG8_SCHED;
            PG8_STAGE(PG8_SB(0, 1), b2 + hstep, voffB);
            PG8_WAIT_V(6); PG8_BAR; PG8_MMA(1, 1, At, B1); PG8_BAR;
            PG8_LDB(B0, 1, 0); PG8_SCHED; PG8_LDA(At, 1, 0); PG8_STAGE(PG8_SA(0, 1), a2 + hstep, voffA);
            PG8_WAIT_L(8); PG8_BAR; PG8_WAIT_L(0); PG8_MMA(0, 0, At, B0); PG8_BAR; PG8_SCHED;
            PG8_LDB(B1, 1, 1); PG8_STAGE(PG8_SB(1, 0), b3, voffB);
            PG8_BAR; PG8_WAIT_L(0); PG8_MMA(0, 1, At, B1); PG8_BAR;
            PG8_LDA(At, 1, 1); PG8_STAGE(PG8_SA(1, 0), a3, voffA);
            PG8_BAR; PG8_WAIT_L(0); PG8_MMA(1, 0, At, B0); PG8_BAR; PG8_SCHED;
            PG8_STAGE(PG8_SB(1, 1), b3 + hstep, voffB);
            PG8_WAIT_V(6); PG8_BAR; PG8_MMA(1, 1, At, B1); PG8_BAR;
            }
        }
        if constexpr (ALIGN_EPI) { if (wr == 0) PG8_BAR; }
        if constexpr (!Epi::AFTER_DRAIN) { E(acc, cur, wr, wc, fr, fq); S.done(cur); }
        if (!has_next) break;
#pragma unroll
        for (int a = 0; a < 2; ++a)
#pragma unroll
            for (int b = 0; b < 2; ++b)
#pragma unroll
                for (int m = 0; m < 4; ++m)
#pragma unroll
                    for (int n = 0; n < 2; ++n) acc[a][b][m][n] = (f32x4){0.f, 0.f, 0.f, 0.f};
        cur = nxt; cA = nA; cB = nB; ++ui;
        if constexpr (ALIGN_EPI) { if (wr == 1) PG8_BAR; }
    }
    PG8_WAIT_V(0);
    if constexpr (!ALIGN_EPI) { if (wr == 0) PG8_BAR; }
    PG8_BAR;
    if constexpr (Epi::AFTER_DRAIN) { E.fused(acc, cur, wr, wc, fr, fq, lds, wid, lane); S.done(cur); }
#undef PG8_SA
#undef PG8_SB
#undef PG8_STAGE
#undef PG8_LDA
#undef PG8_LDB
#undef PG8_MMA
#undef PG8_WAIT_V
#undef PG8_WAIT_L
#undef PG8_BAR
#undef PG8_SCHED
}
}
namespace pg8 {
#define PG8_LOG2E 1.4426950408889634f
__device__ __forceinline__ float fast_sigmoid(float x) { return __builtin_amdgcn_rcpf(1.0f + __builtin_amdgcn_exp2f(-x * PG8_LOG2E)); }
__device__ __forceinline__ float fast_silu(float x) { return x * fast_sigmoid(x); }
struct EpiU {
    static constexpr bool PERM = true, AFTER_DRAIN = false;
    bf16_t* O; int ldc; PG8_LAS const float* lb; float qscale; int probe;
    long tab_off;
    template <int CTRL> static __device__ __forceinline__ float dmax(float v) { return fmaxf(v, __builtin_bit_cast(float, __builtin_amdgcn_update_dpp(0, __builtin_bit_cast(int, v), CTRL, 0xf, 0xf, true))); }
    __device__ __forceinline__ void operator()(const f32x4 (&acc)[2][2][4][2], const Unit& u, int wr, int wc, int fr, int fq) const {
        const int row0 = u.pm * BM + wr * 64 + fr; const int colt = u.pn * BM; const int col0 = colt + wc * 32 + 8 * fq;
        const int kind = (probe == 2) ? 2 : (u.pn >> 1);
        f32x4 lbv[2][2];
        if (kind == 1) {
#pragma unroll
            for (int bj = 0; bj < 2; ++bj)
#pragma unroll
                for (int n = 0; n < 2; ++n) lbv[bj][n] = *(PG8_LAS const f32x4*)(lb + (col0 - 512) + bj * HALF + 4 * n);
        }
#pragma unroll
        for (int ai = 0; ai < 2; ++ai) { float rs[2][4];
#pragma unroll
            for (int m = 0; m < 4; ++m) { bf16_t* rowp = O + (size_t)(row0 + ai * HALF + m * 16) * ldc + col0;
#pragma unroll
                for (int bj = 0; bj < 2; ++bj) { f32x4 v0 = acc[ai][bj][m][0], v1 = acc[ai][bj][m][1];
                    if (kind == 0 || kind == 3) {
#pragma unroll
                        for (int c = 0; c < 4; ++c) { v0[c] = fast_silu(v0[c]); v1[c] = fast_silu(v1[c]); }
                    } else if (kind == 1) {
#pragma unroll
                        for (int c = 0; c < 4; ++c) { const float l0 = lbv[bj][0][c], l1 = lbv[bj][1][c];
                            v0[c] = __builtin_amdgcn_logf(l0 + (1.f - l0) * fast_sigmoid(v0[c]));
                            v1[c] = __builtin_amdgcn_logf(l1 + (1.f - l1) * fast_sigmoid(v1[c])); }
                    } else if (kind == 4) { v0 = v0 * qscale; v1 = v1 * qscale; }
                    u32x4 w; w.x = cvt_pk_bf16(v0[0], v0[1]); w.y = cvt_pk_bf16(v0[2], v0[3]); w.z = cvt_pk_bf16(v1[0], v1[1]); w.w = cvt_pk_bf16(v1[2], v1[3]);
                    if (probe != 1) *(u32x4*)(rowp + bj * HALF) = w; else asm volatile("" :: "v"(w));
                    if (kind == 4 || kind == 5) { float ss = 0.f;
#pragma unroll
                        for (int e = 0; e < 4; ++e) { const unsigned ww = e == 0 ? w.x : (e == 1 ? w.y : (e == 2 ? w.z : w.w)); const float a0 = __builtin_bit_cast(float, ww << 16), a1 = __builtin_bit_cast(float, ww & 0xffff0000u); ss += a0 * a0 + a1 * a1; }
                        rs[bj][m] = ss; } } }
            if (kind == 4 || kind == 5) {
                float t_[2][4];
#pragma unroll
                for (int bj = 0; bj < 2; ++bj)
#pragma unroll
                    for (int m = 0; m < 4; ++m) t_[bj][m] = __builtin_bit_cast(float, __builtin_amdgcn_ds_bpermute(((fq * 16 + fr) ^ 16) << 2, __builtin_bit_cast(int, rs[bj][m])));
#pragma unroll
                for (int bj = 0; bj < 2; ++bj)
#pragma unroll
                    for (int m = 0; m < 4; ++m) rs[bj][m] += t_[bj][m];
#pragma unroll
                for (int bj = 0; bj < 2; ++bj)
#pragma unroll
                    for (int m = 0; m < 4; ++m) t_[bj][m] = __builtin_bit_cast(float, __builtin_amdgcn_ds_bpermute(((fq * 16 + fr) ^ 32) << 2, __builtin_bit_cast(int, rs[bj][m])));
#pragma unroll
                for (int bj = 0; bj < 2; ++bj) { float mx = 0.f;
#pragma unroll
                    for (int m = 0; m < 4; ++m) mx = fmaxf(mx, rs[bj][m] + t_[bj][m]);
                    mx = dmax<0xB1>(mx); mx = dmax<0x4E>(mx); mx = dmax<0x141>(mx); mx = dmax<0x140>(mx);
                    if ((fr | fq) == 0) { unsigned* ktab = (unsigned*)((char*)O + tab_off); unsigned* qtab = ktab + 256 * 2 * 32; const int bh = (u.pm >> 3) * 8 + (u.pn & 1) * 4 + 2 * bj + (wc >> 1), hf = wc & 1;
                        if (kind == 5) __hip_atomic_fetch_max(ktab + (bh * 2 + hf) * 32 + (u.pm & 7) * 4 + ai * 2 + wr, __builtin_bit_cast(unsigned, mx), __ATOMIC_RELAXED, __HIP_MEMORY_SCOPE_AGENT);
                        else __hip_atomic_fetch_max(qtab + (bh * 2 + hf) * 8 + (u.pm & 7), __builtin_bit_cast(unsigned, mx), __ATOMIC_RELAXED, __HIP_MEMORY_SCOPE_AGENT); } } } }
    }
};
struct EpiD {
    static constexpr bool PERM = true, AFTER_DRAIN = false;
    bf16_t* O; int ldc;
    __device__ __forceinline__ void operator()(const f32x4 (&acc)[2][2][4][2], const Unit& u, int wr, int wc, int fr, int fq) const {
        const int row0 = u.pm * BM + wr * 64 + fr; const int col0 = u.pn * BM + wc * 32 + 8 * fq;
#pragma unroll
        for (int ai = 0; ai < 2; ++ai)
#pragma unroll
            for (int m = 0; m < 4; ++m) { bf16_t* rowp = O + (size_t)(row0 + ai * HALF + m * 16) * ldc + col0;
#pragma unroll
                for (int bj = 0; bj < 2; ++bj) { const f32x4 v0 = acc[ai][bj][m][0], v1 = acc[ai][bj][m][1];
                    u32x4 w; w.x = cvt_pk_bf16(v0[0], v0[1]); w.y = cvt_pk_bf16(v0[2], v0[3]); w.z = cvt_pk_bf16(v1[0], v1[1]); w.w = cvt_pk_bf16(v1[2], v1[3]);
                    *(u32x4*)(rowp + bj * HALF) = w; } }
    }
};
struct EpiH1 {
    static constexpr bool PERM = true, AFTER_DRAIN = false;
    const float* gain0; bf16_t* O; int ldc; long xn_off, rms_off;
    __device__ __forceinline__ void operator()(const f32x4 (&acc)[2][2][4][2], const Unit& u, int wr, int wc, int fr, int fq) const {
        const int row0 = u.pm * BM + wr * 64 + fr; const int col0 = u.pn * BM + wc * 32 + 8 * fq;
        const bf16_t* XNp = (const bf16_t*)((const char*)O + xn_off); const float* rms0 = (const float*)((const char*)O + rms_off);
        u32x4 xv[2][4][2]; float rm[2][4];
#pragma unroll
        for (int ai = 0; ai < 2; ++ai)
#pragma unroll
            for (int m = 0; m < 4; ++m) { const int row = row0 + ai * HALF + m * 16; rm[ai][m] = rms0[row];
#pragma unroll
                for (int bj = 0; bj < 2; ++bj) xv[ai][m][bj] = *(const u32x4*)(XNp + (size_t)row * ldc + col0 + bj * HALF); }
#pragma unroll
        for (int ai = 0; ai < 2; ++ai) {
#pragma unroll
            for (int m = 0; m < 4; ++m) { bf16_t* rowp = O + (size_t)(row0 + ai * HALF + m * 16) * ldc + col0; const float r_ = rm[ai][m];
#pragma unroll
                for (int bj = 0; bj < 2; ++bj) { const u32x4 xw = xv[ai][m][bj];
                    const f32x4 x0 = {__builtin_bit_cast(float, xw.x << 16), __builtin_bit_cast(float, xw.x & 0xffff0000u), __builtin_bit_cast(float, xw.y << 16), __builtin_bit_cast(float, xw.y & 0xffff0000u)};
                    const f32x4 x1 = {__builtin_bit_cast(float, xw.z << 16), __builtin_bit_cast(float, xw.z & 0xffff0000u), __builtin_bit_cast(float, xw.w << 16), __builtin_bit_cast(float, xw.w & 0xffff0000u)};
                    const f32x4 v0 = acc[ai][bj][m][0] + x0 * r_, v1 = acc[ai][bj][m][1] + x1 * r_;
                    u32x4 w; w.x = cvt_pk_bf16(v0[0], v0[1]); w.y = cvt_pk_bf16(v0[2], v0[3]); w.z = cvt_pk_bf16(v1[0], v1[1]); w.w = cvt_pk_bf16(v1[2], v1[3]);
                    *(u32x4*)(rowp + bj * HALF) = w; } }
            asm volatile("" ::: "memory"); }
    }
};
struct EpiRes {
    static constexpr bool PERM = false, AFTER_DRAIN = false;
    const float* base; float* out; int ldc;
    __device__ __forceinline__ void operator()(const f32x4 (&acc)[2][2][4][2], const Unit& u, int wr, int wc, int fr, int fq) const {
        const int col0 = u.pn * BM + wc * 32 + 4 * fq;
#pragma unroll
        for (int ai = 0; ai < 2; ++ai)
#pragma unroll
            for (int m = 0; m < 4; ++m) { const size_t off = (size_t)(u.pm * BM + ai * HALF + wr * 64 + m * 16 + fr) * ldc + col0;
#pragma unroll
                for (int bj = 0; bj < 2; ++bj)
#pragma unroll
                    for (int n = 0; n < 2; ++n) { const f32x4 bs = *(const f32x4*)(base + off + bj * HALF + n * 16); *(f32x4*)(out + off + bj * HALF + n * 16) = bs + acc[ai][bj][m][n]; }
                if (m & 1) asm volatile("" ::: "memory"); }
    }
};
struct MUnit { int pm, pn, e, e2, hc, slot, half; };
__host__ __device__ __forceinline__ bool moe_deal(int i, int c, int G, int NU, int& g, int& half, bool quarter = false) {
    const int full = NU / G, rem = NU - full * G;
    if (i < full) { g = i * G + c; half = -1; return true; }
    if (i > full || rem == 0) return false;
    if (quarter && 4 * rem <= G) { if (c >= 4 * rem) return false; g = full * G + (c >> 2); half = 4 + (c & 3); return true; }
    if (2 * rem <= G) { if (c >= 2 * rem) return false; g = full * G + (c >> 1); half = c & 1; return true; }
    if (c >= rem) return false; g = full * G + c; half = -1; return true;
}
struct MGemm { const bf16_t* A; const bf16_t* Bt; int K; int KB; int brows; };
template <int SHIFT> struct MoeOrderP {
    PG8_LAS const int* tb;
    int G, c;
    __device__ __forceinline__ bool next(int i, MUnit& u) const {
        const int NT = __builtin_amdgcn_readfirstlane(tb[24]); int g, half; if (!moe_deal(i, c, G, NT << SHIFT, g, half, SHIFT == 2)) return false;
        const int rt = g >> SHIFT; const int bk = __builtin_amdgcn_readfirstlane(tb[64 + i]);
        const int grp = bk / 6, p = bk - grp * 6; const int a = p < 3 ? 0 : (p < 5 ? 1 : 2), b2 = p < 3 ? p + 1 : (p < 5 ? p - 1 : 3);
        const int elo = grp * 4 + a, ehi = grp * 4 + b2;
        if (SHIFT == 3) { const int pn8 = g & 7; u.e = (pn8 < 4) ? elo : ehi; u.e2 = u.e; u.pn = pn8 & 3; u.hc = (pn8 >> 2) * 512; }
        else { u.e = elo; u.e2 = ehi; u.pn = g & 3; u.hc = 0; }
        u.pm = rt; u.slot = i; u.half = half; return true;
    }
    __device__ __forceinline__ void a_ready(const MUnit&) const {}
    __device__ __forceinline__ void done(const MUnit&) const {}
};
struct EpiSwiglu {
    static constexpr bool PERM = true, AFTER_DRAIN = false;
    bf16_t* H; PG8_LAS const int* tab;
    __device__ __forceinline__ void operator()(const f32x4 (&acc)[2][2][4][2], const MUnit& u, int wr, int wc, int fr, int fq) const {
        const int row0 = u.pm * BM + wr * 64 + fr; const int col0 = u.hc + u.pn * HALF + wc * 32 + 8 * fq;
#pragma unroll
        for (int ai = 0; ai < 2; ++ai) { if (u.half >= 0 && u.half != ai) continue;
#pragma unroll
            for (int m = 0; m < 4; ++m) { bf16_t* rowp = H + (size_t)(row0 + ai * HALF + m * 16) * 1024 + col0; const int rl = ai * HALF + wr * 64 + m * 16 + fr;
                const float rs = __builtin_bit_cast(float, tab[u.slot * 512 + 256 + rl]); const float w = __builtin_bit_cast(float, (unsigned)tab[u.slot * 512 + rl] & 0xffff0000u);
                f32x4 g0 = acc[ai][0][m][0] * rs, g1 = acc[ai][0][m][1] * rs; const f32x4 u0 = acc[ai][1][m][0] * (rs * w), u1 = acc[ai][1][m][1] * (rs * w);
#pragma unroll
                for (int c = 0; c < 4; ++c) { g0[c] = fast_silu(g0[c]) * u0[c]; g1[c] = fast_silu(g1[c]) * u1[c]; }
                u32x4 wv; wv.x = cvt_pk_bf16(g0[0], g0[1]); wv.y = cvt_pk_bf16(g0[2], g0[3]); wv.z = cvt_pk_bf16(g1[0], g1[1]); wv.w = cvt_pk_bf16(g1[2], g1[3]);
                *(u32x4*)rowp = wv; } }
    }
};
struct EpiDown {
    static constexpr bool PERM = true, AFTER_DRAIN = false;
    bf16_t* Y; PG8_LAS const int* tab;
    __device__ __forceinline__ void operator()(const f32x4 (&acc)[2][2][4][2], const MUnit& u, int wr, int wc, int fr, int fq) const {
        const int col0 = u.pn * BM + wc * 32 + 8 * fq;
#pragma unroll
        for (int ai = 0; ai < 2; ++ai) { if (u.half >= 0 && (u.half & 1) != ai) continue;
#pragma unroll
            for (int m = 0; m < 4; ++m) { const int rl = ai * HALF + wr * 64 + m * 16 + fr; const int t = tab[u.slot * 256 + rl];
                if (t >= 0) { bf16_t* rowp = Y + (size_t)t * 1024 + col0;
#pragma unroll
                    for (int bj = 0; bj < 2; ++bj) { if (u.half >= 4 && ((u.half >> 1) & 1) != bj) continue; const f32x4 v0 = acc[ai][bj][m][0], v1 = acc[ai][bj][m][1];
                        u32x4 o; o.x = cvt_pk_bf16(v0[0], v0[1]); o.y = cvt_pk_bf16(v0[2], v0[3]); o.z = cvt_pk_bf16(v1[0], v1[1]); o.w = cvt_pk_bf16(v1[2], v1[3]);
                        *(u32x4*)(rowp + bj * HALF) = o; } } } }
    }
};
template <class Epi, class Sched, bool GATHER, bool ALIGN_EPI, bool DUALB, int TSTRIDE = 512>
__device__ __forceinline__ void gemm_phase_moe(PG8_LAS unsigned char* lds, PG8_LAS const int* tok, const MGemm g, const Sched& S, const Epi& E) {
    const int tid = threadIdx.x, wid = __builtin_amdgcn_readfirstlane(tid >> 6), lane = tid & 63, wr = wid >> 2, wc = wid & 3, fr = lane & 15, fq = lane >> 4;
    const int K = g.K, KB = g.KB, nt = K / BK, nsw = KB / BK;
    unsigned voffB[2]; int RA[2]; unsigned colA[2];
#pragma unroll
    for (int i = 0; i < 2; ++i) { int R, C; stage_rc(tid * 16 + i * 8192, R, C); const int Rb = Epi::PERM ? ((R & ~31) + perm32(R & 31)) : R;
        RA[i] = R; colA[i] = (unsigned)C * 2u; voffB[i] = (unsigned)(Rb * KB + C) * 2u; }
    const size_t kstep = (size_t)(BK * 2);
    const size_t hstep = (size_t)HALF * KB * 2;
    const size_t tstep = (size_t)2 * HALF * K * 2;
    const unsigned ldsw = (unsigned)wid * 1024u;
    const int aoff = lds_byte(wr * 64 + fr, fq * 8), boff = lds_byte(wc * 32 + fr, fq * 8);
#define PG8_SA(b, h) (((b) * 2 + (h)) * HTB)
#define PG8_SB(b, h) ((4 + (b) * 2 + (h)) * HTB)
#define PG8_STAGE(bufoff, gbase, voff) do { _Pragma("unroll") for (int _i = 0; _i < 2; ++_i) \
        __builtin_amdgcn_global_load_lds((const unsigned*)((const char*)(gbase) + (voff)[_i]), (PG8_LAS unsigned*)(lds + (bufoff) + ldsw + _i * 8192), 16, 0, 0); } while (0)
#define PG8_LDA(dst, b, h) do { _Pragma("unroll") for (int m = 0; m < 4; ++m) _Pragma("unroll") for (int k = 0; k < 2; ++k) dst[m][k] = *(const PG8_LAS bf16x8*)(lds + PG8_SA(b, h) + aoff + m * 2048 + k * 1024); } while (0)
#define PG8_LDB(dst, b, h) do { _Pragma("unroll") for (int n = 0; n < 2; ++n) _Pragma("unroll") for (int k = 0; k < 2; ++k) dst[n][k] = *(const PG8_LAS bf16x8*)(lds + PG8_SB(b, h) + boff + n * 2048 + k * 1024); } while (0)
#define PG8_MMA(ai, bj, At, Bt) do { __builtin_amdgcn_s_setprio(1); _Pragma("unroll") for (int m = 0; m < 4; ++m) _Pragma("unroll") for (int n = 0; n < 2; ++n) _Pragma("unroll") for (int k = 0; k < 2; ++k) \
        acc[ai][bj][m][n] = __builtin_amdgcn_mfma_f32_16x16x32_bf16(Bt[n][k], At[m][k], acc[ai][bj][m][n], 0, 0, 0); __builtin_amdgcn_s_setprio(0); } while (0)
#define PG8_WAIT_V(n) asm volatile("s_waitcnt vmcnt(" #n ")" ::: "memory")
#define PG8_WAIT_L(n) asm volatile("s_waitcnt lgkmcnt(" #n ")" ::: "memory")
#define PG8_BAR __builtin_amdgcn_s_barrier()
#define PG8_SCHED __builtin_amdgcn_sched_barrier(0)
#define PG8_AOFFS(dst, U) do { _Pragma("unroll") for (int _h = 0; _h < 2; ++_h) _Pragma("unroll") for (int _i = 0; _i < 2; ++_i) { \
        if constexpr (GATHER) dst[_h][_i] = ((unsigned)tok[(U).slot * TSTRIDE + _h * HALF + RA[_i]] & 0xffffu) * (unsigned)(K * 2) + colA[_i]; \
        else dst[_h][_i] = (unsigned)((_h * HALF + RA[_i]) * K) * 2u + colA[_i]; } } while (0)
    MUnit cur, nxt; int ui = 0;
    if (!S.next(0, cur)) return;
    f32x4 acc[2][2][4][2];
#pragma unroll
    for (int a = 0; a < 2; ++a)
#pragma unroll
        for (int b = 0; b < 2; ++b)
#pragma unroll
            for (int m = 0; m < 4; ++m)
#pragma unroll
                for (int n = 0; n < 2; ++n) acc[a][b][m][n] = (f32x4){0.f, 0.f, 0.f, 0.f};
    bf16x8 At[4][2], B0[2][2], B1[2][2];
    unsigned cv[2][2], nv[2][2];
    PG8_AOFFS(cv, cur);
    const char* cA = GATHER ? (const char*)g.A : (const char*)g.A + (size_t)cur.pm * tstep;
    const char* cB = (const char*)g.Bt + ((size_t)cur.e * g.brows + (size_t)cur.pn * BM) * KB * 2;
    const char* cB2 = (const char*)g.Bt + ((size_t)cur.e2 * g.brows + (size_t)cur.pn * BM) * KB * 2 - (size_t)nsw * kstep;
    S.a_ready(cur);
    PG8_STAGE(PG8_SB(0, 0), cB, voffB); PG8_STAGE(PG8_SB(0, 1), cB + hstep, voffB); PG8_STAGE(PG8_SA(0, 0), cA, cv[0]); PG8_STAGE(PG8_SA(0, 1), cA, cv[1]);
    if (wr == 1) PG8_BAR;
    PG8_WAIT_V(2); PG8_BAR;
    PG8_STAGE(PG8_SB(1, 0), cB + kstep, voffB); PG8_STAGE(PG8_SA(1, 0), cA + kstep, cv[0]); PG8_STAGE(PG8_SB(1, 1), cB + hstep + kstep, voffB);
    PG8_WAIT_V(6); PG8_BAR;
    for (;;) {
        const bool has_next = S.next(ui + 1, nxt);
        const bool do0 = cur.half < 0 || (cur.half & 1) == 0, do1 = cur.half < 0 || (cur.half & 1) == 1;
        const bool db0 = cur.half < 4 || ((cur.half >> 1) & 1) == 0, db1 = cur.half < 4 || ((cur.half >> 1) & 1) == 1;
        const char* nA = cA; const char* nB = cB; const char* nB2 = cB2;
        if (has_next) { PG8_AOFFS(nv, nxt); nA = GATHER ? (const char*)g.A : (const char*)g.A + (size_t)nxt.pm * tstep; nB = (const char*)g.Bt + ((size_t)nxt.e * g.brows + (size_t)nxt.pn * BM) * KB * 2; nB2 = (const char*)g.Bt + ((size_t)nxt.e2 * g.brows + (size_t)nxt.pn * BM) * KB * 2 - (size_t)nsw * kstep; }
        else {
#pragma unroll
            for (int h = 0; h < 2; ++h)
#pragma unroll
                for (int i = 0; i < 2; ++i) nv[h][i] = cv[h][i]; }
        for (int t = 0; t < nt; t += 2) {
            const bool last = (t == nt - 2);
            const char* a1 = cA + (size_t)(t + 1) * kstep;
            const char* a2 = last ? nA : cA + (size_t)(t + 2) * kstep; const char* b2 = last ? nB : ((DUALB && t + 2 >= nsw) ? cB2 : cB) + (size_t)(t + 2) * kstep;
            const char* a3 = a2 + kstep; const char* b3 = b2 + kstep;
            unsigned v2[2][2];
#pragma unroll
            for (int h = 0; h < 2; ++h)
#pragma unroll
                for (int i = 0; i < 2; ++i) v2[h][i] = last ? nv[h][i] : cv[h][i];
            if (last && has_next) S.a_ready(nxt);
            PG8_LDB(B0, 0, 0); PG8_LDB(B1, 0, 1); PG8_SCHED; PG8_LDA(At, 0, 0); PG8_STAGE(PG8_SA(1, 1), a1, cv[1]);
            PG8_WAIT_V(8); PG8_WAIT_L(0); PG8_BAR; if (do0) { if (db0) PG8_MMA(0, 0, At, B0); if (db1) PG8_MMA(0, 1, At, B1); } PG8_BAR; PG8_SCHED;
            PG8_LDA(At, 0, 1); PG8_STAGE(PG8_SB(0, 0), b2, voffB); PG8_STAGE(PG8_SB(0, 1), b2 + hstep, voffB); PG8_STAGE(PG8_SA(0, 0), a2, v2[0]);
            PG8_WAIT_V(8); PG8_WAIT_L(0); PG8_BAR; if (do1) { if (db0) PG8_MMA(1, 0, At, B0); if (db1) PG8_MMA(1, 1, At, B1); } PG8_BAR; PG8_SCHED;
            PG8_LDB(B0, 1, 0); PG8_LDB(B1, 1, 1); PG8_SCHED; PG8_LDA(At, 1, 0); PG8_STAGE(PG8_SA(0, 1), a2, v2[1]);
            PG8_WAIT_V(8); PG8_WAIT_L(0); PG8_BAR; if (do0) { if (db0) PG8_MMA(0, 0, At, B0); if (db1) PG8_MMA(0, 1, At, B1); } PG8_BAR; PG8_SCHED;
            PG8_LDA(At, 1, 1); PG8_STAGE(PG8_SB(1, 0), b3, voffB); PG8_STAGE(PG8_SB(1, 1), b3 + hstep, voffB); PG8_STAGE(PG8_SA(1, 0), a3, v2[0]);
            PG8_WAIT_V(8); PG8_WAIT_L(0); PG8_BAR; if (do1) { if (db0) PG8_MMA(1, 0, At, B0); if (db1) PG8_MMA(1, 1, At, B1); } PG8_BAR; PG8_SCHED;
        }
        if constexpr (ALIGN_EPI) { if (wr == 0) PG8_BAR; }
        E(acc, cur, wr, wc, fr, fq); S.done(cur);
        if (!has_next) break;
#pragma unroll
        for (int a = 0; a < 2; ++a)
#pragma unroll
            for (int b = 0; b < 2; ++b)
#pragma unroll
                for (int m = 0; m < 4; ++m)
#pragma unroll
                    for (int n = 0; n < 2; ++n) acc[a][b][m][n] = (f32x4){0.f, 0.f, 0.f, 0.f};
        cur = nxt; cA = nA; cB = nB; cB2 = nB2; ++ui;
#pragma unroll
        for (int h = 0; h < 2; ++h)
#pragma unroll
            for (int i = 0; i < 2; ++i) cv[h][i] = nv[h][i];
        if constexpr (ALIGN_EPI) { if (wr == 1) PG8_BAR; }
    }
    PG8_WAIT_V(0);
    if constexpr (!ALIGN_EPI) { if (wr == 0) PG8_BAR; }
    PG8_BAR;
#undef PG8_AOFFS
#undef PG8_SA
#undef PG8_SB
#undef PG8_STAGE
#undef PG8_LDA
#undef PG8_LDB
#undef PG8_MMA
#undef PG8_WAIT_V
#undef PG8_WAIT_L
#undef PG8_BAR
#undef PG8_SCHED
}
}
constexpr int NWAVES = 8;
constexpr int T_ = 65536, DM_ = 1024, NB_ = 32, SEQ_ = 2048, INC_ = 3592, UC_ = 3584;
constexpr int NE_ = 16, EH_ = 512;
constexpr int RMAX_ = 2 * T_ + NE_ * 256;
constexpr int NBK_ = 24, RMAXP_ = T_ + NBK_ * 256;
constexpr float EPS_ = 1e-6f;
constexpr float QSCALE_ = 0.125f * 1.4426950408889634f;
constexpr size_t MiB = 1u << 20;
constexpr size_t WS_CTL = 0, CTL_ZERO_BYTES = 352 * 1024;
constexpr size_t WS_LB = 1 * MiB, WS_WI = 2 * MiB, WS_WO = 9 * MiB, WS_WGU = 11 * MiB, WS_WD = 43 * MiB, WS_FLG = 59 * MiB;
constexpr size_t WS_RE = 61 * MiB, WS_RW = 62 * MiB, WS_ENTRY = 63 * MiB, WS_SROW = 67 * MiB, WS_SW = 68 * MiB, WS_STOK = 69 * MiB, WS_TILEE = 70 * MiB, WS_CUM = 71 * MiB  ;
constexpr size_t WS_RSTD = 73 * MiB;
constexpr size_t WS_XN = 74 * MiB;
constexpr size_t WS_U = 202 * MiB;
constexpr size_t WS_HB = 202 * MiB;
constexpr size_t WS_Y = 346 * MiB;
constexpr size_t WS_D = 650 * MiB;
constexpr size_t WS_ORAW = 650 * MiB;
constexpr size_t WS_MIX = 778 * MiB;
constexpr size_t WS_RMS0 = WS_RE;
constexpr size_t WS_END = 906 * MiB;
constexpr int CW_TMO = 0, CW_CODE = 1;
constexpr int CW_CNT = 64;
constexpr int CW_CLAIM = 256;
constexpr int CW_KT = 65536, CW_QT = CW_KT + 256 * 2 * 32;
constexpr int CW_PLAN = 128;
constexpr int CW_BAR = 4096;
constexpr int RING_OFF = 0, RING_BYTES = 131072;
constexpr int TAB_OFF = RING_BYTES, TAB_BYTES = 24576;
constexpr int LDSCTL_OFF = TAB_OFF + TAB_BYTES, MISC_OFF = LDSCTL_OFF + 320;
constexpr int LDS_BYTES = LDSCTL_OFF + 1024;

#define GAS __attribute__((address_space(1)))
#define LAS __attribute__((address_space(3)))
typedef unsigned short bf16;
typedef unsigned v4u __attribute__((ext_vector_type(4)));
typedef unsigned v2u __attribute__((ext_vector_type(2)));
typedef float f32x4 __attribute__((ext_vector_type(4)));
typedef short bf16x8 __attribute__((ext_vector_type(8)));
typedef GAS unsigned gu32;
#define RLX_AGENT __ATOMIC_RELAXED, __HIP_MEMORY_SCOPE_AGENT
#define LDS_WAIT() asm volatile("s_waitcnt lgkmcnt(0)" ::: "memory")
#define VM_WAIT() asm volatile("s_waitcnt vmcnt(0)" ::: "memory")
__device__ __forceinline__ unsigned f2bf(float f) { unsigned u = __builtin_bit_cast(unsigned, f); return (u + 0x7fffu + ((u >> 16) & 1u)) >> 16; }
__device__ __forceinline__ unsigned pk2(float lo, float hi) { return f2bf(lo) | (f2bf(hi) << 16); }
__device__ __forceinline__ float bf2f(unsigned short b) { return __builtin_bit_cast(float, (unsigned)b << 16); }
__device__ __forceinline__ float bflo(unsigned w) { return __builtin_bit_cast(float, w << 16); }
__device__ __forceinline__ float bfhi(unsigned w) { return __builtin_bit_cast(float, w & 0xffff0000u); }

#define XB_TMO      128
#define XB_XCNT(j)  (256  + 64 * (j))
#define XB_XSUB(j)  (1280 + 64 * (j))
#define XB_XGEN(j)  (2304 + 64 * (j))
#define XB_TOP      3328
#define XB_TOPGEN   3392
#define XCD_BAR_WORDS 3456
#define XB_SPIN_CAP (1u << 18)

__device__ __forceinline__ unsigned xb_ld(unsigned* p)              { return __hip_atomic_load(p, __ATOMIC_RELAXED, __HIP_MEMORY_SCOPE_AGENT); }
__device__ __forceinline__ unsigned xb_add(unsigned* p, unsigned v) { return __hip_atomic_fetch_add(p, v, __ATOMIC_RELAXED, __HIP_MEMORY_SCOPE_AGENT); }
__device__ __forceinline__ unsigned xb_xcc_id() { return (unsigned)__builtin_amdgcn_s_getreg((3 << 11) | 20) & 0xFu; }
#define XB_SPIN(cond, bar) do { unsigned _sp = 0; while (cond) { __builtin_amdgcn_s_sleep(1); \
    if ((++_sp & 255u) == 0u) { if (xb_ld(&(bar)[XB_TMO])) break; if (_sp > XB_SPIN_CAP) { atomicAdd(&(bar)[XB_TMO], 1u); break; } } } } while (0)

struct XcdBarrier {
    unsigned* bar; unsigned x;
    volatile LAS unsigned* st;
};

__device__ __forceinline__ XcdBarrier xcd_barrier_post(unsigned* bar, volatile LAS unsigned* st) {
    XcdBarrier b; b.bar = bar; b.x = xb_xcc_id(); b.st = st;
    if (threadIdx.x == 0) (void)xb_add(&bar[XB_XCNT(b.x)], 1u);
    return b;
}
__device__ __forceinline__ void xcd_barrier_complete(unsigned* bar, unsigned x, unsigned& nloc, unsigned& nx) {
    const unsigned G = gridDim.x * gridDim.y * gridDim.z;
    unsigned sum, cnt, mine, sp = 0u;
    for (;;) {
        sum = 0u; cnt = 0u; mine = 0u;
#pragma unroll
        for (unsigned j = 0; j < 16; ++j) { const unsigned c = xb_ld(&bar[XB_XCNT(j)]); sum += c; cnt += (c > 0u) ? 1u : 0u; mine = (j == x) ? c : mine; }
        if (sum == G) break;
        __builtin_amdgcn_s_sleep(1);
        if ((++sp & 255u) == 0u) { if (xb_ld(&bar[XB_TMO])) break; if (sp > XB_SPIN_CAP) { atomicAdd(&bar[XB_TMO], 1u); break; } }
    }
    nloc = mine > 0u ? mine : 1u; nx = cnt > 0u ? cnt : 1u;
}

__device__ __forceinline__ void xcd_barrier(const XcdBarrier& b) {
    asm volatile("s_waitcnt vmcnt(0)" ::: "memory");
    __syncthreads();
    if (threadIdx.x == 0) {
        unsigned* bar = b.bar;
        __builtin_amdgcn_s_waitcnt(0);
        unsigned nloc = b.st[0], nx = b.st[1];
        if (nloc == 0u) { xcd_barrier_complete(bar, b.x, nloc, nx); b.st[0] = nloc; b.st[1] = nx; }
        const unsigned old = xb_add(&bar[XB_XSUB(b.x)], 1u);
        const unsigned gen = old / nloc;
        if (old + 1u == (gen + 1u) * nloc) {
            __builtin_amdgcn_fence(__ATOMIC_RELEASE, "agent");
            asm volatile("s_waitcnt vmcnt(0)" ::: "memory");
            const unsigned og = xb_add(&bar[XB_TOP], 1u);
            const unsigned tg = og / nx;
            if (og + 1u == (tg + 1u) * nx) xb_add(&bar[XB_TOPGEN], 1u);
            else XB_SPIN(xb_ld(&bar[XB_TOPGEN]) == tg, bar);
            __builtin_amdgcn_fence(__ATOMIC_ACQUIRE, "agent");
            xb_add(&bar[XB_XGEN(b.x)], 1u);
            asm volatile("s_waitcnt vmcnt(0)" ::: "memory");
        } else {
            XB_SPIN(xb_ld(&bar[XB_XGEN(b.x)]) == gen, bar);
            __builtin_amdgcn_fence(__ATOMIC_ACQUIRE, "agent");
            asm volatile("s_waitcnt vmcnt(0)" ::: "memory");
        }
    }
    __syncthreads();
}


struct Frame {
    LAS unsigned char* lds;
    volatile LAS unsigned* MISC;
    gu32* ctl;
    int tid, lane, wave;
    int vcu, G;
    const float* in[17]; float* out; unsigned char* ws;
};
template <int CTRL, int RM> __device__ __forceinline__ float dpp_add(float v) { return v + __builtin_bit_cast(float, __builtin_amdgcn_update_dpp(0, __builtin_bit_cast(int, v), CTRL, RM, 0xf, RM == 0xf)); }
__device__ __forceinline__ float wave_sum(float v) {
    v = dpp_add<0xB1, 0xf>(v); v = dpp_add<0x4E, 0xf>(v); v = dpp_add<0x141, 0xf>(v); v = dpp_add<0x140, 0xf>(v);
    v = dpp_add<0x142, 0xa>(v);
    v = dpp_add<0x143, 0xc>(v);
    return __builtin_bit_cast(float, __builtin_amdgcn_readlane(__builtin_bit_cast(int, v), 63));
}
template <bool SC = false> __device__ __forceinline__ void p0_transpose_block(const float* src, int pitch, bf16* dst, int Kdst, LAS float* scr, int lane, const float* ksc = nullptr) {
#pragma unroll 8
    for (int i = 0; i < 32; ++i) { const int kk = 2 * i + (lane >> 5); float v_ = src[(size_t)kk * pitch + (lane & 31)]; if constexpr (SC) v_ *= ksc[kk]; scr[kk * 33 + (lane & 31)] = v_; }
    LDS_WAIT(); asm volatile("" ::: "memory");
    const int c = lane & 7;
#pragma unroll
    for (int j = 0; j < 4; ++j) { const int n = (lane >> 3) + 8 * j; const LAS float* s = scr + (8 * c) * 33 + n;
        v4u o; o.x = pk2(s[0 * 33], s[1 * 33]); o.y = pk2(s[2 * 33], s[3 * 33]); o.z = pk2(s[4 * 33], s[5 * 33]); o.w = pk2(s[6 * 33], s[7 * 33]);
        *(GAS v4u*)(dst + (size_t)n * Kdst + 8 * c) = o; }
    LDS_WAIT(); asm volatile("" ::: "memory");
}
__device__ __forceinline__ void convert_items(Frame& F, int first, int count, int gw, int NGW) {
    LAS float* scr = (LAS float*)(F.lds + RING_OFF + F.wave * 16384);
    const float* w_in = F.in[2]; const float* w_out = F.in[7]; const float* w_gate = F.in[13]; const float* w_up = F.in[14]; const float* w_down = F.in[15];
    bf16* WI = (bf16*)(F.ws + WS_WI); bf16* WO = (bf16*)(F.ws + WS_WO); bf16* WGU = (bf16*)(F.ws + WS_WGU); bf16* WD = (bf16*)(F.ws + WS_WD);
    constexpr int I_WI = 16 * 112, I_WO = 16 * 32, I_WG = 16 * 256;
    for (int it = first + gw; it < first + count; it += NGW) {
        int r = it;
        if (r < I_WI) { const int kb = r / 112, nb = r % 112; p0_transpose_block<true>(w_in + (size_t)(64 * kb) * INC_ + 32 * nb, INC_, WI + (size_t)(32 * nb) * 1024 + 64 * kb, 1024, scr, F.lane, F.in[1] + 64 * kb); continue; }   r -= I_WI;
        if (r < I_WO) { const int kb = r / 32, nb = r % 32; p0_transpose_block(w_out + (size_t)(64 * kb) * 1024 + 32 * nb, 1024, WO + (size_t)(32 * nb) * 1024 + 64 * kb, 1024, scr, F.lane); continue; } r -= I_WO;
        if (r < 2 * I_WG) { const int up = r >= I_WG; if (up) r -= I_WG; const int e = r / 256, q = r % 256, kb = q / 16, nb = q % 16, n0 = 32 * nb;
            const int drow = (n0 >> 7) * 256 + (n0 & 127) + (up ? 128 : 0);
            p0_transpose_block<true>((up ? w_up : w_gate) + (size_t)e * 1024 * 512 + (size_t)(64 * kb) * 512 + n0, 512, WGU + ((size_t)e * 1024 + drow) * 1024 + 64 * kb, 1024, scr, F.lane, F.in[8] + 64 * kb); continue; }   r -= 2 * I_WG;
        { const int e = r / 256, q = r % 256, kb = q / 32, nb = q % 32;
            p0_transpose_block(w_down + (size_t)e * 512 * 1024 + (size_t)(64 * kb) * 1024 + 32 * nb, 1024, WD + ((size_t)e * 1024 + 32 * nb) * 512 + 64 * kb, 512, scr, F.lane); }
    }
}
constexpr int CONV_I_WI = 16 * 112, CONV_I_REST = 16 * 32 + 2 * 16 * 256 + 16 * 256;
__device__ __forceinline__ void p0_prologue(Frame& F) {
    const int gw = F.vcu * NWAVES + F.wave, NGW = F.G * NWAVES;
    const float* w_in = F.in[2];
    convert_items(F, 0, (F.G == 256 && (MK_OPT_MASK & 4)) ? CONV_I_WI : CONV_I_WI + CONV_I_REST, gw, NGW);
    { float* LB = (float*)(F.ws + WS_LB); const float* lg = F.in[3];
      for (int i = gw * 64 + F.lane; i < 512; i += NGW * 64) { const float a = lg[i], b = lg[512 + i]; LB[i] = 1.f / (1.f + expf(b - a)); } }
    const float* x = F.in[0]; const float* gain = F.in[1]; const float* fb = F.in[5];
    bf16* XN = (bf16*)(F.ws + WS_XN); float* FLG = (float*)(F.ws + WS_FLG);
    f32x4 gv[4]; f32x4 wfa[4][4], wfb[4][4];
#pragma unroll
    for (int j = 0; j < 4; ++j) { gv[j] = *(const GAS f32x4*)(gain + 256 * j + 4 * F.lane);
#pragma unroll
        for (int c = 0; c < 4; ++c) { const float* wp = w_in + (size_t)(256 * j + 4 * F.lane + c) * INC_ + 3584; wfa[j][c] = *(const GAS f32x4*)wp; wfb[j][c] = *(const GAS f32x4*)(wp + 4); } }
    const float fbv = fb[F.lane & 7];
    f32x4 nx[4];
#define P0_LOAD(mm) do { const GAS f32x4* xr_ = (const GAS f32x4*)(x + (size_t)(mm) * DM_) + F.lane; _Pragma("unroll") for (int j = 0; j < 4; ++j) nx[j] = xr_[64 * j]; } while (0)
    if (gw < T_) P0_LOAD(gw);
    for (int m = gw; m < T_; m += NGW) {
        f32x4 v[4]; float s = 0.f;
#pragma unroll
        for (int j = 0; j < 4; ++j) v[j] = nx[j];
        if (m + NGW < T_) P0_LOAD(m + NGW);
#pragma unroll
        for (int j = 0; j < 4; ++j) s += (v[j].x * v[j].x + v[j].y * v[j].y) + (v[j].z * v[j].z + v[j].w * v[j].w);
        const float rms_ = sqrtf(wave_sum(s) * (1.f / DM_) + EPS_); const float rstd = 1.f / rms_;
        if (F.lane == 0) ((float*)(F.ws + WS_RMS0))[m] = rms_;
        f32x4 pa = {0.f, 0.f, 0.f, 0.f}, pb = {0.f, 0.f, 0.f, 0.f};
        GAS unsigned long long* o8 = (GAS unsigned long long*)(XN + (size_t)m * DM_) + F.lane;
#pragma unroll
        for (int j = 0; j < 4; ++j) { v[j] = v[j] * rstd;
            o8[64 * j] = (unsigned long long)pk2(v[j].x, v[j].y) | ((unsigned long long)pk2(v[j].z, v[j].w) << 32);
            v[j] = v[j] * gv[j];
#pragma unroll
            for (int c = 0; c < 4; ++c) { pa += wfa[j][c] * v[j][c]; pb += wfb[j][c] * v[j][c]; } }
        float zz;
        { const float z[8] = {pa.x, pa.y, pa.z, pa.w, pb.x, pb.y, pb.z, pb.w}; const bool b0 = F.lane & 1, b1 = F.lane & 2, b2 = F.lane & 4;
          float y[4], w2[2];
#pragma unroll
          for (int k = 0; k < 4; ++k) { const float keep = b0 ? z[2 * k + 1] : z[2 * k], send = b0 ? z[2 * k] : z[2 * k + 1];
              y[k] = keep + __builtin_bit_cast(float, __builtin_amdgcn_update_dpp(0, __builtin_bit_cast(int, send), 0xB1, 0xf, 0xf, true)); }
#pragma unroll
          for (int j = 0; j < 2; ++j) { const float keep = b1 ? y[2 * j + 1] : y[2 * j], send = b1 ? y[2 * j] : y[2 * j + 1];
              w2[j] = keep + __builtin_bit_cast(float, __builtin_amdgcn_update_dpp(0, __builtin_bit_cast(int, send), 0x4E, 0xf, 0xf, true)); }
          { const float keep = b2 ? w2[1] : w2[0], send = b2 ? w2[0] : w2[1];
            const int h_ = __builtin_amdgcn_update_dpp(0, __builtin_bit_cast(int, send), 0x141, 0xf, 0xf, true);
            zz = keep + __builtin_bit_cast(float, __builtin_amdgcn_update_dpp(0, h_, 0x1B, 0xf, 0xf, true)); }
          { const int m_ = __builtin_amdgcn_update_dpp(0, __builtin_bit_cast(int, zz), 0x140, 0xf, 0xf, true);
            zz += __builtin_bit_cast(float, __builtin_amdgcn_update_dpp(0, m_, 0x141, 0xf, 0xf, true)); }
          zz += __builtin_bit_cast(float, __builtin_amdgcn_ds_bpermute((F.lane ^ 16) << 2, __builtin_bit_cast(int, zz)));
          zz += __builtin_bit_cast(float, __builtin_amdgcn_ds_bpermute((F.lane ^ 32) << 2, __builtin_bit_cast(int, zz))); }
        zz += fbv;
        const float ls = fminf(zz, 0.f) - log1pf(expf(-fabsf(zz)));
        if (F.lane < 8) FLG[(size_t)m * 8 + F.lane] = ls;
    }
}
template <bool DRY  > __device__ __forceinline__ void p4_router(Frame& F) {
    const float* wg = F.in[9]; const float* bg = F.in[10]; const float* we = F.in[11]; const float* be = F.in[12]; const float* gain = F.in[8];
    LAS unsigned char* BIMG = F.lds + RING_OFF;
    LAS float* LGW = (LAS float*)(F.lds + TAB_OFF) + F.wave * 640;
    LAS int* cntL = (LAS int*)(F.lds + TAB_OFF + 8 * 640 * 4);
    LAS int* baseL = cntL + 32;
    LAS int* asg = cntL + 64;
    const int fr = F.lane & 15, g4 = F.lane >> 4;
#pragma unroll 4
    for (int f = F.tid; f < 32 * 2 * 64; f += NWAVES * 64) { const int ks = f >> 7, ct = (f >> 6) & 1, ln = f & 63; const int col = 16 * ct + (ln & 15), k0 = 32 * ks + 8 * (ln >> 4);
        v4u h, l;
#pragma unroll
        for (int jp = 0; jp < 4; ++jp) { float w2[2];
#pragma unroll
            for (int e = 0; e < 2; ++e) { const int k = k0 + 2 * jp + e;
                const float* wp_ = (col < 4) ? wg + (size_t)k * 4 + col : we + (size_t)k * 16 + ((col < 20) ? col - 4 : 0); const float wv_ = *wp_ * gain[k]; w2[e] = (col < 20) ? wv_ : 0.f; }
            const unsigned h0 = f2bf(w2[0]), h1 = f2bf(w2[1]); h[jp] = h0 | (h1 << 16);
            l[jp] = f2bf(w2[0] - bf2f((unsigned short)h0)) | (f2bf(w2[1] - bf2f((unsigned short)h1)) << 16); }
        *(LAS v4u*)(BIMG + (size_t)f * 16) = h; *(LAS v4u*)(BIMG + 65536 + (size_t)f * 16) = l; }
    if (F.tid < 32) cntL[F.tid] = 0;
    __syncthreads();
    const bf16* H1 = (const bf16*)(F.ws + WS_D); float* RSTD = (float*)(F.ws + WS_RSTD); float* RW = (float*)(F.ws + WS_RW);
    float bgv[4], bev[16];
#pragma unroll
    for (int i = 0; i < 4; ++i) bgv[i] = bg[i];
#pragma unroll
    for (int i = 0; i < 16; ++i) bev[i] = be[i];
    for (int blk = F.vcu; blk < T_ / 256; blk += F.G) {
        bf16x8 A0[16], A1[16];
#define P4_LDA(dst, tile, half) do { const GAS bf16x8* p_ = (const GAS bf16x8*)(H1 + (size_t)(blk * 256 + F.wave * 32 + (tile) * 16 + fr) * DM_ + (half) * 512 + 8 * g4); \
        _Pragma("unroll") for (int q_ = 0; q_ < 16; ++q_) dst[q_] = p_[4 * q_]; } while (0)
#define P4_MMA(src, half) do { _Pragma("unroll") for (int q_ = 0; q_ < 16; ++q_) { const int ks_ = (half) * 16 + q_; \
            const bf16x8 bh0 = *(const LAS bf16x8*)(BIMG + (ks_ * 2 + 0) * 1024 + F.lane * 16), bh1 = *(const LAS bf16x8*)(BIMG + (ks_ * 2 + 1) * 1024 + F.lane * 16); \
            const bf16x8 bl0 = *(const LAS bf16x8*)(BIMG + 65536 + (ks_ * 2 + 0) * 1024 + F.lane * 16), bl1 = *(const LAS bf16x8*)(BIMG + 65536 + (ks_ * 2 + 1) * 1024 + F.lane * 16); \
            acc0 = __builtin_amdgcn_mfma_f32_16x16x32_bf16(src[q_], bh0, acc0, 0, 0, 0); acc1 = __builtin_amdgcn_mfma_f32_16x16x32_bf16(src[q_], bh1, acc1, 0, 0, 0); \
            acc0 = __builtin_amdgcn_mfma_f32_16x16x32_bf16(src[q_], bl0, acc0, 0, 0, 0); acc1 = __builtin_amdgcn_mfma_f32_16x16x32_bf16(src[q_], bl1, acc1, 0, 0, 0); \
            accs = __builtin_amdgcn_mfma_f32_16x16x32_bf16(src[q_], src[q_], accs, 0, 0, 0); } } while (0)
        P4_LDA(A0, 0, 0); P4_LDA(A1, 0, 1);
#pragma unroll
        for (int tile = 0; tile < 2; ++tile) {
            f32x4 acc0 = {0.f, 0.f, 0.f, 0.f}, acc1 = {0.f, 0.f, 0.f, 0.f}, accs = {0.f, 0.f, 0.f, 0.f};
            P4_MMA(A0, 0); if (tile == 0) P4_LDA(A0, 1, 0);
            P4_MMA(A1, 1); if (tile == 0) P4_LDA(A1, 1, 1);
#pragma unroll
            for (int rg = 0; rg < 4; ++rg) { LGW[(4 * g4 + rg) * 33 + fr] = acc0[rg]; LGW[(4 * g4 + rg) * 33 + 16 + fr] = acc1[rg]; }
            { const float d = (fr & 3) == 0 ? accs[0] : ((fr & 3) == 1 ? accs[1] : ((fr & 3) == 2 ? accs[2] : accs[3])); if ((fr >> 2) == g4) LGW[528 + fr] = d; }
            asm volatile("s_waitcnt lgkmcnt(0)" ::: "memory");
            if (F.lane < 16) { const int rl = F.wave * 32 + tile * 16 + F.lane; const int tok = blk * 256 + rl;
                float lg[20];
#pragma unroll
                for (int q = 0; q < 20; ++q) lg[q] = LGW[F.lane * 33 + q];
                const float rq = 1.f / sqrtf(LGW[528 + F.lane] * (1.f / DM_) + EPS_);
                float g[4]; int gs = 0;
#pragma unroll
                for (int i = 0; i < 4; ++i) g[i] = lg[i] * rq + bgv[i];
                float gm = g[0];
#pragma unroll
                for (int i = 1; i < 4; ++i) if (g[i] > gm) { gm = g[i]; gs = i; }
                float den = 0.f;
#pragma unroll
                for (int i = 0; i < 4; ++i) den += expf(g[i] - gm);
                const float pg = 1.f / den;
                float e[4];
#pragma unroll
                for (int i = 0; i < 4; ++i) { float xx = 0.f;
#pragma unroll
                    for (int q = 0; q < 4; ++q) xx = (q == gs) ? (lg[4 + q * 4 + i] * rq + bev[q * 4 + i]) : xx;
                    e[i] = xx; }
                int i0 = 0; float e0v = e[0];
#pragma unroll
                for (int i = 1; i < 4; ++i) if (e[i] > e0v) { e0v = e[i]; i0 = i; }
                int i1 = -1; float e1v = -3.0e38f;
#pragma unroll
                for (int i = 0; i < 4; ++i) if (i != i0 && e[i] > e1v) { e1v = e[i]; i1 = i; }
                if (i1 < 0) i1 = (i0 + 1) & 3;
                const float p1r = expf(e1v - e0v); const float w0 = pg / (1.f + p1r), w1 = pg * p1r / (1.f + p1r);
                const int a = i0 < i1 ? i0 : i1, b2 = i0 < i1 ? i1 : i0; const int pidx = (a == 0) ? (b2 - 1) : ((a == 1) ? (b2 + 1) : 5); const int bk = gs * 6 + pidx;
                RW[tok * 2] = (i0 < i1) ? w0 : w1; RW[tok * 2 + 1] = (i0 < i1) ? w1 : w0; RSTD[tok] = rq;
                const int la = __hip_atomic_fetch_add(cntL + bk, 1, __ATOMIC_RELAXED, __HIP_MEMORY_SCOPE_WORKGROUP);
                asg[rl] = bk | (la << 8); }
            asm volatile("s_waitcnt lgkmcnt(0)" ::: "memory");
        }
#undef P4_LDA
#undef P4_MMA
    __syncthreads();
    if (!DRY && F.tid < NBK_) { const int c = cntL[F.tid]; baseL[F.tid] = (int)__hip_atomic_fetch_add((unsigned*)(F.ctl + CW_CNT + F.tid), (unsigned)c, RLX_AGENT); }
    __syncthreads();
    if (!DRY && F.tid < 256) { int* ENTRY = (int*)(F.ws + WS_ENTRY); const int a = asg[F.tid]; const int bk = a & 0xff, lp = a >> 8;
      ENTRY[(size_t)bk * T_ + baseL[bk] + lp] = blk * 256 + F.tid; }
    __syncthreads();
    if (F.tid < 32) cntL[F.tid] = 0;
    __syncthreads();
    }
}
constexpr int TB_OFF = TAB_OFF + 23 * 1024;
__device__ __forceinline__ void moe_tables(Frame& F, bool down, bool reuse_tb = false) {
    LAS int* tb = (LAS int*)(F.lds + TB_OFF);
    if (!reuse_tb) {
    if (F.tid < NBK_) tb[32 + F.tid] = (int)F.ctl[CW_CNT + F.tid];
    __syncthreads();
    if (F.tid == 0) { int base = 0;
        for (int b = 0; b < NBK_; ++b) { tb[b] = base; base += (tb[32 + b] + 255) >> 8; }
        tb[NBK_] = base; }
    __syncthreads();
    }
    { const int NT0 = tb[NBK_]; const int sh0 = down ? 2 : 3;
      if (F.tid < 11) { int g, half; int bk = 0;
          if (pg8::moe_deal(F.tid, F.vcu, F.G, NT0 << sh0, g, half, down)) { const int rt = g >> sh0; for (int j = 1; j < NBK_; ++j) bk = (rt >= tb[j]) ? j : bk; }
          tb[64 + F.tid] = bk; } }
    const int NT = tb[NBK_]; const int sh = down ? 2 : 3; const int* ENTRY = (const int*)(F.ws + WS_ENTRY); const float* RW = (const float*)(F.ws + WS_RW); const float* RSTD = (const float*)(F.ws + WS_RSTD);
    int tbr[NBK_];
#pragma unroll
    for (int j = 0; j < NBK_; ++j) tbr[j] = tb[j];
    int tkv[11];
#pragma unroll
    for (int i = 0; i < 11; ++i) { int g, half; tkv[i] = -1;
        if (pg8::moe_deal(i, F.vcu, F.G, NT << sh, g, half, down) && F.tid < 256) { const int rt = g >> sh; int bk = 0;
#pragma unroll
            for (int j = 1; j < NBK_; ++j) bk = (rt >= tbr[j]) ? j : bk;
            const int cnt = tb[32 + bk]; const int pos = (rt - tb[bk]) * 256 + F.tid;
            if (pos < cnt) tkv[i] = ENTRY[(size_t)bk * T_ + pos]; } }
    if (!down) {
        float wv[11], rv[11];
#pragma unroll
        for (int i = 0; i < 11; ++i) { int g, half; wv[i] = 0.f; rv[i] = 0.f;
            if (pg8::moe_deal(i, F.vcu, F.G, NT << sh, g, half, down) && F.tid < 256) { const int ts = tkv[i] < 0 ? 0 : tkv[i]; wv[i] = RW[ts * 2 + ((g >> 2) & 1)]; rv[i] = RSTD[ts]; } }
#pragma unroll
        for (int i = 0; i < 11; ++i) { int g, half;
            if (pg8::moe_deal(i, F.vcu, F.G, NT << sh, g, half, down) && F.tid < 256) { const int t = tkv[i]; const bool valid = t >= 0;
                ((LAS unsigned*)(F.lds + TAB_OFF))[i * 512 + F.tid] = valid ? ((unsigned)t | (f2bf(wv[i]) << 16)) : 0u; ((LAS float*)(F.lds + TAB_OFF))[i * 512 + 256 + F.tid] = valid ? rv[i] : 0.f; } }
    } else {
#pragma unroll
        for (int i = 0; i < 11; ++i) { int g, half;
            if (pg8::moe_deal(i, F.vcu, F.G, NT << sh, g, half, down) && F.tid < 256) ((LAS int*)(F.lds + TAB_OFF))[i * 256 + F.tid] = tkv[i]; }
    }
    __syncthreads();
}
template <bool DRY  > __device__ __forceinline__ void p7_final(Frame& F) {
    const int gw = F.vcu * NWAVES + F.wave, NGW = F.G * NWAVES;
    const float* gain = F.in[16]; const bf16* Y = (const bf16*)(F.ws + WS_Y); const bf16* H1 = (const bf16*)(F.ws + WS_D);
    f32x4 gv[4];
#pragma unroll
    for (int j = 0; j < 4; ++j) gv[j] = *(const GAS f32x4*)(gain + 256 * j + 4 * F.lane);
    const bool poison = __hip_atomic_load(F.ctl + 2, RLX_AGENT) != 0u;
    v2u na[4], nd[4];
#define P7_LOAD(mm) do { const GAS v2u* d_ = (const GAS v2u*)(H1 + (size_t)(mm) * DM_) + F.lane; const GAS v2u* y0_ = (const GAS v2u*)(Y + (size_t)(mm) * DM_) + F.lane; \
        _Pragma("unroll") for (int j = 0; j < 4; ++j) { na[j] = y0_[64 * j]; nd[j] = d_[64 * j]; } } while (0)
    if (gw < T_) P7_LOAD(gw);
    for (int m = gw; m < T_; m += NGW) {
        GAS f32x4* xr = (GAS f32x4*)((DRY ? (float*)(F.ws + 778 * MiB) : F.out) + (size_t)(DRY ? (m & 32767) : m) * DM_) + F.lane;
        f32x4 v[4]; v2u ya[4]; float s = 0.f;
#pragma unroll
        for (int j = 0; j < 4; ++j) { const v2u d = nd[j]; v[j] = (f32x4){bflo(d.x), bfhi(d.x), bflo(d.y), bfhi(d.y)}; ya[j] = na[j]; }
        if (m + NGW < T_) P7_LOAD(m + NGW);
#pragma unroll
        for (int j = 0; j < 4; ++j) { const v2u a = ya[j];
            v[j].x += bflo(a.x); v[j].y += bfhi(a.x); v[j].z += bflo(a.y); v[j].w += bfhi(a.y);
            s += (v[j].x * v[j].x + v[j].y * v[j].y) + (v[j].z * v[j].z + v[j].w * v[j].w); }
        const float rstd = 1.f / sqrtf(wave_sum(s) * (1.f / DM_) + EPS_);
#pragma unroll
        for (int j = 0; j < 4; ++j) xr[64 * j] = v[j] * (poison ? 1.5f * rstd : rstd) * gv[j];
    }
#undef P7_LOAD
}
namespace attn_body {
using bf16=__hip_bfloat16;
using bf16x8=__attribute__((ext_vector_type(8)))short;
using s16x4=__attribute__((ext_vector_type(4)))short;
using f32x16=__attribute__((ext_vector_type(16)))float;
using u32x4=__attribute__((ext_vector_type(4)))unsigned;
constexpr int BATCH=32,NHEAD=8,SEQ=2048,D=64,DM=3584,DMO=1024;
constexpr int NW=8,QBLK=32,QB=QBLK*NW,KVBLK=64,NQB=SEQ/QB;
constexpr int ATTN_PITCH=DM, ATTN_UNIT_ROWS=QB;
__device__ __forceinline__ int crow(int r,int hi){return (r&3)+8*(r>>2)+4*hi;}
#define SBAR() __builtin_amdgcn_sched_barrier(0)
__device__ __forceinline__ void cmask(f32x16&p0,f32x16&p1,int jb,int qrel,int hi){
  const float NEG=-INFINITY; int kb=64*jb+4*hi;
  #pragma unroll
  for(int r=0;r<16;++r){int kv=kb+(r&3)+8*(r>>2); if(kv>qrel)p0[r]=NEG; if(kv+32>qrel)p1[r]=NEG;}
}

constexpr int NSLOT=3, SLOTB=8192;
constexpr int LDS_K=0, LDS_V=NSLOT*SLOTB, LDS_WS=2*NSLOT*SLOTB, LDS_OST=LDS_WS+NW*64*4, LDS_KB=LDS_OST+NW*4096, LDS_SCAN=LDS_KB+SEQ*16, LDS_NRM=LDS_SCAN+64, LDS_TIL=LDS_NRM+2*SEQ*4, LDS_BYTES=LDS_TIL+512;
typedef float f32x4_t __attribute__((ext_vector_type(4)));
constexpr float C2=0.125f*1.4426950408889634f;
__device__ __forceinline__ void glds16s(const void*sbase,unsigned voff,unsigned lds_dst){unsigned keep;
  asm volatile("s_mov_b32 %0, m0\n\ts_mov_b32 m0, %3\n\ts_nop 0\n\tglobal_load_lds_dwordx4 %1, %2\n\ts_mov_b32 m0, %0":"=&s"(keep):"v"(voff),"s"(sbase),"s"(lds_dst):"memory");}
__device__ __forceinline__ void glds16(const void*gsrc,unsigned lds_dst){unsigned keep;
  asm volatile("s_mov_b32 %0, m0\n\ts_mov_b32 m0, %2\n\ts_nop 0\n\tglobal_load_lds_dwordx4 %1, off\n\ts_mov_b32 m0, %0":"=&s"(keep):"v"(gsrc),"s"(lds_dst):"memory");}
__device__ __forceinline__ float max3f(float a,float b,float c){float r;asm("v_max3_f32 %0, %1, %2, %3":"=v"(r):"v"(a),"v"(b),"v"(c));return r;}
__device__ __forceinline__ float max2f(float a,float b){float r;asm("v_max_f32_e32 %0, %1, %2":"=v"(r):"v"(a),"v"(b));return r;}
__device__ __forceinline__ float fadd_s(float a,float b){float r;asm("v_add_f32_e32 %0, %1, %2":"=v"(r):"v"(a),"v"(b));return r;}
__device__ __forceinline__ float fsub_s(float a,float b){float r;asm("v_sub_f32_e32 %0, %1, %2":"=v"(r):"v"(a),"v"(b));return r;}
typedef float f32x2_t __attribute__((ext_vector_type(2))); typedef __bf16 bf16x2_t __attribute__((ext_vector_type(2)));
__device__ __forceinline__ unsigned cvtpk_s(float lo,float hi){f32x2_t v={lo,hi};bf16x2_t b=__builtin_convertvector(v,bf16x2_t);return __builtin_bit_cast(unsigned,b);}
#define WAIT_BAR(N) asm volatile("s_waitcnt vmcnt(" #N ") lgkmcnt(0)\n\ts_barrier":::"memory")

__device__ __forceinline__ void qkt(f32x16&p0,f32x16&p1,const char*Kslot,const bf16x8*qr,const f32x16&negm,int r32,int hi){
  const char*kb=Kslot+hi*1024+r32*16;
  #pragma unroll
  for(int d0=0;d0<4;++d0){
    const bf16x8 b0=*reinterpret_cast<const bf16x8*>(kb+d0*2048);
    const bf16x8 b1=*reinterpret_cast<const bf16x8*>(kb+d0*2048+512);
    if(d0==0){p0=__builtin_amdgcn_mfma_f32_32x32x16_bf16(b0,qr[0],negm,0,0,0);p1=__builtin_amdgcn_mfma_f32_32x32x16_bf16(b1,qr[0],negm,0,0,0);}
    else{p0=__builtin_amdgcn_mfma_f32_32x32x16_bf16(b0,qr[d0],p0,0,0,0);p1=__builtin_amdgcn_mfma_f32_32x32x16_bf16(b1,qr[d0],p1,0,0,0);}}
}
typedef __attribute__((address_space(3))) const char* lds_cptr;
typedef short v4i16_t __attribute__((ext_vector_type(4)));
__device__ __forceinline__ void kload8(bf16x8*kf,lds_cptr kp){
  kf[0]=*(const __attribute__((address_space(3))) bf16x8*)(kp);      kf[1]=*(const __attribute__((address_space(3))) bf16x8*)(kp+512);
  kf[2]=*(const __attribute__((address_space(3))) bf16x8*)(kp+2048); kf[3]=*(const __attribute__((address_space(3))) bf16x8*)(kp+2560);
  kf[4]=*(const __attribute__((address_space(3))) bf16x8*)(kp+4096); kf[5]=*(const __attribute__((address_space(3))) bf16x8*)(kp+4608);
  kf[6]=*(const __attribute__((address_space(3))) bf16x8*)(kp+6144); kf[7]=*(const __attribute__((address_space(3))) bf16x8*)(kp+6656);
}
__device__ __forceinline__ void kload2(bf16x8*kf,lds_cptr kp,int j){ kf[2*j]=*(const __attribute__((address_space(3))) bf16x8*)(kp+j*2048); kf[2*j+1]=*(const __attribute__((address_space(3))) bf16x8*)(kp+j*2048+512); }
__device__ __forceinline__ s16x4 vtr(lds_cptr p){ return __builtin_bit_cast(s16x4,__builtin_amdgcn_ds_read_tr16_b64_v4i16((__attribute__((address_space(3))) v4i16_t*)p)); }
__device__ __forceinline__ float rowmax(const f32x16&p0,const f32x16&p1){
  float a=max3f(p0[0],p0[1],p1[0]),b=max3f(p0[2],p0[3],p1[1]);a=max3f(a,p1[2],p1[3]);
  #pragma unroll
  for(int r=4;r<16;r+=4){a=max3f(a,p0[r],p0[r+1]);b=max3f(b,p0[r+2],p0[r+3]);a=max3f(a,p1[r],p1[r+1]);b=max3f(b,p1[r+2],p1[r+3]);}
  const float m=max2f(a,b);
  auto rr=__builtin_amdgcn_permlane32_swap(__float_as_uint(m),__float_as_uint(m),false,false);
  return max2f(__uint_as_float(rr[0]),__uint_as_float(rr[1]));
}
__device__ __forceinline__ void pv(f32x16*o,int vb,bf16x8 pa0,bf16x8 pa1,bf16x8 pa2,bf16x8 pa3){
  #pragma unroll
  for(int d0=0;d0<2;++d0){s16x4 lo[4],hi[4];
    #pragma unroll
    for(int ks=0;ks<4;++ks){
      asm volatile("ds_read_b64_tr_b16 %0,%1 offset:%c2":"=&v"(lo[ks]):"v"(vb),"i"(d0*4096+ks*1024):"memory");
      asm volatile("ds_read_b64_tr_b16 %0,%1 offset:%c2":"=&v"(hi[ks]):"v"(vb),"i"(d0*4096+ks*1024+512):"memory");}
    asm volatile("s_waitcnt lgkmcnt(0)":::"memory");SBAR();
    #define PK(k) (bf16x8){lo[k][0],lo[k][1],lo[k][2],lo[k][3],hi[k][0],hi[k][1],hi[k][2],hi[k][3]}
    o[d0]=__builtin_amdgcn_mfma_f32_32x32x16_bf16(pa0,PK(0),o[d0],0,0,0);
    o[d0]=__builtin_amdgcn_mfma_f32_32x32x16_bf16(pa1,PK(1),o[d0],0,0,0);
    o[d0]=__builtin_amdgcn_mfma_f32_32x32x16_bf16(pa2,PK(2),o[d0],0,0,0);
    o[d0]=__builtin_amdgcn_mfma_f32_32x32x16_bf16(pa3,PK(3),o[d0],0,0,0);
    #undef PK
  }
}

#ifndef ATTN_STORE16
#define ATTN_STORE16(p,v) (*(u32x4*)(p)=(v))
#endif
template<int CTRL> __device__ __forceinline__ float dpp_f(float v){ return __int_as_float(__builtin_amdgcn_update_dpp(0,__float_as_int(v),CTRL,0xf,0xf,true)); }
__device__ __forceinline__ void split3(float x,unsigned&h,unsigned&m,unsigned&l){
  h=cvtpk_s(x,0.f)&0xffffu; const float r1=x-__uint_as_float(h<<16); m=cvtpk_s(r1,0.f)&0xffffu; const float r2=r1-__uint_as_float(m<<16); l=cvtpk_s(r2,0.f)&0xffffu; }
__device__ __forceinline__ bf16x8 mkqp(float s,int hi){ unsigned h,m,l; split3(s,h,m,l); u32x4 w; w[0]=0x3f803f80u; w[1]=0x3f80u|(h<<16); w[2]=m|(l<<16); w[3]=0u; if(hi){w[0]=0u;w[1]=0u;w[2]=0u;} return __builtin_bit_cast(bf16x8,w); }
template<int THRL> __device__ __forceinline__ void attn_unit(int b,int h,int qb,const bf16*Q,const bf16*__restrict__ K,const bf16*__restrict__ V,bf16*O,const float*__restrict__ gain,char*shm,int t0,bf16x8(&qr)[4],const bool primed,int&qbn,const int t0n_,unsigned*claim){
  int t0n=t0n_; const bool dyn=claim!=nullptr;
  int tid_=threadIdx.x; asm volatile("":"+v"(tid_));
  const int tid=tid_,lane=tid&63,r32=lane&31,hi=lane>>5; const int wid=__builtin_amdgcn_readfirstlane(tid>>6);
  int claimv=0; if(dyn&&tid==0)claimv=(int)__hip_atomic_fetch_add(claim,1u,__ATOMIC_RELAXED,__HIP_MEMORY_SCOPE_AGENT);
  const long rowbase=(long)b*SEQ; const int q0=qb*QB;
  const bf16*Qw=Q+(rowbase+q0+wid*QBLK)*DM+h*D;
  const bf16*Kh=K+(rowbase+(long)t0*KVBLK)*DM+h*D,*Vh=V+(rowbase+(long)t0*KVBLK)*DM+h*D;
  const unsigned lds0=(unsigned)(uintptr_t)shm;
  float*wsf=(float*)(shm+LDS_WS)+wid*64;
  const unsigned koff=(unsigned)(lane*DM+wid*8)*2u;
  const unsigned voff=(unsigned)((16*(wid&3)+(lane>>2))*DM+(wid>>2)*32+(lane&3)*8)*2u;
  const unsigned kdst=lds0+LDS_K+wid*1024, vdst=lds0+LDS_V+wid*1024;
  #define DMA_KP(base,t,slot) glds16s((base)+(long)(t)*KVBLK*DM,koff,(unsigned)__builtin_amdgcn_readfirstlane(kdst+(slot)))
  #define DMA_VP(base,t,slot) glds16s((base)+(long)(t)*KVBLK*DM,voff,(unsigned)__builtin_amdgcn_readfirstlane(vdst+(slot)))
  #define DMA_K(t,slot) DMA_KP(Kh,t,slot)
  #define DMA_V(t,slot) DMA_VP(Vh,t,slot)
  #define PRIME(KB,VB,QW,QR) do{ DMA_KP(KB,0,0);DMA_VP(VB,0,0);DMA_KP(KB,1,SLOTB); \
    _Pragma("unroll") for(int d0=0;d0<4;++d0)QR[d0]=*reinterpret_cast<const bf16x8*>(&(QW)[(long)r32*DM+d0*16+hi*8]); DMA_KP(KB,2,2*SLOTB); }while(0)
  const int vb0=(int)(lds0+LDS_V)+((lane>>4)&1)*32+(lane&3)*8+(4*hi+((lane&15)>>2))*64;
  const char*Kbase=shm+LDS_K; bf16x8 kf[8];
  const lds_cptr shm3=(lds_cptr)shm; const lds_cptr kp0=shm3+LDS_K+hi*1024+r32*16; const lds_cptr vp0=shm3+LDS_V+((lane>>4)&1)*32+(lane&3)*8+(4*hi+((lane&15)>>2))*64;
  const int NT=(q0+QB)/KVBLK-t0;
  if(!primed){ PRIME(Kh,Vh,Qw,qr); }
  const int qrel=wid*QBLK+r32;
  const lds_cptr kb3=(lds_cptr)shm+LDS_KB+t0*1024+r32*16;
  float cq; { const u32x4 e=*(const __attribute__((address_space(3))) u32x4*)((lds_cptr)shm+LDS_KB+(q0+qrel)*16); cq=-((__uint_as_float(e[0]<<16)+__uint_as_float(e[0]&0xffff0000u))+__uint_as_float(e[1]<<16)); }
  float mhat=0.f,l_reg=0.f;f32x16 o[2];o[0]=f32x16{};o[1]=f32x16{}; const f32x16 negm=f32x16{};
  bf16x8 qp=mkqp(cq,hi);
  #define CMASK(P0,P1,t) do{int jb_=(t)-(NT-4); if(jb_>=0)cmask(P0,P1,jb_,qrel,hi);}while(0)
  bool resc=false;
  #define START(P0,P1) do{ const float rm=rowmax(P0,P1); resc=false; \
    { const float dl=__builtin_fmaxf(rm,0.f); mhat=fadd_s(mhat,dl); \
      _Pragma("unroll") for(int r=0;r<16;++r){P0[r]=fsub_s(P0[r],dl);P1[r]=fsub_s(P1[r],dl);} \
      qp=mkqp(cq-mhat,hi); } \
    _Pragma("unroll") for(int r=0;r<16;++r)P0[r]=__builtin_amdgcn_exp2f(P0[r]); }while(0)
  #define RESC() do{ if(resc){ asm volatile("s_waitcnt lgkmcnt(0)":::"memory"); \
      _Pragma("unroll") for(int d_=0;d_<2;++d_) _Pragma("unroll") for(int r=0;r<16;++r)o[d_][r]*=wsf[crow(r,hi)]; } }while(0)
  f32x16 pA0,pA1,pB0,pB1;
  int sl_prev=0,sl_cur=0,sl_next=SLOTB;
  #define ROT() do{sl_prev=sl_cur;sl_cur=sl_next;sl_next=(sl_next==(NSLOT-1)*SLOTB)?0:sl_next+SLOTB;}while(0)
  WAIT_BAR(3);
  if(dyn&&tid==0)((int*)(shm+LDS_TIL))[104]=claimv;
  qkt(pA0,pA1,Kbase,qr,negm,r32,hi);
  { const bf16x8 kb0_=*(const __attribute__((address_space(3))) bf16x8*)(kb3), kb1_=*(const __attribute__((address_space(3))) bf16x8*)(kb3+512);
    pA0=__builtin_amdgcn_mfma_f32_32x32x16_bf16(kb0_,qp,pA0,0,0,0); pA1=__builtin_amdgcn_mfma_f32_32x32x16_bf16(kb1_,qp,pA1,0,0,0); }
  asm volatile("s_nop 15\n\ts_nop 7":"+v"(pA0),"+v"(pA1));CMASK(pA0,pA1,0);
  START(pA0,pA1);
  _Pragma("unroll") for(int r=0;r<16;++r)pA1[r]=__builtin_amdgcn_exp2f(pA1[r]);
  WAIT_BAR(0);
  DMA_K(3,0);DMA_V(1,SLOTB);
  ROT();
  kload8(kf,kp0+sl_cur);
  WAIT_BAR(2);
  s16x4 vlo[8],vhi[8]; u32x4 pw0,pw1,pw2,pw3;
  #define PKW(P,B) cvtpk_s(P[B],P[B+1])
  #define PAF(k) __builtin_bit_cast(bf16x8,pw##k)
  #define VFR(i) (bf16x8){vlo[i][0],vlo[i][1],vlo[i][2],vlo[i][3],vhi[i][0],vhi[i][1],vhi[i][2],vhi[i][3]}
  #define PIN(x) asm volatile("":"+v"(x))
  #define MX3(a,b,c) __builtin_fmaxf(__builtin_fmaxf((a),(b)),(c))
  #define GAPA(MF,A0,A1,A2,A3,W0,W1,PW) do{ MF; sacc+=A0; sacc+=A1; sacc+=A2; sacc+=A3; PIN(sacc); W0; W1; PIN(PW); SBAR(); }while(0)
  #define EX(v) __builtin_amdgcn_exp2f(v)
  #define GAPB(MF,X,B) do{ MF; X[B]=EX(X[B]); X[B+1]=EX(X[B+1]); X[B+2]=EX(X[B+2]); X[B+3]=EX(X[B+3]); PIN(X); SBAR(); }while(0)
  #define VRD(i) do{ vlo[i]=vtr(vp_+(((i)>>2)*4096+((i)&3)*1024)); vhi[i]=vtr(vp_+(((i)>>2)*4096+((i)&3)*1024+512)); }while(0)
  #define KRD(G,j) do{ if(G){ kload2(kf,kp0+sl_next,j); SBAR(); } }while(0)
  #define STEP(C0,C1,P0,P1,t,GK,GV,GL) do{ SBAR(); \
    const lds_cptr vp_=vp0+sl_prev; \
    const bf16x8 kb0_=*(const __attribute__((address_space(3))) bf16x8*)(kb3+(t)*1024), kb1_=*(const __attribute__((address_space(3))) bf16x8*)(kb3+(t)*1024+512); \
    VRD(0); SBAR(); float sacc=(P0[0]+P0[1]); \
    GAPA(C0=__builtin_amdgcn_mfma_f32_32x32x16_bf16(kf[0],qr[0],negm,0,0,0), P0[2],P0[3],P0[4],P0[5],     pw0[0]=PKW(P0,0), pw0[1]=PKW(P0,2), pw0); \
    VRD(4); SBAR(); GAPA(C1=__builtin_amdgcn_mfma_f32_32x32x16_bf16(kf[1],qr[0],negm,0,0,0), P0[6],P0[7],P0[8],P0[9],     pw0[2]=PKW(P0,4), pw0[3]=PKW(P0,6), pw0); \
    VRD(1); SBAR(); GAPA(C0=__builtin_amdgcn_mfma_f32_32x32x16_bf16(kf[2],qr[1],C0,0,0,0),   P0[10],P0[11],P0[12],P0[13], pw1[0]=PKW(P0,8), pw1[1]=PKW(P0,10), pw1); \
    VRD(5); SBAR(); GAPA(C1=__builtin_amdgcn_mfma_f32_32x32x16_bf16(kf[3],qr[1],C1,0,0,0),   P0[14],P0[15],P1[0],P1[1],   pw1[2]=PKW(P0,12),pw1[3]=PKW(P0,14), pw1); \
    VRD(2); SBAR(); GAPA(C0=__builtin_amdgcn_mfma_f32_32x32x16_bf16(kf[4],qr[2],C0,0,0,0),   P1[2],P1[3],P1[4],P1[5],     pw2[0]=PKW(P1,0), pw2[1]=PKW(P1,2), pw2); \
    VRD(6); SBAR(); GAPA(C1=__builtin_amdgcn_mfma_f32_32x32x16_bf16(kf[5],qr[2],C1,0,0,0),   P1[6],P1[7],P1[8],P1[9],     pw2[2]=PKW(P1,4), pw2[3]=PKW(P1,6), pw2); \
    VRD(3); SBAR(); GAPA(C0=__builtin_amdgcn_mfma_f32_32x32x16_bf16(kf[6],qr[3],C0,0,0,0),   P1[10],P1[11],P1[12],P1[13], pw3[0]=PKW(P1,8), pw3[1]=PKW(P1,10), pw3); \
    VRD(7); SBAR(); GAPA(C1=__builtin_amdgcn_mfma_f32_32x32x16_bf16(kf[7],qr[3],C1,0,0,0),   P1[14],P1[15],0.f,0.f,       pw3[2]=PKW(P1,12),pw3[3]=PKW(P1,14), pw3); \
    C0=__builtin_amdgcn_mfma_f32_32x32x16_bf16(kb0_,qp,C0,0,0,0); C1=__builtin_amdgcn_mfma_f32_32x32x16_bf16(kb1_,qp,C1,0,0,0); \
    l_reg+=sacc; \
    if(GK){DMA_K((t)+3,sl_cur);} if(GV){DMA_V((t)+1,sl_next);} \
    CMASK(C0,C1,t); \
    { float a=MX3(C0[0],C0[1],C1[0]),b=MX3(C0[2],C0[3],C1[1]); a=MX3(a,C1[2],C1[3]); \
      _Pragma("unroll") for(int r=4;r<16;r+=4){a=MX3(a,C0[r],C0[r+1]);b=MX3(b,C0[r+2],C0[r+3]);a=MX3(a,C1[r],C1[r+1]);b=MX3(b,C1[r+2],C1[r+3]);} \
      float rm=__builtin_fmaxf(a,b); { auto rr=__builtin_amdgcn_permlane32_swap(__float_as_uint(rm),__float_as_uint(rm),false,false); rm=__builtin_fmaxf(__uint_as_float(rr[0]),__uint_as_float(rr[1])); } \
      resc=false; \
      if(__builtin_expect(__any(rm>(float)THRL),0)){ const float dl=__builtin_fmaxf(rm,0.f); mhat+=dl; \
        _Pragma("unroll") for(int r=0;r<16;++r){C0[r]-=dl;C1[r]-=dl;} \
        qp=mkqp(cq-mhat,hi); \
        const float f=__builtin_amdgcn_exp2f(-dl); l_reg*=f; if(hi==0)wsf[r32]=f; resc=true; } } \
    SBAR(); \
    GAPB(o[0]=__builtin_amdgcn_mfma_f32_32x32x16_bf16(PAF(0),VFR(0),o[0],0,0,0), C0,0); \
    GAPB(o[1]=__builtin_amdgcn_mfma_f32_32x32x16_bf16(PAF(0),VFR(4),o[1],0,0,0), C0,4); \
    KRD(GL,0); GAPB(o[0]=__builtin_amdgcn_mfma_f32_32x32x16_bf16(PAF(1),VFR(1),o[0],0,0,0), C0,8); \
    KRD(GL,1); GAPB(o[1]=__builtin_amdgcn_mfma_f32_32x32x16_bf16(PAF(1),VFR(5),o[1],0,0,0), C0,12); \
    KRD(GL,2); GAPB(o[0]=__builtin_amdgcn_mfma_f32_32x32x16_bf16(PAF(2),VFR(2),o[0],0,0,0), C1,0); \
    KRD(GL,3); GAPB(o[1]=__builtin_amdgcn_mfma_f32_32x32x16_bf16(PAF(2),VFR(6),o[1],0,0,0), C1,4); \
    GAPB(o[0]=__builtin_amdgcn_mfma_f32_32x32x16_bf16(PAF(3),VFR(3),o[0],0,0,0), C1,8); \
    GAPB(o[1]=__builtin_amdgcn_mfma_f32_32x32x16_bf16(PAF(3),VFR(7),o[1],0,0,0), C1,12); \
    }while(0)
  int t=1;
  #undef CMASK
  #define CMASK(P0,P1,t) do{}while(0)
  for(;t+5<NT;t+=2){
    STEP(pB0,pB1,pA0,pA1,t,true,true,true);     WAIT_BAR(2); RESC(); ROT();
    STEP(pA0,pA1,pB0,pB1,t+1,true,true,true);   WAIT_BAR(2); RESC(); ROT();
  }
  #undef CMASK
  #define CMASK(P0,P1,t) do{int jb_=(t)-(NT-4); if(jb_>=0)cmask(P0,P1,jb_,qrel,hi);}while(0)
  #define ENDW(tt) do{ if((tt)+3<NT){WAIT_BAR(2);} else if((tt)+2<NT){WAIT_BAR(1);} else {WAIT_BAR(0);} }while(0)
  for(;t+1<NT;t+=2){
    STEP(pB0,pB1,pA0,pA1,t,(t+3<NT),(t+1<NT),(t+1<NT));       ENDW(t);   RESC(); ROT();
    STEP(pA0,pA1,pB0,pB1,t+1,(t+4<NT),(t+2<NT),(t+2<NT));     ENDW(t+1); RESC(); ROT();
  }
  STEP(pB0,pB1,pA0,pA1,NT-1,false,false,false); RESC();
  { float sacc=pB0[0]+pB0[1]; _Pragma("unroll") for(int r=2;r<16;++r)sacc+=pB0[r]; _Pragma("unroll") for(int r=0;r<16;++r)sacc+=pB1[r]; l_reg+=sacc;
    pw0=(u32x4){PKW(pB0,0),PKW(pB0,2),PKW(pB0,4),PKW(pB0,6)};pw1=(u32x4){PKW(pB0,8),PKW(pB0,10),PKW(pB0,12),PKW(pB0,14)};pw2=(u32x4){PKW(pB1,0),PKW(pB1,2),PKW(pB1,4),PKW(pB1,6)};pw3=(u32x4){PKW(pB1,8),PKW(pB1,10),PKW(pB1,12),PKW(pB1,14)};
    SBAR(); pv(o,vb0+sl_cur,PAF(0),PAF(1),PAF(2),PAF(3)); }
  asm volatile("s_waitcnt lgkmcnt(0)\n\ts_barrier":::"memory");
  if(dyn){ const int n_=__builtin_amdgcn_readfirstlane(((const int*)(shm+LDS_TIL))[104]); qbn=(n_<NQB)?NQB-1-n_:-1; t0n=__builtin_amdgcn_readfirstlane(((const int*)(shm+LDS_TIL))[96+(qbn<0?0:qbn)]); }
  bf16x8 qn[4];
  if(qbn>=0){ const bf16*Khn=K+(rowbase+(long)t0n*KVBLK)*DM+h*D,*Vhn=V+(rowbase+(long)t0n*KVBLK)*DM+h*D; const bf16*Qwn=Q+(rowbase+qbn*QB+wid*QBLK)*DM+h*D; PRIME(Khn,Vhn,Qwn,qn); }
  #undef PKW
  #undef PAF
  #undef VFR
  #undef PIN
  #undef MX3
  #undef GAPA
  #undef GAPB
  #undef EX
  #undef VRD
  #undef KRD
  #undef STEP
  #undef ENDW
  {auto rr=__builtin_amdgcn_permlane32_swap(__float_as_uint(l_reg),__float_as_uint(l_reg),false,false);l_reg=__uint_as_float(rr[0])+__uint_as_float(rr[1]);}
  if(hi==0)wsf[32+r32]=l_reg;asm volatile("s_waitcnt lgkmcnt(0)":::"memory");
  float rli[16];
  #pragma unroll
  for(int r=0;r<16;++r)rli[r]=__builtin_amdgcn_rcpf(wsf[32+crow(r,hi)]);
  bf16*Ow=O+(rowbase+q0+wid*QBLK)*DMO+h*D;
  { bf16*stg=(bf16*)(shm+LDS_OST)+wid*2048;
    #pragma unroll
    for(int r=0;r<16;++r){const int orow=crow(r,hi);
      #pragma unroll
      for(int d0=0;d0<2;++d0)stg[orow*64+d0*32+r32]=__float2bfloat16(o[d0][r]*rli[r]);}
    asm volatile("s_waitcnt lgkmcnt(0)":::"memory");
    const int ch=lane&7; const f32x4_t g0=*(const f32x4_t*)(gain+ch*8), g1=*(const f32x4_t*)(gain+ch*8+4);
    #pragma unroll
    for(int i=0;i<4;++i){const int row=i*8+(lane>>3); const u32x4 v=*(const u32x4*)(stg+row*64+ch*8);
      float f[8];
      #pragma unroll
      for(int e=0;e<4;++e){ f[2*e]=__uint_as_float(v[e]<<16); f[2*e+1]=__uint_as_float(v[e]&0xffff0000u); }
      float ss=(f[0]*f[0]+f[1]*f[1])+(f[2]*f[2]+f[3]*f[3])+(f[4]*f[4]+f[5]*f[5])+(f[6]*f[6]+f[7]*f[7]);
      ss+=dpp_f<0xB1>(ss); ss+=dpp_f<0x4E>(ss); ss+=dpp_f<0x141>(ss);
      const float rs=__builtin_amdgcn_rsqf(ss*(1.f/64.f)+1e-6f);
      u32x4 w; w[0]=cvtpk_s(f[0]*rs*g0[0],f[1]*rs*g0[1]); w[1]=cvtpk_s(f[2]*rs*g0[2],f[3]*rs*g0[3]); w[2]=cvtpk_s(f[4]*rs*g1[0],f[5]*rs*g1[1]); w[3]=cvtpk_s(f[6]*rs*g1[2],f[7]*rs*g1[3]);
      ATTN_STORE16(Ow+(long)row*DMO+ch*8,w);} }
  if(qbn>=0){
    #pragma unroll
    for(int d0=0;d0<4;++d0)qr[d0]=qn[d0]; }
  #undef DMA_K
  #undef DMA_V
  #undef DMA_KP
  #undef DMA_VP
  #undef PRIME
  #undef CMASK
  #undef START
  #undef RESC
  #undef ROT
}
constexpr int ATTN_LDS_BYTES=LDS_BYTES;
template<int THRL=8> __device__ __forceinline__ void attn_bh(char*lds,const bf16*U,bf16*MIX,const float*__restrict__ FLG,const float*__restrict__ gain,int bh,int qlo,int qhi,unsigned*claim,const unsigned*ktab,const unsigned*qtab){
  const int tid=threadIdx.x,lane=tid&63,wid=tid>>6;
  { const int b=bh/NHEAD,h=bh%NHEAD;
    { float a[4];
      #pragma unroll
      for(int i=0;i<4;++i)a[i]=FLG[((size_t)b*SEQ+4*tid+i)*8+h];
      a[1]+=a[0];a[2]+=a[1];a[3]+=a[2];
      float sc=a[3];
      int lo_=lane; asm volatile("":"+v"(lo_));
      #pragma unroll
      for(int o=1;o<64;o<<=1){const float n=__int_as_float(__builtin_amdgcn_ds_bpermute(((lo_-o)&63)<<2,__float_as_int(sc))); if(lo_>=o)sc+=n;}
      float*ws=(float*)(lds+LDS_SCAN);
      if(lane==63)ws[wid]=sc;
      __syncthreads();
      float base=0.f;
      #pragma unroll
      for(int w=0;w<NW;++w)base+=(w<wid)?ws[w]:0.f;
      const float ex=base+sc-a[3];
      #pragma unroll
      for(int i=0;i<4;++i){ unsigned hh,mm,ll; split3(-(ex+a[i])*1.4426950408889634f,hh,mm,ll); u32x4 e; e[0]=hh|(mm<<16); e[1]=ll|0x3f800000u; e[2]=0x3f803f80u; e[3]=0u; *(u32x4*)(lds+LDS_KB+16*(4*tid+i))=e; }
      __syncthreads(); }
    { float* til=(float*)(lds+LDS_TIL); unsigned* tilu=(unsigned*)(lds+LDS_TIL);
      if(tid<128)tilu[tid]=0u;
      __syncthreads();
      if(tid<32)til[tid]=__uint_as_float(ktab[(bh*2+0)*32+tid])+__uint_as_float(ktab[(bh*2+1)*32+tid]);
      else if(tid>=64&&tid<72)til[tid]=__uint_as_float(qtab[(bh*2+0)*8+(tid-64)])+__uint_as_float(qtab[(bh*2+1)*8+(tid-64)]);
      if(tid<32){ const u32x4 e=*(const u32x4*)(lds+LDS_KB+16*(64*tid+63)); til[32+tid]=-((__uint_as_float(e[0]<<16)+__uint_as_float(e[0]&0xffff0000u))+__uint_as_float(e[1]<<16)); }
      else if(tid<40){ const int bq=tid-32; const u32x4 e=*(const u32x4*)(lds+LDS_KB+16*(256*bq)); til[72+bq]=-((__uint_as_float(e[0]<<16)+__uint_as_float(e[0]&0xffff0000u))+__uint_as_float(e[1]<<16)); }
      __syncthreads(); }
    if(tid<NQB*32){ const float* til=(const float*)(lds+LDS_TIL); const int qb=tid>>5, j=tid&31; const float qn2=til[64+qb]*1.0001f, cq0=til[72+qb];
      const float bound=sqrtf(qn2*til[j])*1.0001f+cq0-til[32+j]; const bool hit=(j<4*qb)&&!(bound<-150.f);
      const unsigned long long mk=__ballot(hit); const unsigned half_=(lane&32)?(unsigned)(mk>>32):(unsigned)mk;
      const int t0=half_?__builtin_ctz(half_):4*qb;
      if((lane&31)==0)((int*)(lds+LDS_TIL))[96+qb]=t0&~1; }
    __syncthreads();
    { bf16x8 qr[4]; bool primed=false; const bool dyn=claim!=nullptr; const int* t0t=(const int*)(lds+LDS_TIL)+96;
      int qb=qhi-1;
      if(dyn){ if(tid==0)((int*)(lds+LDS_TIL))[105]=(int)__hip_atomic_fetch_add(claim,1u,__ATOMIC_RELAXED,__HIP_MEMORY_SCOPE_AGENT); __syncthreads(); const int n_=__builtin_amdgcn_readfirstlane(((const int*)(lds+LDS_TIL))[105]); qb=(n_<NQB)?NQB-1-n_:-1; }
      while(qb>=qlo){ const int t0=__builtin_amdgcn_readfirstlane(t0t[qb]);
        int qbn=(!dyn&&qb>qlo)?qb-1:-1; const int t0n=__builtin_amdgcn_readfirstlane(t0t[qbn<0?0:qbn]);
        attn_unit<THRL>(b,h,qb,U+2048,U+2560,U+3072,MIX+512,gain,lds,t0,qr,primed,qbn,t0n,claim); primed=(qbn>=0); qb=qbn; } }
    __syncthreads();
  }
}
template<int THRL=8,class Pre> __device__ __forceinline__ void attn_phase(char*lds,const bf16*U,bf16*MIX,const float*__restrict__ FLG,const float*__restrict__ gain,int vcu,int G,unsigned*claims,const unsigned*ktab,const unsigned*qtab,const Pre&pre){
  for(int it=0;;++it){ int bh,qlo=0,qhi=NQB; unsigned*claim=nullptr;
    if(G==256){ if(vcu<128){ if(it>0)break; bh=vcu; claim=claims+vcu; } else { if(it>1)break; bh=it?vcu-128:vcu; if(it)claim=claims+(vcu-128); } }
    else { bh=vcu+it*G; if(bh>=BATCH*NHEAD)break; }
    pre(it);
    attn_bh<THRL>(lds,U,MIX,FLG,gain,bh,qlo,qhi,claim,ktab,qtab); }
  pre(-1);
}
#undef SBAR
#undef WAIT_BAR
}
namespace hgrn_body {
typedef unsigned short bf16;
typedef short bf16x8 __attribute__((ext_vector_type(8)));
typedef short s16x4 __attribute__((ext_vector_type(4)));
typedef float f32x4 __attribute__((ext_vector_type(4)));
typedef float f32x2 __attribute__((ext_vector_type(2)));
typedef unsigned u32x4 __attribute__((ext_vector_type(4)));
typedef unsigned u32x2 __attribute__((ext_vector_type(2)));
#define HL __attribute__((address_space(3)))
constexpr int SEQ = 2048, NCH = SEQ / 64, UP = 3584, MP = 1024, NUNITS = 32 * 4;
constexpr int QS = 272, PS = 144, OS = 132;
constexpr int QSET = 64 * QS;
constexpr int L_Q = 0, L_K = L_Q + 2 * QSET, L_P = L_K + 2 * QSET, L_V = L_P + 64 * PS, L_O = L_V + 2 * 16384, L_SEG = L_O + 64 * OS * 4, L_ER = L_SEG + 8 * 128 * 4, L_END = L_ER + 2 * 1024;
static_assert(L_END <= 155648, "HGRN LDS map");
__device__ __forceinline__ unsigned pk(float lo, float hi) { typedef __bf16 b2 __attribute__((ext_vector_type(2))); const f32x2 v = {lo, hi}; const b2 b = __builtin_convertvector(v, b2); return __builtin_bit_cast(unsigned, b); }
__device__ __forceinline__ float blo(unsigned w) { return __builtin_bit_cast(float, w << 16); }
__device__ __forceinline__ float bhi(unsigned w) { return __builtin_bit_cast(float, w & 0xffff0000u); }
__device__ __forceinline__ float ex2(float x) { return __builtin_amdgcn_exp2f(x); }
template <int CTRL> __device__ __forceinline__ float dppf(float v) { return __builtin_bit_cast(float, __builtin_amdgcn_update_dpp(0, __builtin_bit_cast(int, v), CTRL, 0xf, 0xf, true)); }
__device__ __forceinline__ s16x4 trd(HL char* p) { return __builtin_bit_cast(s16x4, __builtin_amdgcn_ds_read_tr16_b64_v4i16((HL s16x4*)p)); }
#define HBAR() do { asm volatile("s_waitcnt lgkmcnt(0)" ::: "memory"); __builtin_amdgcn_s_barrier(); asm volatile("" ::: "memory"); } while (0)
#define HMF(a, b, c) __builtin_amdgcn_mfma_f32_16x16x32_bf16((a), (b), (c), 0, 0, 0)

template <int VAR  >
__device__ __forceinline__ void hgrn_unit(char* lds_, const bf16* __restrict__ U, bf16* MIX, const float* __restrict__ gain, int b, int h) {
    HL char* lds = (HL char*)lds_;
    int tid_ = threadIdx.x; asm volatile("" : "+v"(tid_));
    const int tid = tid_, lane = tid & 63, w = __builtin_amdgcn_readfirstlane(tid >> 6), fr = lane & 15, g = lane >> 4;
    const size_t row0 = (size_t)b * SEQ;
    const bf16* Uq = U + row0 * UP + h * 128;
    const int ot = tid >> 3, oj = tid & 7;
    f32x4 gn[4];
#pragma unroll
    for (int i = 0; i < 4; ++i) gn[i] = *(const f32x4*)(gain + 16 * oj + 4 * i);
    unsigned rq[8], rl[8]; u32x4 sgc0, sgc1;
    float cx[8], cy[8];
    f32x4 S[8];
#pragma unroll
    for (int i = 0; i < 8; ++i) S[i] = (f32x4){0.f, 0.f, 0.f, 0.f};
#define H_LOAD_RAW(c) do { _Pragma("unroll") for (int i_ = 0; i_ < 8; ++i_) { const bf16* p_ = Uq + (size_t)((c) * 64 + 8 * w + i_) * UP + 2 * lane; rq[i_] = *(const unsigned*)p_; rl[i_] = *(const unsigned*)(p_ + 512); } } while (0)
#define H_DMA_V(c, slot) do { _Pragma("unroll") for (int i_ = 0; i_ < 2; ++i_) \
        __builtin_amdgcn_global_load_lds((const unsigned*)(Uq + 1024 + (size_t)((c) * 64 + 8 * w + 4 * i_ + (lane >> 4)) * UP + (lane & 15) * 8), (HL unsigned*)(lds + L_V + (slot) * 16384 + (8 * w + 4 * i_) * 256), 16, 0, 0); } while (0)
#define H_LOAD_SG(c, d0, d1) do { const bf16* p_ = Uq + 1536 + (size_t)((c) * 64 + ot) * UP + 16 * oj; d0 = *(const u32x4*)p_; d1 = *(const u32x4*)(p_ + 8); } while (0)
#define H_PREP1() do { float ax_ = 0.f, ay_ = 0.f; \
        _Pragma("unroll") for (int i = 0; i < 8; ++i) { ax_ += blo(rl[i]); ay_ += bhi(rl[i]); cx[i] = ax_; cy[i] = ay_; } \
        *(HL f32x2*)(lds + L_SEG + (w * 128 + 2 * lane) * 4) = (f32x2){ax_, ay_}; } while (0)
#define H_PREP2(set) do { float px = 0.f, py = 0.f, rx = 0.f, ry = 0.f, tx = 0.f, ty = 0.f; \
        _Pragma("unroll") for (int ww = 0; ww < 8; ++ww) { const f32x2 s = *(HL f32x2*)(lds + L_SEG + (ww * 128 + 2 * lane) * 4); \
            px += (ww < w) ? s.x : 0.f; py += (ww < w) ? s.y : 0.f; if (ww < 4) { rx += s.x; ry += s.y; } tx += s.x; ty += s.y; } \
        _Pragma("unroll") for (int i = 0; i < 8; ++i) { const float bx = px + cx[i], by = py + cy[i]; \
            const float qx = blo(rq[i]) * ex2(bx - rx), qy = bhi(rq[i]) * ex2(by - ry); \
            const float kx = (1.f - ex2(blo(rl[i]))) * ex2(rx - bx), ky = (1.f - ex2(bhi(rl[i]))) * ex2(ry - by); \
            const int t = 8 * w + i; \
            *(HL unsigned*)(lds + L_Q + (set) * QSET + t * QS + 4 * lane) = pk(qx, qy); \
            *(HL unsigned*)(lds + L_K + (set) * QSET + t * QS + 4 * lane) = pk(kx, ky); } \
        if (w == 0) { *(HL f32x2*)(lds + L_ER + (set) * 1024 + (2 * lane) * 4) = (f32x2){ex2(rx), ex2(ry)}; *(HL f32x2*)(lds + L_ER + (set) * 1024 + 512 + (2 * lane) * 4) = (f32x2){ex2(tx - rx), ex2(ty - ry)}; } } while (0)
#define H_OUTPUT(cc) do { f32x4 o[4]; float ss = 0.f; \
        _Pragma("unroll") for (int i = 0; i < 4; ++i) { o[i] = *(HL f32x4*)(lds + L_O + (ot * OS + 16 * oj + 4 * i) * 4); ss += (o[i][0] * o[i][0] + o[i][1] * o[i][1]) + (o[i][2] * o[i][2] + o[i][3] * o[i][3]); } \
        ss += dppf<0xB1>(ss); ss += dppf<0x4E>(ss); ss += dppf<0x141>(ss); \
        const float rs = __builtin_amdgcn_rsqf(ss * (1.f / 128.f) + 1e-6f); \
        const unsigned sgw[8] = {sgc0[0], sgc0[1], sgc0[2], sgc0[3], sgc1[0], sgc1[1], sgc1[2], sgc1[3]}; \
        u32x4 y0, y1; \
        _Pragma("unroll") for (int i = 0; i < 4; ++i) { const float a0 = o[i][0] * rs * gn[i][0] * blo(sgw[2 * i]), a1 = o[i][1] * rs * gn[i][1] * bhi(sgw[2 * i]); \
            const float a2 = o[i][2] * rs * gn[i][2] * blo(sgw[2 * i + 1]), a3 = o[i][3] * rs * gn[i][3] * bhi(sgw[2 * i + 1]); \
            if (i < 2) { y0[2 * i] = pk(a0, a1); y0[2 * i + 1] = pk(a2, a3); } else { y1[2 * (i - 2)] = pk(a0, a1); y1[2 * (i - 2) + 1] = pk(a2, a3); } } \
        bf16* op = MIX + (row0 + (size_t)(cc) * 64 + ot) * MP + h * 128 + 16 * oj; \
        *(u32x4*)op = y0; *(u32x4*)(op + 8) = y1; } while (0)
    H_LOAD_RAW(0); H_DMA_V(0, 0); sgc0 = (u32x4){0u, 0u, 0u, 0u}; sgc1 = sgc0;
    H_PREP1(); HBAR(); H_PREP2(0); H_LOAD_RAW(1); HBAR();
    for (int c = 0; c < NCH; ++c) {
        const int set = c & 1;
        asm volatile("s_waitcnt vmcnt(0)" ::: "memory");
        if (VAR != 1 && c + 1 < NCH) H_DMA_V(c + 1, (c + 1) & 1);
        if (c > 0) H_OUTPUT(c - 1);
        if (VAR != 1) H_LOAD_SG(c, sgc0, sgc1);
        if (VAR != 2 && c + 1 < NCH) H_PREP1();
#pragma unroll
        for (int q = 0; q < 2; ++q) { const int ti = 2 * w + q, tt = ti >> 2, st = ti & 3;
            f32x4 acc = {0.f, 0.f, 0.f, 0.f};
            if (st <= tt) {
                bf16x8 pa[4], pb[4];
#pragma unroll
                for (int ks = 0; ks < 4; ++ks) { pa[ks] = *(HL bf16x8*)(lds + L_K + set * QSET + (16 * st + fr) * QS + (32 * ks + 8 * g) * 2); pb[ks] = *(HL bf16x8*)(lds + L_Q + set * QSET + (16 * tt + fr) * QS + (32 * ks + 8 * g) * 2); }
#pragma unroll
                for (int ks = 0; ks < 4; ++ks) if (VAR != 3) acc = HMF(pa[ks], pb[ks], acc);
                const int dlt = 16 * (tt - st) + fr - 4 * g;
#pragma unroll
                for (int r = 0; r < 4; ++r) acc[r] = (r > dlt) ? 0.f : acc[r];
                asm volatile("" : "+v"(acc));
            }
            *(HL u32x2*)(lds + L_P + (16 * tt + fr) * PS + (16 * st + 4 * g) * 2) = (u32x2){pk(acc[0], acc[1]), pk(acc[2], acc[3])}; }
        f32x4 O[4];
#pragma unroll
        for (int i = 0; i < 4; ++i) O[i] = (f32x4){0.f, 0.f, 0.f, 0.f};
#pragma unroll
        for (int kt = 0; kt < 8; ++kt) S[kt] = S[kt] * *(HL f32x4*)(lds + L_ER + set * 1024 + (16 * kt + 4 * g) * 4);
        bf16x8 sf[4];
#pragma unroll
        for (int ks = 0; ks < 4; ++ks) { u32x4 p; p[0] = pk(S[2 * ks][0], S[2 * ks][1]); p[1] = pk(S[2 * ks][2], S[2 * ks][3]); p[2] = pk(S[2 * ks + 1][0], S[2 * ks + 1][1]); p[3] = pk(S[2 * ks + 1][2], S[2 * ks + 1][3]); sf[ks] = __builtin_bit_cast(bf16x8, p); }
#pragma unroll
        for (int th = 0; th < 2; ++th) {
            u32x2 flo[2][4], fhi[2][4];
#pragma unroll
            for (int t2 = 0; t2 < 2; ++t2)
#pragma unroll
                for (int ks = 0; ks < 4; ++ks) { const int tt = 2 * th + t2; flo[t2][ks] = *(HL u32x2*)(lds + L_Q + set * QSET + (16 * tt + fr) * QS + (32 * ks + 4 * g) * 2); fhi[t2][ks] = *(HL u32x2*)(lds + L_Q + set * QSET + (16 * tt + fr) * QS + (32 * ks + 16 + 4 * g) * 2); }
#pragma unroll
            for (int ks = 0; ks < 4; ++ks)
#pragma unroll
                for (int t2 = 0; t2 < 2; ++t2) { const u32x4 a4 = {flo[t2][ks][0], flo[t2][ks][1], fhi[t2][ks][0], fhi[t2][ks][1]}; if (VAR != 3) O[2 * th + t2] = HMF(__builtin_bit_cast(bf16x8, a4), sf[ks], O[2 * th + t2]); } }
        HBAR();
        if (c + 1 < NCH) { if (VAR != 2) H_PREP2(set ^ 1); if (VAR != 1 && c + 2 < NCH) H_LOAD_RAW(c + 2); }
        bf16x8 vf[2];
        { HL char* vb = lds + L_V + set * 16384 + (8 * g + (fr >> 2)) * 256 + (16 * w + 4 * (fr & 3)) * 2;
#pragma unroll
          for (int st = 0; st < 2; ++st) { const s16x4 lo = trd(vb + st * 32 * 256), hi = trd(vb + st * 32 * 256 + 4 * 256); vf[st] = (bf16x8){lo[0], lo[1], lo[2], lo[3], hi[0], hi[1], hi[2], hi[3]}; } }
        { bf16x8 pf[4][2];
#pragma unroll
          for (int tt = 0; tt < 4; ++tt)
#pragma unroll
            for (int st = 0; st < 2; ++st) { if (st == 1 && tt < 2) continue; pf[tt][st] = *(HL bf16x8*)(lds + L_P + (16 * tt + fr) * PS + (32 * st + 8 * g) * 2); }
#pragma unroll
          for (int st = 0; st < 2; ++st)
#pragma unroll
            for (int tt = 0; tt < 4; ++tt) { if (st == 1 && tt < 2) continue; if (VAR != 3) O[tt] = HMF(pf[tt][st], vf[st], O[tt]); } }
        { HL char* kb = lds + L_K + set * QSET + (8 * g + (fr >> 2)) * QS + (4 * (fr & 3)) * 2;
#pragma unroll
          for (int kh = 0; kh < 2; ++kh) {
            s16x4 tlo[4][2], thi[4][2];
#pragma unroll
            for (int k4 = 0; k4 < 4; ++k4)
#pragma unroll
                for (int st = 0; st < 2; ++st) { const int kt = 4 * kh + k4; tlo[k4][st] = trd(kb + st * 32 * QS + kt * 32); thi[k4][st] = trd(kb + st * 32 * QS + 4 * QS + kt * 32); }
#pragma unroll
            for (int st = 0; st < 2; ++st)
#pragma unroll
                for (int k4 = 0; k4 < 4; ++k4) { const bf16x8 a = (bf16x8){tlo[k4][st][0], tlo[k4][st][1], tlo[k4][st][2], tlo[k4][st][3], thi[k4][st][0], thi[k4][st][1], thi[k4][st][2], thi[k4][st][3]};
                    if (VAR != 3) S[4 * kh + k4] = HMF(a, vf[st], S[4 * kh + k4]); else asm volatile("" :: "v"(a)); } } }
#pragma unroll
        for (int kt = 0; kt < 8; ++kt) S[kt] = S[kt] * *(HL f32x4*)(lds + L_ER + set * 1024 + 512 + (16 * kt + 4 * g) * 4);
#pragma unroll
        for (int tt = 0; tt < 4; ++tt)
#pragma unroll
            for (int r = 0; r < 4; ++r) *(HL float*)(lds + L_O + ((16 * tt + 4 * g + r) * OS + 16 * w + fr) * 4) = O[tt][r];
        HBAR();
    }
    H_OUTPUT(NCH - 1);
#undef H_OUTPUT
#undef H_PREP1
#undef H_PREP2
#undef H_LOAD_RAW
#undef H_DMA_V
#undef H_LOAD_SG
}
template <int VAR = 0> __device__ __forceinline__ void hgrn_phase(char* lds, const bf16* U, bf16* MIX, const float* gain, int vcu, int G) {
    for (int u = vcu; u < NUNITS; u += G) { hgrn_unit<VAR>(lds, U, MIX, gain, u >> 2, u & 3); __syncthreads(); }
    __syncthreads();
}
#undef HL
#undef HBAR
#undef HMF
}
#if MK_OPT_MASK != 0xFF || defined(MK_NAIVE_HGRN) || defined(MK_NAIVE_ATTN) || defined(MK_OVERWRITE)
namespace nb {
__device__ __forceinline__ float wsum(float v) {
#pragma unroll
    for (int o = 1; o < 64; o <<= 1) v += __shfl_xor(v, o);
    return v;
}
__device__ __forceinline__ float siluf(float x) { return x / (1.f + expf(-x)); }
__device__ __forceinline__ float sigm(float x) { return 1.f / (1.f + expf(-x)); }
__device__ __forceinline__ unsigned short tobf(float f) { return (unsigned short)f2bf(f); }
struct NG { const bf16* A; int lda; const int* a_rows; const bf16* Bt; int ldb; const int* tile_e; size_t strideB; int M, N, K, mode; const int* Mdev;
            void* C; const float* R; const float* lb; const int* c_rows; const float* roww; };
__global__ void __launch_bounds__(256) k_ngemm(NG a) {
    __shared__ float As[32][68], Bs[32][68], Bs2[32][68];
    const int M = a.Mdev ? *a.Mdev : a.M;
    const int m0 = blockIdx.y * 64, n0 = blockIdx.x * 64;
    if (m0 >= M) return;
    const bf16* Bp = a.Bt; if (a.tile_e) Bp += (size_t)a.tile_e[m0 >> 8] * a.strideB;
    const int tid = threadIdx.x, tx = tid & 15, ty = tid >> 4;
    const int lr = tid >> 2, lk = (tid & 3) * 8;
    int arow = m0 + lr; bool aval = arow < M;
    if (aval && a.a_rows) { const int g = a.a_rows[arow]; aval = g >= 0; arow = g; }
    const bf16* Ap = a.A + (size_t)(aval ? arow : 0) * a.lda;
    const int j = n0 + lr; const bool dual = a.mode == 2;
    const int brow = dual ? ((j >> 7) * 256 + (j & 127)) : j;
    const bf16* Bq = Bp + (size_t)brow * a.ldb; const bf16* Bq2 = Bq + (size_t)128 * a.ldb;
    float acc[4][4] = {}, acc2[4][4] = {};
    for (int k0 = 0; k0 < a.K; k0 += 32) {
        uint4 av = aval ? *(const uint4*)(Ap + k0 + lk) : make_uint4(0, 0, 0, 0);
        uint4 bv = *(const uint4*)(Bq + k0 + lk); uint4 bv2 = make_uint4(0, 0, 0, 0); if (dual) bv2 = *(const uint4*)(Bq2 + k0 + lk);
        __syncthreads();
        { const unsigned w[4] = {av.x, av.y, av.z, av.w}; const unsigned x[4] = {bv.x, bv.y, bv.z, bv.w}; const unsigned y[4] = {bv2.x, bv2.y, bv2.z, bv2.w};
#pragma unroll
          for (int q = 0; q < 4; ++q) { As[lk + 2 * q][lr] = bflo(w[q]); As[lk + 2 * q + 1][lr] = bfhi(w[q]); Bs[lk + 2 * q][lr] = bflo(x[q]); Bs[lk + 2 * q + 1][lr] = bfhi(x[q]);
              if (dual) { Bs2[lk + 2 * q][lr] = bflo(y[q]); Bs2[lk + 2 * q + 1][lr] = bfhi(y[q]); } } }
        __syncthreads();
#pragma unroll
        for (int kk = 0; kk < 32; ++kk) {
            const float4 a4 = *(const float4*)&As[kk][ty * 4]; const float4 b4 = *(const float4*)&Bs[kk][tx * 4];
            const float aa[4] = {a4.x, a4.y, a4.z, a4.w}, bb[4] = {b4.x, b4.y, b4.z, b4.w};
#pragma unroll
            for (int i = 0; i < 4; ++i)
#pragma unroll
                for (int jj = 0; jj < 4; ++jj) acc[i][jj] = fmaf(aa[i], bb[jj], acc[i][jj]);
            if (dual) { const float4 c4 = *(const float4*)&Bs2[kk][tx * 4]; const float cc[4] = {c4.x, c4.y, c4.z, c4.w};
#pragma unroll
                for (int i = 0; i < 4; ++i)
#pragma unroll
                    for (int jj = 0; jj < 4; ++jj) acc2[i][jj] = fmaf(aa[i], cc[jj], acc2[i][jj]); }
        }
    }
#pragma unroll
    for (int i = 0; i < 4; ++i) {
        const int r = m0 + ty * 4 + i; if (r >= M) continue;
        const int c = n0 + tx * 4;
        float o[4] = {acc[i][0], acc[i][1], acc[i][2], acc[i][3]};
        if (a.mode == 0) { const int kind = c >> 9;
#pragma unroll
            for (int q = 0; q < 4; ++q) { float v = o[q];
                if (kind == 0 || kind == 3) v = siluf(v); else if (kind == 1) { const float l = a.lb[c + q - 512]; v = log2f(l + (1.f - l) * sigm(v)); } else if (kind == 4) v *= QSCALE_;
                ((bf16*)a.C)[(size_t)r * UC_ + c + q] = tobf(v); }
        } else if (a.mode == 1) {
#pragma unroll
            for (int q = 0; q < 4; ++q) ((bf16*)a.C)[(size_t)r * DM_ + c + q] = tobf(o[q]);
        } else if (a.mode == 2) {
#pragma unroll
            for (int q = 0; q < 4; ++q) ((bf16*)a.C)[(size_t)r * 512 + c + q] = tobf(siluf(o[q]) * acc2[i][q]);
        } else { const int cr = a.c_rows[r]; if (cr < 0) continue; const float w = a.roww[r];
            bf16* dst = (bf16*)a.C + (size_t)(cr & 1) * T_ * DM_ + (size_t)(cr >> 1) * DM_ + c;
#pragma unroll
            for (int q = 0; q < 4; ++q) dst[q] = tobf(w * o[q]); }
    }
}
__global__ void k_cum(const float* __restrict__ flg, float* __restrict__ cum) {
    const int i = blockIdx.x * blockDim.x + threadIdx.x; if (i >= NB_ * 8) return;
    const int b = i / 8, h = i % 8; double acc = 0.0;
    for (int s = 0; s < SEQ_; ++s) { acc += (double)flg[(size_t)(b * SEQ_ + s) * 8 + h]; cum[(size_t)(b * SEQ_ + s) * 8 + h] = (float)acc; }
}
__global__ void __launch_bounds__(128) k_hgrn(const bf16* __restrict__ u, float* __restrict__ oraw) {
    __shared__ float qs[16][128], fs[16][128], ks[16][128];
    const int b = blockIdx.x / 4, h = blockIdx.x % 4, v = threadIdx.x;
    float Sr[128];
#pragma unroll
    for (int k = 0; k < 128; ++k) Sr[k] = 0.f;
    for (int t0 = 0; t0 < SEQ_; t0 += 16) {
        __syncthreads();
        for (int i = 0; i < 16; ++i) { const bf16* ur = u + (size_t)(b * SEQ_ + t0 + i) * UC_ + h * 128 + v;
            const float f = exp2f(bf2f(ur[512])); qs[i][v] = bf2f(ur[0]); fs[i][v] = f; ks[i][v] = 1.f - f; }
        __syncthreads();
        for (int i = 0; i < 16; ++i) { const float iv = bf2f(u[(size_t)(b * SEQ_ + t0 + i) * UC_ + 1024 + h * 128 + v]); float o = 0.f;
#pragma unroll
            for (int k = 0; k < 128; ++k) { Sr[k] = fmaf(fs[i][k], Sr[k], ks[i][k] * iv); o = fmaf(qs[i][k], Sr[k], o); }
            oraw[(size_t)(b * SEQ_ + t0 + i) * 512 + h * 128 + v] = o; }
    }
}
__global__ void k_hnorm(const float* __restrict__ oraw, const bf16* __restrict__ u, const float* __restrict__ gain, bf16* __restrict__ mix) {
    const int w = (int)((blockIdx.x * (size_t)blockDim.x + threadIdx.x) >> 6), lane = threadIdx.x & 63;
    if (w >= T_ * 4) return;
    const int t = w / 4, h = w % 4;
    const float* orow = oraw + (size_t)t * 512 + h * 128; const float a = orow[lane], c = orow[lane + 64];
    const float r = rsqrtf(wsum(a * a + c * c) * (1.f / 128) + EPS_);
    const bf16* gr = u + (size_t)t * UC_ + 1536 + h * 128;
    mix[(size_t)t * DM_ + h * 128 + lane] = tobf(a * r * gain[lane] * bf2f(gr[lane]));
    mix[(size_t)t * DM_ + h * 128 + lane + 64] = tobf(c * r * gain[lane + 64] * bf2f(gr[lane + 64]));
}
__global__ void __launch_bounds__(64) k_attn(const bf16* __restrict__ u, const float* __restrict__ cum, const float* __restrict__ gain, bf16* __restrict__ mix) {
    __shared__ float Ks[64][64], Vs[64][64], Cs[64];
    const int qt = blockIdx.x % (SEQ_ / 64), bh = blockIdx.x / (SEQ_ / 64), h = bh % 8, b = bh / 8, lane = threadIdx.x;
    const int t = qt * 64 + lane;
    float q[64], o[64];
    const bf16* qrow = u + (size_t)(b * SEQ_ + t) * UC_ + 2048 + h * 64;
#pragma unroll
    for (int d = 0; d < 64; ++d) { q[d] = bf2f(qrow[d]); o[d] = 0.f; }
    const float ct = cum[(size_t)(b * SEQ_ + t) * 8 + h] * 1.4426950408889634f;
    float m = -1e30f, l = 0.f;
    for (int kt = 0; kt <= qt; ++kt) {
        __syncthreads();
        for (int i = 0; i < 64; ++i) { const bf16* kr = u + (size_t)(b * SEQ_ + kt * 64 + i) * UC_ + 2560 + h * 64; Ks[i][lane] = bf2f(kr[lane]); Vs[i][lane] = bf2f(kr[512 + lane]); }
        Cs[lane] = cum[(size_t)(b * SEQ_ + kt * 64 + lane) * 8 + h] * 1.4426950408889634f;
        __syncthreads();
        for (int s = 0; s < 64; ++s) {
            float x = 0.f;
#pragma unroll
            for (int d = 0; d < 64; ++d) x = fmaf(q[d], Ks[s][d], x);
            x += ct - Cs[s];
            const bool ok = (kt * 64 + s) <= t; if (!ok) x = -1e30f;
            const float mn = fmaxf(m, x); const float al = exp2f(m - mn); const float p = ok ? exp2f(x - mn) : 0.f;
            l = l * al + p; m = mn;
#pragma unroll
            for (int d = 0; d < 64; ++d) o[d] = fmaf(o[d], al, p * Vs[s][d]);
        }
    }
    float ss = 0.f; const float il = 1.f / l;
#pragma unroll
    for (int d = 0; d < 64; ++d) { o[d] *= il; ss += o[d] * o[d]; }
    const float r = rsqrtf(ss * (1.f / 64) + EPS_);
    bf16* orow = mix + (size_t)(b * SEQ_ + t) * DM_ + 512 + h * 64;
#pragma unroll
    for (int d = 0; d < 64; ++d) orow[d] = tobf(o[d] * r * gain[d]);
}
__global__ void k_route(const float* __restrict__ x0, const bf16* __restrict__ dd, const float* __restrict__ gain, const float* __restrict__ wg, const float* __restrict__ bg,
                        const float* __restrict__ we, const float* __restrict__ be, bf16* __restrict__ xn2, int* __restrict__ re, float* __restrict__ rw) {
    const int w = (int)((blockIdx.x * (size_t)blockDim.x + threadIdx.x) >> 6), lane = threadIdx.x & 63;
    if (w >= T_) return;
    const float4* xr = (const float4*)(x0 + (size_t)w * DM_); const float4* gr = (const float4*)gain;
    float4 v[4]; float s = 0.f;
#pragma unroll
    for (int j = 0; j < 4; ++j) { v[j] = xr[lane + 64 * j]; const bf16* dp = dd + (size_t)w * DM_ + (lane + 64 * j) * 4; v[j].x += bf2f(dp[0]); v[j].y += bf2f(dp[1]); v[j].z += bf2f(dp[2]); v[j].w += bf2f(dp[3]); s += v[j].x * v[j].x + v[j].y * v[j].y + v[j].z * v[j].z + v[j].w * v[j].w; }
    s = wsum(s); const float r = rsqrtf(s * (1.f / DM_) + EPS_);
    float lg[20];
#pragma unroll
    for (int i = 0; i < 20; ++i) lg[i] = 0.f;
#pragma unroll
    for (int j = 0; j < 4; ++j) { const float4 gg = gr[lane + 64 * j]; const float tv[4] = {v[j].x * r * gg.x, v[j].y * r * gg.y, v[j].z * r * gg.z, v[j].w * r * gg.w};
        bf16* xo = xn2 + (size_t)w * DM_ + (lane + 64 * j) * 4;
#pragma unroll
        for (int c = 0; c < 4; ++c) { xo[c] = tobf(tv[c]); const int d = (lane + 64 * j) * 4 + c; const float4 g4 = *(const float4*)(wg + (size_t)d * 4);
            lg[0] = fmaf(tv[c], g4.x, lg[0]); lg[1] = fmaf(tv[c], g4.y, lg[1]); lg[2] = fmaf(tv[c], g4.z, lg[2]); lg[3] = fmaf(tv[c], g4.w, lg[3]);
#pragma unroll
            for (int q = 0; q < 4; ++q) { const float4 e4 = *(const float4*)(we + (size_t)d * 16 + q * 4);
                lg[4 + q * 4 + 0] = fmaf(tv[c], e4.x, lg[4 + q * 4 + 0]); lg[4 + q * 4 + 1] = fmaf(tv[c], e4.y, lg[4 + q * 4 + 1]);
                lg[4 + q * 4 + 2] = fmaf(tv[c], e4.z, lg[4 + q * 4 + 2]); lg[4 + q * 4 + 3] = fmaf(tv[c], e4.w, lg[4 + q * 4 + 3]); } } }
#pragma unroll
    for (int i = 0; i < 20; ++i) lg[i] = wsum(lg[i]);
    if (lane == 0) {
        float g[4]; int gs = 0;
#pragma unroll
        for (int i = 0; i < 4; ++i) g[i] = lg[i] + bg[i];
        float gm = g[0];
#pragma unroll
        for (int i = 1; i < 4; ++i) if (g[i] > gm) { gm = g[i]; gs = i; }
        float den = 0.f;
#pragma unroll
        for (int i = 0; i < 4; ++i) den += expf(g[i] - gm);
        const float pg = 1.f / den;
        float e[4];
#pragma unroll
        for (int i = 0; i < 4; ++i) { float x = 0.f;
#pragma unroll
            for (int q = 0; q < 4; ++q) if (q == gs) x = lg[4 + q * 4 + i] + be[q * 4 + i];
            e[i] = x; }
        int i0 = 0; float e0v = e[0];
#pragma unroll
        for (int i = 1; i < 4; ++i) if (e[i] > e0v) { e0v = e[i]; i0 = i; }
        int i1 = -1; float e1v = -3.0e38f;
#pragma unroll
        for (int i = 0; i < 4; ++i) if (i != i0 && e[i] > e1v) { e1v = e[i]; i1 = i; }
        const float p1r = expf(e1v - e0v);
        re[w] = (gs * 4 + i0) | ((gs * 4 + i1) << 8);
        rw[w * 2 + 0] = pg / (1.f + p1r); rw[w * 2 + 1] = pg * p1r / (1.f + p1r);
    }
}
__global__ void k_assign(const int* __restrict__ re, int* __restrict__ cnt, int* __restrict__ entry) {
    const int t = blockIdx.x * blockDim.x + threadIdx.x; if (t >= T_) return;
    const int r = re[t];
#pragma unroll
    for (int k = 0; k < 2; ++k) { const int e = (r >> (8 * k)) & 0xff; const int pos = atomicAdd(&cnt[e], 1); entry[(size_t)e * T_ + pos] = t * 2 + k; }
}
__global__ void k_plan(const int* __restrict__ cnt, int* __restrict__ plan, int* __restrict__ tile_e) {
    if (threadIdx.x == 0 && blockIdx.x == 0) { int base = 0;
        for (int e = 0; e < NE_; ++e) { plan[e] = base; const int nt = (cnt[e] + 255) >> 8; for (int i = 0; i < nt; ++i) tile_e[(base >> 8) + i] = e; base += nt * 256; }
        plan[16] = base; plan[32] = base; }
}
__global__ void k_fill(const int* __restrict__ cnt, const int* __restrict__ plan, const int* __restrict__ entry, const float* __restrict__ rw, int* __restrict__ srow, float* __restrict__ sw, int* __restrict__ stok) {
    const int r = blockIdx.x * blockDim.x + threadIdx.x; if (r >= RMAX_) return;
    int tk = -1; float w = 0.f;
    if (r < plan[16]) { int e = 0;
#pragma unroll
        for (int i = 1; i < NE_; ++i) if (r >= plan[i]) e = i;
        const int pos = r - plan[e];
        if (pos < cnt[e]) { tk = entry[(size_t)e * T_ + pos]; w = rw[tk]; } }
    srow[r] = tk; sw[r] = w; stok[r] = tk < 0 ? -1 : (tk >> 1);
}
__global__ void k_final(const float* x0, const bf16* __restrict__ dd, const bf16* __restrict__ y, const float* __restrict__ g, float* out) {
    const int w = (int)((blockIdx.x * (size_t)blockDim.x + threadIdx.x) >> 6), lane = threadIdx.x & 63;
    if (w >= T_) return;
    const float4* xr = (const float4*)(x0 + (size_t)w * DM_); const float4* gr = (const float4*)g; float4* yr = (float4*)(out + (size_t)w * DM_);
    float4 v[4]; float s = 0.f;
#pragma unroll
    for (int j = 0; j < 4; ++j) { v[j] = xr[lane + 64 * j]; { const bf16* dp = dd + (size_t)w * DM_ + (lane + 64 * j) * 4; v[j].x += bf2f(dp[0]); v[j].y += bf2f(dp[1]); v[j].z += bf2f(dp[2]); v[j].w += bf2f(dp[3]); } const bf16* y0 = y + (size_t)w * DM_ + (lane + 64 * j) * 4; const bf16* y1 = y0 + (size_t)T_ * DM_;
        v[j].x += bf2f(y0[0]) + bf2f(y1[0]); v[j].y += bf2f(y0[1]) + bf2f(y1[1]); v[j].z += bf2f(y0[2]) + bf2f(y1[2]); v[j].w += bf2f(y0[3]) + bf2f(y1[3]);
        s += v[j].x * v[j].x + v[j].y * v[j].y + v[j].z * v[j].z + v[j].w * v[j].w; }
    s = wsum(s); const float r = rsqrtf(s * (1.f / DM_) + EPS_);
#pragma unroll
    for (int j = 0; j < 4; ++j) { const float4 gg = gr[lane + 64 * j]; float4 o; o.x = v[j].x * r * gg.x; o.y = v[j].y * r * gg.y; o.z = v[j].z * r * gg.z; o.w = v[j].w * r * gg.w; yr[lane + 64 * j] = o; }
}
}
#endif
constexpr int N_PHASES = 8;
struct Args { const float* in[17]; float* out; unsigned char* ws; int ph_lo, ph_hi, li, pad; };
__global__ void __launch_bounds__(NWAVES * 64, 2) mk_fwd(Args args) {
    extern __shared__ __attribute__((aligned(16))) unsigned char lds[];
    Frame F;
    F.lds = (LAS unsigned char*)lds;
    F.MISC = (volatile LAS unsigned*)(F.lds + MISC_OFF);
    F.tid = threadIdx.x; F.lane = F.tid & 63; F.wave = __builtin_amdgcn_readfirstlane(F.tid >> 6);
    F.G = gridDim.x; { const int bx = blockIdx.x; F.vcu = (F.G % 8 == 0) ? (bx % 8) * (F.G / 8) + bx / 8 : bx; }
    F.ws = args.ws; F.out = args.out;
#pragma unroll
    for (int i = 0; i < 17; ++i) F.in[i] = args.in[i];
    F.ctl = (gu32*)(args.ws + WS_CTL);
#if defined(MK_ZERO_LDS)
    for (int u = F.tid; u < LDSCTL_OFF / 4; u += NWAVES * 64) ((LAS unsigned*)(F.lds))[u] = 0u;
#endif
    for (int u = F.tid; u < (LDS_BYTES - LDSCTL_OFF) / 4; u += NWAVES * 64) ((LAS unsigned*)(F.lds + LDSCTL_OFF))[u] = 0u;
    __syncthreads();
    const int lo = args.ph_lo, hi = args.ph_hi;
    XcdBarrier bar; bar.bar = (unsigned*)(F.ctl + CW_BAR) + args.li * XCD_BAR_WORDS; bar.x = 0; bar.st = nullptr;
    if (hi - lo > 1) bar = xcd_barrier_post((unsigned*)(F.ctl + CW_BAR) + args.li * XCD_BAR_WORDS, F.MISC + 8);
#ifndef MK_PH_EN
#define MK_PH_EN 0xFF
#endif
#define IN(k) (((MK_PH_EN >> (k)) & 1) && lo <= (k) && (k) < hi)
#define BOTH(k) (IN(k) && IN((k) + 1))
#define GRID_BAR() xcd_barrier(bar)
#define P1_PROBE 0
#ifndef MK_REP_PHASE
#define MK_REP_PHASE -1
#endif
#ifndef MK_REP_SUB
#define MK_REP_SUB 0
#endif
#define NREP(k) ((MK_REP_PHASE == (k)) ? 2 : 1)
    bf16* XN = (bf16*)(F.ws + WS_XN); bf16* U = (bf16*)(F.ws + WS_U);

    if (IN(0)) { p0_prologue(F); if (BOTH(0)) GRID_BAR(); }

    if (IN(1)) {
        pg8::Gemm g{XN, (const bf16*)(F.ws + WS_WI), T_, UC_, DM_}; pg8::StaticOrder S; S.init(T_, UC_, F.G, (int)blockIdx.x);
        { LAS float* lbl = (LAS float*)(F.lds + TAB_OFF); if (F.tid < 512) lbl[F.tid] = ((const float*)(F.ws + WS_LB))[F.tid]; __syncthreads(); }
        pg8::EpiU E{U, UC_, (LAS const float*)(F.lds + TAB_OFF), QSCALE_, P1_PROBE, (long)(WS_CTL + (size_t)CW_KT * 4) - (long)WS_U};
        pg8::gemm_phase<pg8::EpiU, pg8::StaticOrder, true, true>(F.lds + RING_OFF, g, S, E);
        if (BOTH(1)) GRID_BAR();
    }

    if (IN(2)) {
#if !defined(MK_NAIVE_HGRN)
#if MK_REP_SUB == 1
#ifndef MK_HG_VAR
#define MK_HG_VAR 0
#endif
        hgrn_body::hgrn_phase<MK_HG_VAR>((char*)lds + RING_OFF, (const bf16*)U, (bf16*)(F.ws + WS_MIX), F.in[4], F.vcu, F.G);
#endif
        hgrn_body::hgrn_phase((char*)lds + RING_OFF, (const bf16*)U, (bf16*)(F.ws + WS_MIX), F.in[4], F.vcu, F.G);
#endif
#if defined(MK_SELFCHECK_HGRN)
#if defined(MK_SCRAMBLE_LDS)
        __syncthreads(); for (int u = F.tid; u < LDSCTL_OFF / 4; u += NWAVES * 64) ((LAS unsigned*)(F.lds))[u] = 0xFFFFFFFFu; __syncthreads();
#endif
        hgrn_body::hgrn_phase((char*)lds + RING_OFF, (const bf16*)U, (bf16*)(F.ws + WS_ORAW), F.in[4], F.vcu, F.G);
        asm volatile("s_waitcnt vmcnt(0)" ::: "memory"); __syncthreads();
        if (F.vcu < 128) { const int ub = F.vcu >> 2, uh = F.vcu & 3; unsigned bad = 0u;
            for (int i = F.tid; i < 2048 * 16; i += NWAVES * 64) { const size_t off = ((size_t)ub * 2048 + (i >> 4)) * 1024 + uh * 128 + (i & 15) * 8;
                const unsigned long long a0 = __hip_atomic_load((const unsigned long long*)(XN + off), RLX_AGENT), a1 = __hip_atomic_load((const unsigned long long*)(XN + off) + 1, RLX_AGENT);
                const unsigned long long b0 = __hip_atomic_load((const unsigned long long*)((const bf16*)(F.ws + WS_ORAW) + off), RLX_AGENT), b1 = __hip_atomic_load((const unsigned long long*)((const bf16*)(F.ws + WS_ORAW) + off) + 1, RLX_AGENT);
                bad |= (a0 != b0 || a1 != b1) ? 1u : 0u; }
            if (bad) __hip_atomic_store(F.ctl + 2, 1u, RLX_AGENT); }
        __syncthreads();
#endif
#if !defined(MK_NAIVE_ATTN)
        attn_body::attn_phase<8>((char*)lds + RING_OFF, (const attn_body::bf16*)U, (attn_body::bf16*)(F.ws + WS_MIX), (const float*)(F.ws + WS_FLG), F.in[6], F.vcu, F.G, (unsigned*)(F.ctl + CW_CLAIM), (const unsigned*)(F.ctl + CW_KT), (const unsigned*)(F.ctl + CW_QT),
            [&](int it) { if (F.G == 256 && it < 0) { __syncthreads(); Frame F2 = F; { int l_ = F.lane; asm volatile("" : "+v"(l_)); F2.lane = l_; }
                convert_items(F2, CONV_I_WI, CONV_I_REST, F.vcu * NWAVES + F.wave, F.G * NWAVES); __syncthreads(); } });
#endif
#if MK_REP_SUB == 2
        attn_body::attn_phase<8>((char*)lds + RING_OFF, (const attn_body::bf16*)U, (attn_body::bf16*)(F.ws + WS_MIX), (const float*)(F.ws + WS_FLG), F.in[6], F.vcu, F.G, (unsigned*)(F.ctl + CW_CLAIM), (const unsigned*)(F.ctl + CW_KT), (const unsigned*)(F.ctl + CW_QT),
            [&](int it) { if (F.G == 256 && it < 0) { __syncthreads(); Frame F2 = F; { int l_ = F.lane; asm volatile("" : "+v"(l_)); F2.lane = l_; }
                convert_items(F2, CONV_I_WI, CONV_I_REST, F.vcu * NWAVES + F.wave, F.G * NWAVES); __syncthreads(); } });
#endif

        if (BOTH(2)) GRID_BAR();
    }

    if (IN(3)) {
        pg8::Gemm g{(const bf16*)(F.ws + WS_MIX), (const bf16*)(F.ws + WS_WO), T_, DM_, DM_}; pg8::StaticOrder S; S.init(T_, DM_, F.G, (int)blockIdx.x);
        pg8::EpiH1 E{F.in[1], (bf16*)(F.ws + WS_D), DM_, (long)WS_XN - (long)WS_D, (long)WS_RMS0 - (long)WS_D};
        pg8::gemm_phase<pg8::EpiH1, pg8::StaticOrder, true, true>(F.lds + RING_OFF, g, S, E);
        if (BOTH(3)) GRID_BAR();
    }

#if defined(MK_TIME_P4)
    if (IN(4)) { p4_router<true>(F); GRID_BAR(); }
#endif
    if (IN(4)) { p4_router<false>(F); if (BOTH(4)) GRID_BAR(); }

    if (IN(5)) {
        moe_tables(F, false);
        pg8::MGemm g{(const bf16*)(F.ws + WS_D), (const bf16*)(F.ws + WS_WGU), DM_, DM_, 1024}; pg8::MoeOrderP<3> S{(LAS const int*)(F.lds + TB_OFF), F.G, F.vcu};
        pg8::EpiSwiglu E{(bf16*)(F.ws + WS_HB), (LAS const int*)(F.lds + TAB_OFF)};
        pg8::gemm_phase_moe<pg8::EpiSwiglu, pg8::MoeOrderP<3>, true, true, false>(F.lds + RING_OFF, (LAS const int*)(F.lds + TAB_OFF), g, S, E);
        if (BOTH(5)) GRID_BAR();
    }

    if (IN(6)) {
        moe_tables(F, true, IN(5));
        pg8::MGemm g{(const bf16*)(F.ws + WS_HB), (const bf16*)(F.ws + WS_WD), 2 * EH_, EH_, 1024}; pg8::MoeOrderP<2> S{(LAS const int*)(F.lds + TB_OFF), F.G, F.vcu};
        pg8::EpiDown E{(bf16*)(F.ws + WS_Y), (LAS const int*)(F.lds + TAB_OFF)};
        pg8::gemm_phase_moe<pg8::EpiDown, pg8::MoeOrderP<2>, false, true, true>(F.lds + RING_OFF, (LAS const int*)(F.lds + TAB_OFF), g, S, E);
        if (BOTH(6)) GRID_BAR();
    }

#if defined(MK_TIME_P7)
    if (IN(7)) { p7_final<true>(F); GRID_BAR(); }
#endif
    if (IN(7)) { p7_final<false>(F); }
#undef IN
#undef BOTH
#undef GRID_BAR
}
extern "C" void kernel_launch(void* const* d_in, const int* in_sizes, int n_in, void* d_out, int out_size, void* d_ws, size_t ws_size, hipStream_t stream) {
    static int grid = 0;
    if (grid == 0) {
        if (n_in != 17 || in_sizes[0] != T_ * DM_ || out_size != T_ * DM_ || ws_size < WS_END) { fprintf(stderr, "kernel_launch: unexpected shapes (n_in %d, in0 %d, out %d, ws %zu); nothing launched\n", n_in, n_in > 0 ? in_sizes[0] : -1, out_size, ws_size); grid = -1; return; }
        int dev = 0, cus = 0, per_cu = 0;
        if (hipGetDevice(&dev) != hipSuccess || hipDeviceGetAttribute(&cus, hipDeviceAttributeMultiprocessorCount, dev) != hipSuccess) { grid = -1; return; }
        if (hipFuncSetAttribute((const void*)mk_fwd, hipFuncAttributeMaxDynamicSharedMemorySize, LDS_BYTES) != hipSuccess) { fprintf(stderr, "kernel_launch: hipFuncSetAttribute failed\n"); grid = -1; return; }
        if (hipOccupancyMaxActiveBlocksPerMultiprocessor(&per_cu, (const void*)mk_fwd, NWAVES * 64, LDS_BYTES) != hipSuccess || per_cu < 1)
            fprintf(stderr, "kernel_launch: note: occupancy query reports %d workgroups per CU\n", per_cu);
        (void)hipGetLastError();
        grid = cus;
    }
    if (grid < 0) return;
    unsigned char* ws = (unsigned char*)d_ws;
    if (hipMemsetAsync(ws + WS_CTL, 0, CTL_ZERO_BYTES, stream) != hipSuccess) return;
    Args a{};
    for (int i = 0; i < 17; ++i) a.in[i] = (const float*)d_in[i];
    a.out = (float*)d_out; a.ws = ws;
    int li = 0;
    for (int p = 0; p < N_PHASES;) {
        if ((MK_OPT_MASK >> p) & 1) { int q = p; while (q < N_PHASES && ((MK_OPT_MASK >> q) & 1)) ++q;
#if defined(MK_NAIVE_HGRN) || defined(MK_NAIVE_ATTN)
            if (p < 2 && q > 2) q = 2;
#endif
#if defined(MK_NAIVE_HGRN)
            if (p == 2) { nb::k_hgrn<<<NB_ * 4, 128, 0, stream>>>((const bf16*)(ws + WS_U), (float*)(ws + WS_ORAW)); nb::k_hnorm<<<T_ * 4 / 4, 256, 0, stream>>>((const float*)(ws + WS_ORAW), (const bf16*)(ws + WS_U), (const float*)d_in[4], (bf16*)(ws + WS_XN)); }
#endif
#if defined(MK_NAIVE_ATTN)
            if (p == 2) { nb::k_cum<<<1, 256, 0, stream>>>((const float*)(ws + WS_FLG), (float*)(ws + WS_CUM)); nb::k_attn<<<NB_ * 8 * (SEQ_ / 64), 64, 0, stream>>>((const bf16*)(ws + WS_U), (const float*)(ws + WS_CUM), (const float*)d_in[6], (bf16*)(ws + WS_XN)); }
#endif
#if defined(MK_OVERWRITE)
            { int c = p; while (c < q && !((MK_OVERWRITE >> c) & 1) && !(c == 2 && (MK_OVERWRITE & 0x300))) ++c; if (c < q) q = c + 1; }
#endif
            a.ph_lo = p; a.ph_hi = q; a.li = li++;
            hipLaunchKernelGGL(mk_fwd, dim3(grid), dim3(NWAVES * 64), LDS_BYTES, stream, a);
#if defined(MK_OVERWRITE)
            { const int k = q - 1; bf16* XNb = (bf16*)(ws + WS_XN); bf16* Ub = (bf16*)(ws + WS_U); float* outf = (float*)d_out;
              int* CNT = (int*)(ws + WS_CTL) + CW_CNT; int* PLAN = (int*)(ws + WS_CTL) + CW_PLAN;
              if (k == 1 && ((MK_OVERWRITE >> 1) & 1)) { nb::NG g{}; g.A = XNb; g.lda = DM_; g.Bt = (const bf16*)(ws + WS_WI); g.ldb = DM_; g.M = T_; g.N = UC_; g.K = DM_; g.mode = 0; g.C = Ub; g.lb = (const float*)(ws + WS_LB);
                  nb::k_ngemm<<<dim3(UC_ / 64, T_ / 64), 256, 0, stream>>>(g); }
              if (k == 2 && (MK_OVERWRITE & 0x100)) { nb::k_hgrn<<<NB_ * 4, 128, 0, stream>>>(Ub, (float*)(ws + WS_ORAW)); nb::k_hnorm<<<T_ * 4 / 4, 256, 0, stream>>>((const float*)(ws + WS_ORAW), Ub, (const float*)d_in[4], XNb); }
              if (k == 2 && (MK_OVERWRITE & 0x200)) { nb::k_cum<<<1, 256, 0, stream>>>((const float*)(ws + WS_FLG), (float*)(ws + WS_CUM)); nb::k_attn<<<NB_ * 8 * (SEQ_ / 64), 64, 0, stream>>>(Ub, (const float*)(ws + WS_CUM), (const float*)d_in[6], XNb); }
              if (k == 3 && ((MK_OVERWRITE >> 3) & 1)) { nb::NG g{}; g.A = XNb; g.lda = DM_; g.Bt = (const bf16*)(ws + WS_WO); g.ldb = DM_; g.M = T_; g.N = DM_; g.K = DM_; g.mode = 1; g.C = (bf16*)(ws + WS_D);
                  nb::k_ngemm<<<dim3(DM_ / 64, T_ / 64), 256, 0, stream>>>(g); }
              if ((k == 5 && ((MK_OVERWRITE >> 5) & 1)) || (k == 6 && ((MK_OVERWRITE >> 6) & 1))) {
                  nb::k_plan<<<1, 64, 0, stream>>>(CNT, PLAN, (int*)(ws + WS_TILEE)); nb::k_fill<<<(RMAX_ + 255) / 256, 256, 0, stream>>>(CNT, PLAN, (const int*)(ws + WS_ENTRY), (const float*)(ws + WS_RW), (int*)(ws + WS_SROW), (float*)(ws + WS_SW), (int*)(ws + WS_STOK));
                  nb::NG g{}; g.tile_e = (const int*)(ws + WS_TILEE); g.Mdev = PLAN + 16; g.M = RMAX_;
                  if (k == 5) { g.A = XNb; g.lda = DM_; g.a_rows = (const int*)(ws + WS_STOK); g.Bt = (const bf16*)(ws + WS_WGU); g.ldb = DM_; g.strideB = (size_t)1024 * 1024; g.N = 512; g.K = DM_; g.mode = 2; g.C = (bf16*)(ws + WS_HB);
                      nb::k_ngemm<<<dim3(512 / 64, RMAX_ / 64), 256, 0, stream>>>(g); }
                  else { g.A = (const bf16*)(ws + WS_HB); g.lda = 512; g.Bt = (const bf16*)(ws + WS_WD); g.ldb = 512; g.strideB = (size_t)1024 * 512; g.N = DM_; g.K = 512; g.mode = 3; g.C = (bf16*)(ws + WS_Y); g.c_rows = (const int*)(ws + WS_SROW); g.roww = (const float*)(ws + WS_SW);
                      nb::k_ngemm<<<dim3(DM_ / 64, RMAX_ / 64), 256, 0, stream>>>(g); } } }
#endif
            p = q; continue; }
#if MK_OPT_MASK != 0xFF
        bf16* XN = (bf16*)(ws + WS_XN); bf16* U = (bf16*)(ws + WS_U); float* out = (float*)d_out;
        int* CNT = (int*)(ws + WS_CTL) + CW_CNT; int* PLAN = (int*)(ws + WS_CTL) + CW_PLAN;
        int* RE = (int*)(ws + WS_RE); float* RW = (float*)(ws + WS_RW); int* ENTRY = (int*)(ws + WS_ENTRY); int* SROW = (int*)(ws + WS_SROW); float* SW = (float*)(ws + WS_SW);
        int* STOK = (int*)(ws + WS_STOK); int* TILEE = (int*)(ws + WS_TILEE); float* CUM = (float*)(ws + WS_CUM); float* ORAW = (float*)(ws + WS_ORAW);
        bf16* HB = (bf16*)(ws + WS_HB); bf16* Y = (bf16*)(ws + WS_Y);
        if (p == 1) { nb::NG g{}; g.A = XN; g.lda = DM_; g.Bt = (const bf16*)(ws + WS_WI); g.ldb = DM_; g.M = T_; g.N = UC_; g.K = DM_; g.mode = 0; g.C = U; g.lb = (const float*)(ws + WS_LB);
            nb::k_ngemm<<<dim3(UC_ / 64, T_ / 64), 256, 0, stream>>>(g); }
        else if (p == 2) { nb::k_cum<<<1, 256, 0, stream>>>((const float*)(ws + WS_FLG), CUM);
            nb::k_hgrn<<<NB_ * 4, 128, 0, stream>>>(U, ORAW); nb::k_hnorm<<<T_ * 4 / 4, 256, 0, stream>>>(ORAW, U, (const float*)d_in[4], XN);
            nb::k_attn<<<NB_ * 8 * (SEQ_ / 64), 64, 0, stream>>>(U, CUM, (const float*)d_in[6], XN); }
        else if (p == 3) { nb::NG g{}; g.A = XN; g.lda = DM_; g.Bt = (const bf16*)(ws + WS_WO); g.ldb = DM_; g.M = T_; g.N = DM_; g.K = DM_; g.mode = 1; g.C = (bf16*)(ws + WS_D);
            nb::k_ngemm<<<dim3(DM_ / 64, T_ / 64), 256, 0, stream>>>(g); }
        else if (p == 4) { nb::k_route<<<T_ / 4, 256, 0, stream>>>((const float*)d_in[0], (const bf16*)(ws + WS_D), (const float*)d_in[8], (const float*)d_in[9], (const float*)d_in[10], (const float*)d_in[11], (const float*)d_in[12], XN, RE, RW);
            nb::k_assign<<<T_ / 256, 256, 0, stream>>>(RE, CNT, ENTRY); }
        else if (p == 5 || p == 6) { nb::k_plan<<<1, 64, 0, stream>>>(CNT, PLAN, TILEE); nb::k_fill<<<(RMAX_ + 255) / 256, 256, 0, stream>>>(CNT, PLAN, ENTRY, RW, SROW, SW, STOK);
            nb::NG g{}; g.tile_e = TILEE; g.Mdev = PLAN + 16; g.M = RMAX_;
            if (p == 5) { g.A = XN; g.lda = DM_; g.a_rows = STOK; g.Bt = (const bf16*)(ws + WS_WGU); g.ldb = DM_; g.strideB = (size_t)1024 * 1024; g.N = 512; g.K = DM_; g.mode = 2; g.C = HB;
                nb::k_ngemm<<<dim3(512 / 64, RMAX_ / 64), 256, 0, stream>>>(g); }
            else { g.A = HB; g.lda = 512; g.Bt = (const bf16*)(ws + WS_WD); g.ldb = 512; g.strideB = (size_t)1024 * 512; g.N = DM_; g.K = 512; g.mode = 3; g.C = Y; g.c_rows = SROW; g.roww = SW;
                nb::k_ngemm<<<dim3(DM_ / 64, RMAX_ / 64), 256, 0, stream>>>(g); } }
        else if (p == 7) { nb::k_final<<<T_ / 4, 256, 0, stream>>>((const float*)d_in[0], (const bf16*)(ws + WS_D), Y, (const float*)d_in[16], out); }
#endif
        ++p;
    }
}
```
